# Optimizing an MI355X kernel written in HIP

```python
import jax, jax.numpy as jnp
from jax import lax
import numpy as np

D_MODEL = 1024
BATCH = 8
SEQ = 4096
DEPTH = 2

HEAD_DIM = 64
MOBA_HEADS = 8
MOBA_BLOCK = 256
MOBA_TOPK = 3
MOBA_Q_CHUNK = 32
FOX_HEADS = 8
FOX_Q_BLOCK = 128
POOL_WINDOWS = (2, 4, 8, 16)
POOL_GROUP = 128
POOL_WIDTH = POOL_GROUP * len(POOL_WINDOWS)
MEM_HEADS = 4
MEM_HEAD_DIM = 128
MEM_LEN = 256
ROPE_THETA = 500000.0
ROT_DIM = HEAD_DIM // 4
N_BRANCH = 4
BRANCH_WIDTH = 512
D_FF = 2816
RMS_EPS = 1e-6
NEG_INF = -1e30

MOBA_WIDTH = MOBA_HEADS * HEAD_DIM
FOX_WIDTH = FOX_HEADS * HEAD_DIM
MEM_WIDTH = MEM_HEADS * MEM_HEAD_DIM
IN_SIZES = (3 * MOBA_WIDTH, 3 * FOX_WIDTH, FOX_HEADS, POOL_WIDTH, MEM_WIDTH, N_BRANCH * D_MODEL)
IN_SPLITS = tuple(sum(IN_SIZES[:i + 1]) for i in range(len(IN_SIZES) - 1))
D_IN = sum(IN_SIZES)

kernel_name = 'hybrid_moba_pool_fox_memory_macaron'


def rms_norm(x, gain):
    x32 = x.astype(jnp.float32)
    y = x32 * lax.rsqrt(jnp.mean(x32 * x32, axis=-1, keepdims=True) + RMS_EPS)
    return (y * gain.astype(jnp.float32)).astype(x.dtype)


def swiglu(h, w_in, w_out):
    g, u = jnp.split(h @ w_in, 2, axis=-1)
    return (jax.nn.silu(g) * u) @ w_out


def to_heads(t, n, d):
    b, s, _ = t.shape
    return t.reshape(b, s, n, d).transpose(0, 2, 1, 3)


def from_heads(t):
    b, n, s, d = t.shape
    return t.transpose(0, 2, 1, 3).reshape(b, s, n * d)


def split_qkv(t, n, d):
    b, s, _ = t.shape
    t = t.reshape(b, s, 3, n, d)
    return (t[:, :, 0].transpose(0, 2, 1, 3), t[:, :, 1].transpose(0, 2, 1, 3),
            t[:, :, 2].transpose(0, 2, 1, 3))


def partial_rotary(x, positions):
    half = ROT_DIM // 2
    inv_freq = jnp.power(ROPE_THETA, -jnp.arange(half, dtype=jnp.float32) * (2.0 / ROT_DIM))
    ang = positions.astype(jnp.float32)[:, None, :, None] * inv_freq
    cos = jnp.cos(ang).astype(x.dtype)
    sin = jnp.sin(ang).astype(x.dtype)
    x1 = x[..., :half]
    x2 = x[..., half:ROT_DIM]
    return jnp.concatenate([x1 * cos - x2 * sin, x2 * cos + x1 * sin, x[..., ROT_DIM:]], axis=-1)


def moba_attention(q, k, v):
    b, h, s, d = q.shape
    n_blk = -(-s // MOBA_BLOCK)
    s_pad = n_blk * MOBA_BLOCK
    pad = ((0, 0), (0, 0), (0, s_pad - s), (0, 0))
    q, k, v = (jnp.pad(t, pad) for t in (q, k, v))
    kb = k.reshape(b, h, n_blk, MOBA_BLOCK, d)
    vb = v.reshape(b, h, n_blk, MOBA_BLOCK, d)
    k_mean = jnp.mean(kb.astype(jnp.float32), axis=3)
    n_sel = min(MOBA_TOPK, n_blk)
    n_chunk = s_pad // MOBA_Q_CHUNK
    qc = q.reshape(b, h, n_chunk, MOBA_Q_CHUNK, d).transpose(2, 0, 1, 3, 4)
    b_idx = jnp.arange(b)[:, None, None, None]
    h_idx = jnp.arange(h)[None, :, None, None]
    scale = d ** -0.5

    def chunk(args):
        q_i, c_i = args
        start = c_i * MOBA_Q_CHUNK
        blk = start // MOBA_BLOCK
        q_pos = start + jnp.arange(MOBA_Q_CHUNK)
        gate = jnp.einsum('bhqd,bhnd->bhqn', q_i.astype(jnp.float32), k_mean)
        gate = jnp.where(jnp.arange(n_blk) < blk, gate, NEG_INF)
        _, sel = lax.top_k(gate, n_sel)
        valid = sel < blk
        k_sel = kb[b_idx, h_idx, sel]
        v_sel = vb[b_idx, h_idx, sel]
        s_sel = jnp.einsum('bhqd,bhqkld->bhqkl', q_i, k_sel).astype(jnp.float32) * scale
        s_sel = jnp.where(valid[..., None], s_sel, NEG_INF)
        s_sel = s_sel.reshape(b, h, MOBA_Q_CHUNK, n_sel * MOBA_BLOCK)
        k_own = lax.dynamic_index_in_dim(kb, blk, axis=2, keepdims=False)
        v_own = lax.dynamic_index_in_dim(vb, blk, axis=2, keepdims=False)
        s_own = jnp.einsum('bhqd,bhld->bhql', q_i, k_own).astype(jnp.float32) * scale
        k_pos = blk * MOBA_BLOCK + jnp.arange(MOBA_BLOCK)
        s_own = jnp.where(k_pos[None, :] <= q_pos[:, None], s_own, NEG_INF)
        p = jax.nn.softmax(jnp.concatenate([s_sel, s_own], axis=-1), axis=-1).astype(v.dtype)
        p_sel = p[..., :n_sel * MOBA_BLOCK].reshape(b, h, MOBA_Q_CHUNK, n_sel, MOBA_BLOCK)
        p_own = p[..., n_sel * MOBA_BLOCK:]
        return (jnp.einsum('bhqkl,bhqkld->bhqd', p_sel, v_sel)
                + jnp.einsum('bhql,bhld->bhqd', p_own, v_own))

    out = lax.map(chunk, (qc, jnp.arange(n_chunk)))
    out = out.transpose(1, 2, 0, 3, 4).reshape(b, h, s_pad, d)
    return out[:, :, :s]


def forgetting_attention(q, k, v, log_f):
    b, h, s, d = q.shape
    c = jnp.cumsum(log_f, axis=-1)
    n_blk = s // FOX_Q_BLOCK
    qb = q.reshape(b, h, n_blk, FOX_Q_BLOCK, d).transpose(2, 0, 1, 3, 4)
    cb = c.reshape(b, h, n_blk, FOX_Q_BLOCK).transpose(2, 0, 1, 3)
    k_pos = jnp.arange(s)
    scale = d ** -0.5

    def block(args):
        q_i, c_i, i = args
        q_pos = i * FOX_Q_BLOCK + jnp.arange(FOX_Q_BLOCK)
        logits = (jnp.einsum('bhqd,bhkd->bhqk', q_i, k).astype(jnp.float32) * scale
                  + (c_i[..., None] - c[:, :, None, :]))
        logits = jnp.where(k_pos[None, :] <= q_pos[:, None], logits, NEG_INF)
        p = jax.nn.softmax(logits, axis=-1).astype(v.dtype)
        return jnp.einsum('bhqk,bhkd->bhqd', p, v)

    out = lax.map(block, (qb, cb, jnp.arange(n_blk)))
    return out.transpose(1, 2, 0, 3, 4).reshape(b, h, s, d)


def multiscale_pool(u, pool_mix, pool_scale):
    b, s, _ = u.shape
    ug = u.reshape(b, s, len(POOL_WINDOWS), POOL_GROUP)
    csum = jnp.cumsum(ug.astype(jnp.float32), axis=1)
    t = jnp.arange(s)
    means = []
    for g, w in enumerate(POOL_WINDOWS):
        cg = csum[:, :, g]
        prev = jnp.pad(cg, ((0, 0), (w, 0), (0, 0)))[:, :s]
        cnt = jnp.minimum(t + 1, w).astype(jnp.float32)[None, :, None]
        means.append((cg - prev) / cnt)
    pooled = (jnp.stack(means, axis=2) - ug.astype(jnp.float32)).astype(u.dtype)
    mixed = jnp.einsum('bsgc,gce->bsge', pooled, pool_mix)
    return mixed.reshape(b, s, POOL_WIDTH) * pool_scale


def memory_cross_attention(q_flat, mem, norm_gain, w_kv, q_gain, k_gain):
    q = rms_norm(to_heads(q_flat, MEM_HEADS, MEM_HEAD_DIM), q_gain)
    k_m, v_m = jnp.split(rms_norm(mem, norm_gain) @ w_kv, 2, axis=-1)
    k_m = rms_norm(to_heads(k_m, MEM_HEADS, MEM_HEAD_DIM), k_gain)
    v_m = to_heads(v_m, MEM_HEADS, MEM_HEAD_DIM)
    logits = jnp.einsum('bhqd,bhmd->bhqm', q, k_m).astype(jnp.float32) * (MEM_HEAD_DIM ** -0.5)
    p = jax.nn.softmax(logits, axis=-1).astype(v_m.dtype)
    return from_heads(jnp.einsum('bhqm,bhmd->bhqd', p, v_m))


def hybrid_mixer(h, mem, positions, w_in, b_forget, moba_q_gain, moba_k_gain,
                 fox_q_gain, fox_k_gain, norm_mem, w_mem_kv, mem_q_gain, mem_k_gain,
                 pool_mix, pool_scale, w_branch, w_out):
    b, s, _ = h.shape
    proj = h @ w_in
    moba_qkv, fox_qkv, fox_f, pool_u, mem_q, gate_logits = jnp.split(proj, IN_SPLITS, axis=-1)
    q_a, k_a, v_a = split_qkv(moba_qkv, MOBA_HEADS, HEAD_DIM)
    q_a = partial_rotary(rms_norm(q_a, moba_q_gain), positions)
    k_a = partial_rotary(rms_norm(k_a, moba_k_gain), positions)
    o_a = from_heads(moba_attention(q_a, k_a, v_a))
    o_b = multiscale_pool(pool_u, pool_mix, pool_scale)
    q_c, k_c, v_c = split_qkv(fox_qkv, FOX_HEADS, HEAD_DIM)
    log_f = jax.nn.log_sigmoid((fox_f + b_forget).astype(jnp.float32)).transpose(0, 2, 1)
    o_c = from_heads(forgetting_attention(rms_norm(q_c, fox_q_gain), rms_norm(k_c, fox_k_gain),
                                          v_c, log_f))
    o_m = memory_cross_attention(mem_q, mem, norm_mem, w_mem_kv, mem_q_gain, mem_k_gain)
    branches = jnp.stack([o_a, o_b, o_c, o_m], axis=2)
    y = jnp.einsum('bsnc,ncd->bsnd', branches, w_branch)
    gates = jax.nn.sigmoid(gate_logits.reshape(b, s, N_BRANCH, D_MODEL))
    return jnp.sum(gates * y, axis=2) @ w_out


def setup_inputs(seed: int = 0) -> dict:
    key = jax.random.key(seed)
    ks = jax.random.split(key, 26)
    f32 = jnp.float32

    def dense(k, shape, fan_in):
        return jax.random.normal(k, shape, f32) * (fan_in ** -0.5)

    def gain(k, shape):
        return 1.0 + 0.05 * jax.random.normal(k, shape, f32)

    x = jax.random.normal(ks[0], (BATCH, SEQ, D_MODEL), f32)
    mem = jax.random.normal(ks[1], (BATCH, MEM_LEN, D_MODEL), f32)
    offsets = jax.random.randint(ks[2], (BATCH, 1), 0, 1024, dtype=jnp.int32)
    positions = offsets + jnp.arange(SEQ, dtype=jnp.int32)[None, :]
    L = DEPTH
    return {
        'x': x,
        'mem': mem,
        'positions': positions,
        'norm_ffn1': gain(ks[3], (L, D_MODEL)),
        'w_ffn1_in': dense(ks[4], (L, D_MODEL, 2 * D_FF), D_MODEL),
        'w_ffn1_out': dense(ks[5], (L, D_FF, D_MODEL), D_FF),
        'norm_mix': gain(ks[6], (L, D_MODEL)),
        'w_in': dense(ks[7], (L, D_MODEL, D_IN), D_MODEL),
        'b_forget': jax.random.uniform(ks[8], (L, FOX_HEADS), f32, 1.0, 5.0),
        'moba_q_gain': gain(ks[9], (L, HEAD_DIM)),
        'moba_k_gain': gain(ks[10], (L, HEAD_DIM)),
        'fox_q_gain': gain(ks[11], (L, HEAD_DIM)),
        'fox_k_gain': gain(ks[12], (L, HEAD_DIM)),
        'norm_mem': gain(ks[13], (L, D_MODEL)),
        'w_mem_kv': dense(ks[14], (L, D_MODEL, 2 * MEM_WIDTH), D_MODEL),
        'mem_q_gain': gain(ks[15], (L, MEM_HEAD_DIM)),
        'mem_k_gain': gain(ks[16], (L, MEM_HEAD_DIM)),
        'pool_mix': dense(ks[17], (L, len(POOL_WINDOWS), POOL_GROUP, POOL_GROUP), POOL_GROUP),
        'pool_scale': gain(ks[18], (L, POOL_WIDTH)),
        'w_branch': dense(ks[19], (L, N_BRANCH, BRANCH_WIDTH, D_MODEL), BRANCH_WIDTH),
        'w_out': dense(ks[20], (L, D_MODEL, D_MODEL), D_MODEL),
        'norm_ffn2': gain(ks[21], (L, D_MODEL)),
        'w_ffn2_in': dense(ks[22], (L, D_MODEL, 2 * D_FF), D_MODEL),
        'w_ffn2_out': dense(ks[23], (L, D_FF, D_MODEL), D_FF),
    }


def reference(x, mem, positions, norm_ffn1, w_ffn1_in, w_ffn1_out, norm_mix, w_in, b_forget,
              moba_q_gain, moba_k_gain, fox_q_gain, fox_k_gain, norm_mem, w_mem_kv,
              mem_q_gain, mem_k_gain, pool_mix, pool_scale, w_branch, w_out,
              norm_ffn2, w_ffn2_in, w_ffn2_out):
    for l in range(DEPTH):
        x = x + 0.5 * swiglu(rms_norm(x, norm_ffn1[l]), w_ffn1_in[l], w_ffn1_out[l])
        x = x + hybrid_mixer(rms_norm(x, norm_mix[l]), mem, positions, w_in[l], b_forget[l],
                             moba_q_gain[l], moba_k_gain[l], fox_q_gain[l], fox_k_gain[l],
                             norm_mem[l], w_mem_kv[l], mem_q_gain[l], mem_k_gain[l],
                             pool_mix[l], pool_scale[l], w_branch[l], w_out[l])
        x = x + 0.5 * swiglu(rms_norm(x, norm_ffn2[l]), w_ffn2_in[l], w_ffn2_out[l])
    return x
```

```cpp
#include <hip/hip_runtime.h>
#include <hip/hip_cooperative_groups.h>
#include <hip/hip_bf16.h>
#include <cstdio>
#include <cstdint>
#include <cmath>
namespace cg = cooperative_groups;

__device__ __forceinline__ int tid_from_wave(int wave_s) { int l; asm volatile("v_mbcnt_lo_u32_b32 %0, -1, 0\n\tv_mbcnt_hi_u32_b32 %0, -1, %0" : "=v"(l)); return wave_s * 64 + l; }

template <int M> __device__ __forceinline__ float xor_lane(float v) {
    if constexpr (M < 32) { return __builtin_bit_cast(float, __builtin_amdgcn_ds_swizzle(__builtin_bit_cast(int, v), (M << 10) | 0x1f)); }
    else { const unsigned u = __builtin_bit_cast(unsigned, v); auto rr = __builtin_amdgcn_permlane32_swap(u, u, false, false); const unsigned a = rr[0], b = rr[1]; return __builtin_bit_cast(float, a == u ? b : a); }
}
__device__ __forceinline__ float sum_x32(float v) { const unsigned u = __builtin_bit_cast(unsigned, v); auto rr = __builtin_amdgcn_permlane32_swap(u, u, false, false); return __builtin_bit_cast(float, (unsigned)rr[0]) + __builtin_bit_cast(float, (unsigned)rr[1]); }
__device__ __forceinline__ float max_x32(float v) { const unsigned u = __builtin_bit_cast(unsigned, v); auto rr = __builtin_amdgcn_permlane32_swap(u, u, false, false); return __builtin_fmaxf(__builtin_bit_cast(float, (unsigned)rr[0]), __builtin_bit_cast(float, (unsigned)rr[1])); }

namespace pg8 {
#define PG8_LAS __attribute__((address_space(3)))
typedef unsigned short bf16_t;
typedef short bf16x8 __attribute__((ext_vector_type(8)));
typedef float f32x4 __attribute__((ext_vector_type(4)));
typedef unsigned u32x4 __attribute__((ext_vector_type(4)));
constexpr int BM = 256, BK = 64, HALF = 128, HTB = HALF * BK * 2  , STAGE_BYTES = 8 * HTB, NXCD = 8, WGM = 8;

__host__ __device__ __forceinline__ int lds_byte(int r, int c) { const int st = (r >> 4) * 2 + (c >> 5), rr = r & 15, cc = c & 31, ob = rr * 64 + cc * 2; return st * 1024 + (ob ^ (((ob >> 9) & 1) << 5)); }
__host__ __device__ __forceinline__ void stage_rc(int b, int& R, int& C) { const int st = b / 1024, sb = b % 1024, swz = sb ^ (((sb >> 9) & 1) << 5); R = (st >> 1) * 16 + swz / 64; C = (st & 1) * 32 + (swz % 64) / 2; }
__host__ __device__ __forceinline__ int perm32(int rho) { const int n = rho >> 4, i = rho & 15; return 8 * (i >> 2) + 4 * n + (i & 3); }

struct Unit { int pm, pn, z; };
struct Gemm { const bf16_t* A; const bf16_t* Bt; int M, N, K, lda, ldb; long azoff, bzoff; };

struct StaticOrder {
    int nM, nN, nwg, G, c, NZ;
    __host__ __device__ void init(int M, int N, int G_, int c_, int NZ_ = 1) { nM = M / BM; nN = N / BM; nwg = nM * nN; G = G_; c = c_; NZ = NZ_; }
    __host__ __device__ bool next(int i, Unit& u) const {
        const int zi = i % NZ, ii = i / NZ;
        const long L = (long)ii * G + c; if (L >= nwg) return false;
        int wgid = (int)L; { const int q = nwg / NXCD, r = nwg % NXCD, xcd = wgid % NXCD, off = wgid / NXCD; wgid = (xcd < r ? xcd * (q + 1) : r * (q + 1) + (xcd - r) * q) + off; }
        const int nig = WGM * nN, gid = wgid / nig, fm = gid * WGM, gsz = (nM - fm) < WGM ? (nM - fm) : WGM;
        u.pm = fm + ((wgid % nig) % gsz); u.pn = (wgid % nig) / gsz; u.z = zi; return true;
    }
    __device__ __forceinline__ void a_ready(const Unit&) const {}
    __device__ __forceinline__ void done(const Unit&) const {}
};

__device__ __forceinline__ unsigned cvt_pk_bf16(float lo, float hi) { unsigned r; asm volatile("v_cvt_pk_bf16_f32 %0, %1, %2" : "=v"(r) : "v"(lo), "v"(hi)); return r; }
__device__ __forceinline__ float bf_lo(unsigned w) { return __uint_as_float(w << 16); }
__device__ __forceinline__ float bf_hi(unsigned w) { return __uint_as_float(w & 0xffff0000u); }
__device__ __forceinline__ float sigm(float x) { return __builtin_amdgcn_rcpf(1.0f + __builtin_amdgcn_exp2f(-1.4426950408889634f * x)); }

struct EpiBf16 {
    static constexpr bool PERM = true, AFTER_DRAIN = false;
    bf16_t* O; int ldc;
    __device__ __forceinline__ void operator()(const f32x4 (&acc)[2][2][4][2], const Unit& u, int wr, int wc, int fr, int fq) const {
        const int row0 = u.pm * BM + wr * 64 + fr, col0 = u.pn * BM + wc * 32 + 8 * fq;
#pragma unroll
        for (int ai = 0; ai < 2; ++ai)
#pragma unroll
            for (int m = 0; m < 4; ++m) { bf16_t* rowp = O + (size_t)(row0 + ai * HALF + m * 16) * ldc + col0;
#pragma unroll
                for (int bj = 0; bj < 2; ++bj) { const f32x4 v0 = acc[ai][bj][m][0], v1 = acc[ai][bj][m][1];
                    u32x4 w; w.x = cvt_pk_bf16(v0[0], v0[1]); w.y = cvt_pk_bf16(v0[2], v0[3]); w.z = cvt_pk_bf16(v1[0], v1[1]); w.w = cvt_pk_bf16(v1[2], v1[3]);
                    *(u32x4*)(rowp + bj * HALF) = w; } }
    }
};
struct EpiSwiglu {
    static constexpr bool PERM = true, AFTER_DRAIN = false;
    bf16_t* O; int ldc;
    __device__ __forceinline__ void operator()(const f32x4 (&acc)[2][2][4][2], const Unit& u, int wr, int wc, int fr, int fq) const {
        const int row0 = u.pm * BM + wr * 64 + fr, col0 = u.pn * HALF + wc * 32 + 8 * fq;
#pragma unroll
        for (int ai = 0; ai < 2; ++ai)
#pragma unroll
            for (int m = 0; m < 4; ++m) { bf16_t* rowp = O + (size_t)(row0 + ai * HALF + m * 16) * ldc + col0;
                float r[8];
#pragma unroll
                for (int n = 0; n < 2; ++n)
#pragma unroll
                    for (int e = 0; e < 4; ++e) { const float g = acc[ai][0][m][n][e], uu = acc[ai][1][m][n][e]; r[n * 4 + e] = g * sigm(g) * uu; }
                u32x4 w; w.x = cvt_pk_bf16(r[0], r[1]); w.y = cvt_pk_bf16(r[2], r[3]); w.z = cvt_pk_bf16(r[4], r[5]); w.w = cvt_pk_bf16(r[6], r[7]);
                *(u32x4*)rowp = w; }
    }
};
struct EpiResid {
    static constexpr bool PERM = false, AFTER_DRAIN = false;
    const float* base; float* out; int ldc; float scale;
    __device__ __forceinline__ void operator()(const f32x4 (&acc)[2][2][4][2], const Unit& u, int wr, int wc, int fr, int fq) const {
        const int row0 = u.pm * BM + wr * 64 + fr, col0 = u.pn * BM + wc * 32 + 4 * fq;
#pragma unroll
        for (int ai = 0; ai < 2; ++ai)
#pragma unroll
            for (int m = 0; m < 4; ++m) { const size_t off = (size_t)(row0 + ai * HALF + m * 16) * ldc + col0;
#pragma unroll
                for (int bj = 0; bj < 2; ++bj)
#pragma unroll
                    for (int n = 0; n < 2; ++n) { const f32x4 bs = *(const f32x4*)(base + off + bj * HALF + n * 16); *(f32x4*)(out + off + bj * HALF + n * 16) = bs + acc[ai][bj][m][n] * scale; }
                asm volatile("" ::: "memory"); }
    }
};
struct EpiGate {
    static constexpr bool PERM = true, AFTER_DRAIN = false;
    bf16_t* Z; int ldz; const bf16_t* G; int ldg;
    __device__ __forceinline__ void operator()(const f32x4 (&acc)[2][2][4][2], const Unit& u, int wr, int wc, int fr, int fq) const {
        const int row0 = u.pm * BM + wr * 64 + fr, col0 = u.pn * BM + wc * 32 + 8 * fq;
#pragma unroll
        for (int ai = 0; ai < 2; ++ai)
#pragma unroll
            for (int m = 0; m < 4; ++m) { const size_t r = (size_t)(row0 + ai * HALF + m * 16);
#pragma unroll
                for (int bj = 0; bj < 2; ++bj) { const int c = col0 + bj * HALF;
                    const u32x4 gv = *(const u32x4*)(G + r * ldg + u.z * 1024 + c);
                    const f32x4 v0 = acc[ai][bj][m][0], v1 = acc[ai][bj][m][1];
                    float o[8];
                    o[0] = sigm(bf_lo(gv.x)) * v0[0]; o[1] = sigm(bf_hi(gv.x)) * v0[1]; o[2] = sigm(bf_lo(gv.y)) * v0[2]; o[3] = sigm(bf_hi(gv.y)) * v0[3];
                    o[4] = sigm(bf_lo(gv.z)) * v1[0]; o[5] = sigm(bf_hi(gv.z)) * v1[1]; o[6] = sigm(bf_lo(gv.w)) * v1[2]; o[7] = sigm(bf_hi(gv.w)) * v1[3];
                    bf16_t* zp = Z + r * ldz + c;
                    if (u.z > 0) { const u32x4 zv = *(const u32x4*)zp;
                        o[0] += bf_lo(zv.x); o[1] += bf_hi(zv.x); o[2] += bf_lo(zv.y); o[3] += bf_hi(zv.y); o[4] += bf_lo(zv.z); o[5] += bf_hi(zv.z); o[6] += bf_lo(zv.w); o[7] += bf_hi(zv.w); }
                    u32x4 w; w.x = cvt_pk_bf16(o[0], o[1]); w.y = cvt_pk_bf16(o[2], o[3]); w.z = cvt_pk_bf16(o[4], o[5]); w.w = cvt_pk_bf16(o[6], o[7]);
                    *(u32x4*)zp = w; }
                asm volatile("" ::: "memory"); }
    }
};

template <class Epi, class Sched, bool ALIGN_EPI = false, bool SP2 = false>
__device__ __forceinline__ void gemm_phase(PG8_LAS unsigned char* lds, const Gemm g, const Sched& S, const Epi& E, const int wave_s) {
    int tid_ = tid_from_wave(wave_s);
    const int tid = tid_, wid = __builtin_amdgcn_readfirstlane(tid >> 6), lane = tid & 63, wr = wid >> 2, wc = wid & 3, fr = lane & 15, fq = lane >> 4;
    const int K = g.K, nt = K / BK, lda = g.lda, ldb = g.ldb;
    unsigned voffA[2], voffB[2];
#pragma unroll
    for (int i = 0; i < 2; ++i) { int R, C; stage_rc(tid * 16 + i * 8192, R, C); const int Rb = Epi::PERM ? ((R & ~31) + perm32(R & 31)) : R;
        voffA[i] = (unsigned)(R * lda + C) * 2u; voffB[i] = (unsigned)(Rb * ldb + C) * 2u; }
    const size_t kstep = (size_t)(BK * 2);
    const size_t hstepA = (size_t)HALF * lda * 2, hstepB = (size_t)HALF * ldb * 2;
    const size_t tstepA = 2 * hstepA, tstepB = 2 * hstepB;
    const unsigned ldsw = (unsigned)wid * 1024u;
    const int aoff = lds_byte(wr * 64 + fr, fq * 8), boff = lds_byte(wc * 32 + fr, fq * 8);
#define PG8_SA(b, h) (((b) * 2 + (h)) * HTB)
#define PG8_SB(b, h) ((4 + (b) * 2 + (h)) * HTB)
#define PG8_STAGE(bufoff, gbase, voff) do { _Pragma("unroll") for (int _i = 0; _i < 2; ++_i) \
        __builtin_amdgcn_global_load_lds((const unsigned*)((const char*)(gbase) + (voff)[_i]), (PG8_LAS unsigned*)(lds + (bufoff) + ldsw + _i * 8192), 16, 0, 0); } while (0)
#define PG8_LDA(dst, b, h) do { _Pragma("unroll") for (int m = 0; m < 4; ++m) _Pragma("unroll") for (int k = 0; k < 2; ++k) dst[m][k] = *(const PG8_LAS bf16x8*)(lds + PG8_SA(b, h) + aoff + m * 2048 + k * 1024); } while (0)
#define PG8_LDB(dst, b, h) do { _Pragma("unroll") for (int n = 0; n < 2; ++n) _Pragma("unroll") for (int k = 0; k < 2; ++k) dst[n][k] = *(const PG8_LAS bf16x8*)(lds + PG8_SB(b, h) + boff + n * 2048 + k * 1024); } while (0)
#define PG8_MMA(ai, bj, At, Bt) do { __builtin_amdgcn_s_setprio(1); _Pragma("unroll") for (int m = 0; m < 4; ++m) _Pragma("unroll") for (int n = 0; n < 2; ++n) _Pragma("unroll") for (int k = 0; k < 2; ++k) \
        acc[ai][bj][m][n] = __builtin_amdgcn_mfma_f32_16x16x32_bf16(Bt[n][k], At[m][k], acc[ai][bj][m][n], 0, 0, 0); __builtin_amdgcn_s_setprio(0); } while (0)
#define PG8_WAIT_V(n) asm volatile("s_waitcnt vmcnt(" #n ")" ::: "memory")
#define PG8_WAIT_L(n) asm volatile("s_waitcnt lgkmcnt(" #n ")" ::: "memory")
#define PG8_BAR __builtin_amdgcn_s_barrier()
#define PG8_SCHED __builtin_amdgcn_sched_barrier(0)
    Unit cur, nxt; int ui = 0;
    if (!S.next(0, cur)) return;
    f32x4 acc[2][2][4][2];
#pragma unroll
    for (int a = 0; a < 2; ++a)
#pragma unroll
        for (int b = 0; b < 2; ++b)
#pragma unroll
            for (int m = 0; m < 4; ++m)
#pragma unroll
                for (int n = 0; n < 2; ++n) acc[a][b][m][n] = (f32x4){0.f, 0.f, 0.f, 0.f};
    bf16x8 At[4][2], B0[2][2], B1[2][2];
    const char* cA = (const char*)g.A + (size_t)cur.pm * tstepA + (size_t)cur.z * g.azoff * 2; const char* cB = (const char*)g.Bt + (size_t)cur.pn * tstepB + (size_t)cur.z * g.bzoff * 2;
    S.a_ready(cur);
    if constexpr (SP2) {
        PG8_STAGE(PG8_SB(0, 0), cB, voffB); PG8_STAGE(PG8_SB(0, 1), cB + hstepB, voffB); PG8_STAGE(PG8_SA(0, 0), cA, voffA); PG8_STAGE(PG8_SA(0, 1), cA + hstepA, voffA);
        if (wr == 1) PG8_BAR;
        PG8_WAIT_V(2); PG8_BAR;
        PG8_STAGE(PG8_SB(1, 0), cB + kstep, voffB); PG8_STAGE(PG8_SA(1, 0), cA + kstep, voffA); PG8_STAGE(PG8_SB(1, 1), cB + hstepB + kstep, voffB);
        PG8_WAIT_V(6); PG8_BAR;
    } else {
        PG8_STAGE(PG8_SB(0, 0), cB, voffB); PG8_STAGE(PG8_SA(0, 0), cA, voffA); PG8_STAGE(PG8_SB(0, 1), cB + hstepB, voffB); PG8_STAGE(PG8_SA(0, 1), cA + hstepA, voffA);
        if (wr == 1) PG8_BAR;
        PG8_WAIT_V(4); PG8_BAR;
        PG8_STAGE(PG8_SB(1, 0), cB + kstep, voffB); PG8_STAGE(PG8_SA(1, 0), cA + kstep, voffA); PG8_STAGE(PG8_SB(1, 1), cB + hstepB + kstep, voffB);
        PG8_WAIT_V(6); PG8_BAR;
    }
    for (;;) {
        const bool has_next = S.next(ui + 1, nxt);
        const char* nA = has_next ? (const char*)g.A + (size_t)nxt.pm * tstepA + (size_t)nxt.z * g.azoff * 2 : cA; const char* nB = has_next ? (const char*)g.Bt + (size_t)nxt.pn * tstepB + (size_t)nxt.z * g.bzoff * 2 : cB;
        for (int t = 0; t < nt; t += 2) {
            const bool last = (t == nt - 2);
            const char* a1 = cA + (size_t)(t + 1) * kstep;
            const char* a2 = last ? nA : cA + (size_t)(t + 2) * kstep; const char* b2 = last ? nB : cB + (size_t)(t + 2) * kstep;
            const char* a3 = a2 + kstep; const char* b3 = b2 + kstep;
            if (last && has_next) S.a_ready(nxt);
            if constexpr (SP2) {
            PG8_LDB(B0, 0, 0); PG8_LDB(B1, 0, 1); PG8_SCHED; PG8_LDA(At, 0, 0); PG8_STAGE(PG8_SA(1, 1), a1 + hstepA, voffA);
            PG8_WAIT_V(8); PG8_WAIT_L(0); PG8_BAR; PG8_MMA(0, 0, At, B0); PG8_MMA(0, 1, At, B1); PG8_BAR; PG8_SCHED;
            PG8_LDA(At, 0, 1); PG8_STAGE(PG8_SB(0, 0), b2, voffB); PG8_STAGE(PG8_SB(0, 1), b2 + hstepB, voffB); PG8_STAGE(PG8_SA(0, 0), a2, voffA);
            PG8_WAIT_V(8); PG8_WAIT_L(0); PG8_BAR; PG8_MMA(1, 0, At, B0); PG8_MMA(1, 1, At, B1); PG8_BAR; PG8_SCHED;
            PG8_LDB(B0, 1, 0); PG8_LDB(B1, 1, 1); PG8_SCHED; PG8_LDA(At, 1, 0); PG8_STAGE(PG8_SA(0, 1), a2 + hstepA, voffA);
            PG8_WAIT_V(8); PG8_WAIT_L(0); PG8_BAR; PG8_MMA(0, 0, At, B0); PG8_MMA(0, 1, At, B1); PG8_BAR; PG8_SCHED;
            PG8_LDA(At, 1, 1); PG8_STAGE(PG8_SB(1, 0), b3, voffB); PG8_STAGE(PG8_SB(1, 1), b3 + hstepB, voffB); PG8_STAGE(PG8_SA(1, 0), a3, voffA);
            PG8_WAIT_V(8); PG8_WAIT_L(0); PG8_BAR; PG8_MMA(1, 0, At, B0); PG8_MMA(1, 1, At, B1); PG8_BAR; PG8_SCHED;
            } else {
            PG8_LDB(B0, 0, 0); PG8_SCHED; PG8_LDA(At, 0, 0); PG8_STAGE(PG8_SA(1, 1), a1 + hstepA, voffA);
            PG8_WAIT_L(8); PG8_BAR; PG8_WAIT_L(0); PG8_MMA(0, 0, At, B0); PG8_BAR; PG8_SCHED;
            PG8_LDB(B1, 0, 1); PG8_STAGE(PG8_SB(0, 0), b2, voffB);
            PG8_BAR; PG8_WAIT_L(0); PG8_MMA(0, 1, At, B1); PG8_BAR;
            PG8_LDA(At, 0, 1); PG8_STAGE(PG8_SA(0, 0), a2, voffA);
            PG8_BAR; PG8_WAIT_L(0); PG8_MMA(1, 0, At, B0); PG8_BAR; PG8_SCHED;
            PG8_STAGE(PG8_SB(0, 1), b2 + hstepB, voffB);
            PG8_WAIT_V(6); PG8_BAR; PG8_MMA(1, 1, At, B1); PG8_BAR;
            PG8_LDB(B0, 1, 0); PG8_SCHED; PG8_LDA(At, 1, 0); PG8_STAGE(PG8_SA(0, 1), a2 + hstepA, voffA);
            PG8_WAIT_L(8); PG8_BAR; PG8_WAIT_L(0); PG8_MMA(0, 0, At, B0); PG8_BAR; PG8_SCHED;
            PG8_LDB(B1, 1, 1); PG8_STAGE(PG8_SB(1, 0), b3, voffB);
            PG8_BAR; PG8_WAIT_L(0); PG8_MMA(0, 1, At, B1); PG8_BAR;
            PG8_LDA(At, 1, 1); PG8_STAGE(PG8_SA(1, 0), a3, voffA);
            PG8_BAR; PG8_WAIT_L(0); PG8_MMA(1, 0, At, B0); PG8_BAR; PG8_SCHED;
            PG8_STAGE(PG8_SB(1, 1), b3 + hstepB, voffB);
            PG8_WAIT_V(6); PG8_BAR; PG8_MMA(1, 1, At, B1); PG8_BAR;
            }
        }
        if constexpr (ALIGN_EPI) { if (wr == 0) PG8_BAR; }
        if constexpr (!Epi::AFTER_DRAIN) { E(acc, cur, wr, wc, fr, fq); S.done(cur); }
        if (!has_next) break;
#pragma unroll
        for (int a = 0; a < 2; ++a)
#pragma unroll
            for (int b = 0; b < 2; ++b)
#pragma unroll
                for (int m = 0; m < 4; ++m)
#pragma unroll
                    for (int n = 0; n < 2; ++n) acc[a][b][m][n] = (f32x4){0.f, 0.f, 0.f, 0.f};
        cur = nxt; cA = nA; cB = nB; ++ui;
        if constexpr (ALIGN_EPI) { if (wr == 1) PG8_BAR; }
    }
    PG8_WAIT_V(0);
    if constexpr (!ALIGN_EPI) { if (wr == 0) PG8_BAR; }
    PG8_BAR;
    if constexpr (Epi::AFTER_DRAIN) { E.fused(acc, cur, wr, wc, fr, fq, lds, wid, lane); S.done(cur); }
#undef PG8_SA
#undef PG8_SB
#undef PG8_STAGE
#undef PG8_LDA
#undef PG8_LDB
#undef PG8_MMA
#undef PG8_WAIT_V
#undef PG8_WAIT_L
#undef PG8_BAR
#undef PG8_SCHED
}
}

namespace attn_body {
using bf16=__hip_bfloat16;
using bf16x8=__attribute__((ext_vector_type(8)))short;
using s16x4=__attribute__((ext_vector_type(4)))short;
using f32x16=__attribute__((ext_vector_type(16)))float;
using u32x4=__attribute__((ext_vector_type(4)))unsigned;
constexpr int SEQ=4096,D=64,DM=8192;
constexpr int NW=8,QBLK=32,QB=QBLK*NW,KVBLK=64,NQB=SEQ/QB;
constexpr int ATTN_PITCH=DM, ATTN_UNIT_ROWS=QB;
__device__ __forceinline__ int crow(int r,int hi){return (r&3)+8*(r>>2)+4*hi;}
#define SBAR() __builtin_amdgcn_sched_barrier(0)
__device__ __forceinline__ void cmask(f32x16&p0,f32x16&p1,int jb,int qrel,int hi){
  const float NEG=-INFINITY; int kb=64*jb+4*hi;
  #pragma unroll
  for(int r=0;r<16;++r){int kv=kb+(r&3)+8*(r>>2); if(kv>qrel)p0[r]=NEG; if(kv+32>qrel)p1[r]=NEG;}
}

constexpr int NSLOT=3, SLOTB=8192;
constexpr int LDS_K=0, LDS_V=NSLOT*SLOTB, LDS_WS=2*NSLOT*SLOTB, LDS_OST=LDS_WS+NW*64*4, LDS_BYTES=LDS_OST+NW*4096, LDS_AUX=86016;
constexpr float C2=0.125f*1.4426950408889634f;
__device__ __forceinline__ void glds16(const void*gsrc,unsigned lds_dst){unsigned keep;
  asm volatile("s_mov_b32 %0, m0\n\ts_mov_b32 m0, %2\n\ts_nop 0\n\tglobal_load_lds_dwordx4 %1, off\n\ts_mov_b32 m0, %0":"=&s"(keep):"v"(gsrc),"s"(lds_dst):"memory");}
__device__ __forceinline__ float max3f(float a,float b,float c){float r;asm("v_max3_f32 %0, %1, %2, %3":"=v"(r):"v"(a),"v"(b),"v"(c));return r;}
__device__ __forceinline__ float max2f(float a,float b){float r;asm("v_max_f32_e32 %0, %1, %2":"=v"(r):"v"(a),"v"(b));return r;}
__device__ __forceinline__ float fadd_s(float a,float b){float r;asm("v_add_f32_e32 %0, %1, %2":"=v"(r):"v"(a),"v"(b));return r;}
__device__ __forceinline__ float fsub_s(float a,float b){float r;asm("v_sub_f32_e32 %0, %1, %2":"=v"(r):"v"(a),"v"(b));return r;}
typedef float f32x4_t __attribute__((ext_vector_type(4))); typedef float f32x2_t __attribute__((ext_vector_type(2))); typedef __bf16 bf16x2_t __attribute__((ext_vector_type(2)));
__device__ __forceinline__ unsigned cvtpk_s(float lo,float hi){f32x2_t v={lo,hi};bf16x2_t b=__builtin_convertvector(v,bf16x2_t);return __builtin_bit_cast(unsigned,b);}
#define WAIT_BAR(N) asm volatile("s_waitcnt vmcnt(" #N ") lgkmcnt(0)\n\ts_barrier":::"memory")

__device__ __forceinline__ void qkt(f32x16&p0,f32x16&p1,const char*Kslot,const bf16x8*qr,const f32x16&negm,int r32,int hi){
  const char*kb=Kslot+hi*1024+r32*16;
  #pragma unroll
  for(int d0=0;d0<4;++d0){
    const bf16x8 b0=*reinterpret_cast<const bf16x8*>(kb+d0*2048);
    const bf16x8 b1=*reinterpret_cast<const bf16x8*>(kb+d0*2048+512);
    if(d0==0){p0=__builtin_amdgcn_mfma_f32_32x32x16_bf16(b0,qr[0],negm,0,0,0);p1=__builtin_amdgcn_mfma_f32_32x32x16_bf16(b1,qr[0],negm,0,0,0);}
    else{p0=__builtin_amdgcn_mfma_f32_32x32x16_bf16(b0,qr[d0],p0,0,0,0);p1=__builtin_amdgcn_mfma_f32_32x32x16_bf16(b1,qr[d0],p1,0,0,0);}}
}
typedef __attribute__((address_space(3))) const char* lds_cptr;
typedef short v4i16_t __attribute__((ext_vector_type(4)));
__device__ __forceinline__ void kload8(bf16x8*kf,lds_cptr kp){
  kf[0]=*(const __attribute__((address_space(3))) bf16x8*)(kp);      kf[1]=*(const __attribute__((address_space(3))) bf16x8*)(kp+512);
  kf[2]=*(const __attribute__((address_space(3))) bf16x8*)(kp+2048); kf[3]=*(const __attribute__((address_space(3))) bf16x8*)(kp+2560);
  kf[4]=*(const __attribute__((address_space(3))) bf16x8*)(kp+4096); kf[5]=*(const __attribute__((address_space(3))) bf16x8*)(kp+4608);
  kf[6]=*(const __attribute__((address_space(3))) bf16x8*)(kp+6144); kf[7]=*(const __attribute__((address_space(3))) bf16x8*)(kp+6656);
}
__device__ __forceinline__ void kload2(bf16x8*kf,lds_cptr kp,int j){ kf[2*j]=*(const __attribute__((address_space(3))) bf16x8*)(kp+j*2048); kf[2*j+1]=*(const __attribute__((address_space(3))) bf16x8*)(kp+j*2048+512); }
__device__ __forceinline__ s16x4 vtr(lds_cptr p){ return __builtin_bit_cast(s16x4,__builtin_amdgcn_ds_read_tr16_b64_v4i16((__attribute__((address_space(3))) v4i16_t*)p)); }
__device__ __forceinline__ float rowmax(const f32x16&p0,const f32x16&p1){
  float a=max3f(p0[0],p0[1],p1[0]),b=max3f(p0[2],p0[3],p1[1]);a=max3f(a,p1[2],p1[3]);
  #pragma unroll
  for(int r=4;r<16;r+=4){a=max3f(a,p0[r],p0[r+1]);b=max3f(b,p0[r+2],p0[r+3]);a=max3f(a,p1[r],p1[r+1]);b=max3f(b,p1[r+2],p1[r+3]);}
  const float m=max2f(a,b);
  auto rr=__builtin_amdgcn_permlane32_swap(__float_as_uint(m),__float_as_uint(m),false,false);
  return max2f(__uint_as_float(rr[0]),__uint_as_float(rr[1]));
}
__device__ __forceinline__ void pv(f32x16*o,int vb,bf16x8 pa0,bf16x8 pa1,bf16x8 pa2,bf16x8 pa3){
  #pragma unroll
  for(int d0=0;d0<2;++d0){s16x4 lo[4],hi[4];
    #pragma unroll
    for(int ks=0;ks<4;++ks){
      asm volatile("ds_read_b64_tr_b16 %0,%1 offset:%c2":"=&v"(lo[ks]):"v"(vb),"i"(d0*4096+ks*1024):"memory");
      asm volatile("ds_read_b64_tr_b16 %0,%1 offset:%c2":"=&v"(hi[ks]):"v"(vb),"i"(d0*4096+ks*1024+512):"memory");}
    asm volatile("s_waitcnt lgkmcnt(0)":::"memory");SBAR();
    #define PK(k) (bf16x8){lo[k][0],lo[k][1],lo[k][2],lo[k][3],hi[k][0],hi[k][1],hi[k][2],hi[k][3]}
    o[d0]=__builtin_amdgcn_mfma_f32_32x32x16_bf16(pa0,PK(0),o[d0],0,0,0);
    o[d0]=__builtin_amdgcn_mfma_f32_32x32x16_bf16(pa1,PK(1),o[d0],0,0,0);
    o[d0]=__builtin_amdgcn_mfma_f32_32x32x16_bf16(pa2,PK(2),o[d0],0,0,0);
    o[d0]=__builtin_amdgcn_mfma_f32_32x32x16_bf16(pa3,PK(3),o[d0],0,0,0);
    #undef PK
  }
}

#ifndef ATTN_STORE16
#define ATTN_STORE16(p,v) (*(u32x4*)(p)=(v))
#endif
typedef __attribute__((address_space(3))) float lds_f32; typedef __attribute__((address_space(3))) f32x4_t lds_f32x4;
template<int MODE,int THRL> __device__ __forceinline__ void attn_unit(int b,int h,int qb,const bf16*Q,const bf16*__restrict__ K,const bf16*__restrict__ V,bf16*O,const float*__restrict__ aux,char*shm,const int wave_s){
  const int tid=tid_from_wave(wave_s),lane=tid&63,r32=lane&31,hi=lane>>5; const int wid=wave_s;
  const long rowbase=(long)b*SEQ; const int q0=qb*QB;
  const bf16*Qw=Q+(rowbase+q0+wid*QBLK)*DM+h*D;
  const bf16*Kh=K+rowbase*DM+h*D,*Vh=V+rowbase*DM+h*D;
  const unsigned lds0=(unsigned)(uintptr_t)shm;
  float*wsf=(float*)(shm+LDS_WS)+wid*64;
  const bf16*ksrc=Kh+(long)lane*DM+wid*8;
  const bf16*vsrc=Vh+(long)(16*(wid&3)+(lane>>2))*DM+(wid>>2)*32+(lane&3)*8;
  const unsigned kdst=lds0+LDS_K+wid*1024, vdst=lds0+LDS_V+wid*1024;
  #define DMA_K(t,slot) glds16(ksrc+(long)(t)*KVBLK*DM,(unsigned)__builtin_amdgcn_readfirstlane(kdst+(slot)))
  #define DMA_V(t,slot) glds16(vsrc+(long)(t)*KVBLK*DM,(unsigned)__builtin_amdgcn_readfirstlane(vdst+(slot)))
  const int vb0=(int)(lds0+LDS_V)+((lane>>4)&1)*32+(lane&3)*8+(4*hi+((lane&15)>>2))*64;
  const char*Kbase=shm+LDS_K; bf16x8 kf[8];
  const lds_cptr shm3=(lds_cptr)shm; const lds_cptr kp0=shm3+LDS_K+hi*1024+r32*16; const lds_cptr vp0=shm3+LDS_V+((lane>>4)&1)*32+(lane&3)*8+(4*hi+((lane&15)>>2))*64;
  const int NT=(q0+QB)/KVBLK;
  lds_f32* auxl=(lds_f32*)(shm3+LDS_AUX);
  if(MODE==0){ for(int e=tid;e<qb*64;e+=512){ const int j=e>>6,dd=e&63; const float*p=aux+(size_t)((b*16+j)*4)*512+h*64+dd; auxl[e]=(p[0]+p[512])+(p[1024]+p[1536]); } }
  else { const float*p=aux+(size_t)(b*8+h)*SEQ; for(int e=tid*4;e<(qb+1)*256;e+=2048){ *(lds_f32x4*)(auxl+e)=*(const f32x4_t*)(p+e); } }
  asm volatile("s_waitcnt vmcnt(0) lgkmcnt(0)\n\ts_barrier":::"memory");
  DMA_K(0,0);DMA_V(0,0);DMA_K(1,SLOTB);
  bf16x8 qr[4];
  #pragma unroll
  for(int d0=0;d0<4;++d0)qr[d0]=*reinterpret_cast<const bf16x8*>(&Qw[(long)r32*DM+d0*16+hi*8]);
  float mhat=0.f,l_reg=0.f;f32x16 o[2];o[0]=f32x16{};o[1]=f32x16{};f32x16 negm=f32x16{};asm volatile("":"+v"(negm));
  const int qrel=wid*QBLK+r32;
  #define CMASK(P0,P1,t) do{int jb_=(t)-(NT-4); if(jb_>=0)cmask(P0,P1,jb_,qrel,hi);}while(0)
  bool resc=false;
  #define START(P0,P1) do{ const float rm=rowmax(P0,P1); resc=false; \
    { const float dl=__builtin_fmaxf(rm,-30.f); mhat=fadd_s(mhat,dl); \
      _Pragma("unroll") for(int r=0;r<16;++r){P0[r]=fsub_s(P0[r],dl);P1[r]=fsub_s(P1[r],dl);} \
      _Pragma("unroll") for(int r=0;r<16;++r)negm[r]=-mhat; asm volatile("":"+v"(negm)); } \
    _Pragma("unroll") for(int r=0;r<16;++r)P0[r]=__builtin_amdgcn_exp2f(P0[r]); }while(0)
  #define RESC() do{ if(resc){ asm volatile("s_waitcnt lgkmcnt(0)":::"memory"); \
      _Pragma("unroll") for(int d_=0;d_<2;++d_) _Pragma("unroll") for(int r=0;r<16;++r)o[d_][r]*=wsf[crow(r,hi)]; } }while(0)
  f32x16 pA0,pA1,pB0,pB1;
  int sl_prev=0,sl_cur=0,sl_next=SLOTB;
  #define ROT() do{sl_prev=sl_cur;sl_cur=sl_next;sl_next=(sl_next==(NSLOT-1)*SLOTB)?0:sl_next+SLOTB;}while(0)
  DMA_K(2,2*SLOTB);
  WAIT_BAR(3);
  unsigned sel=0u;
  if(MODE==0){ float v1=-3.0e38f,v2=-3.0e38f,v3=-3.0e38f; int i1=-1,i2=-1,i3=-1;
    for(int j=0;j<qb;++j){ const lds_f32* km=auxl+j*64+hi*8; float g=0.f;
      _Pragma("unroll") for(int d0=0;d0<4;++d0){ const f32x4_t a=*(const lds_f32x4*)(km+d0*16), c=*(const lds_f32x4*)(km+d0*16+4);
        g+=__uint_as_float((unsigned)(unsigned short)qr[d0][0]<<16)*a[0]; g+=__uint_as_float((unsigned)(unsigned short)qr[d0][1]<<16)*a[1]; g+=__uint_as_float((unsigned)(unsigned short)qr[d0][2]<<16)*a[2]; g+=__uint_as_float((unsigned)(unsigned short)qr[d0][3]<<16)*a[3];
        g+=__uint_as_float((unsigned)(unsigned short)qr[d0][4]<<16)*c[0]; g+=__uint_as_float((unsigned)(unsigned short)qr[d0][5]<<16)*c[1]; g+=__uint_as_float((unsigned)(unsigned short)qr[d0][6]<<16)*c[2]; g+=__uint_as_float((unsigned)(unsigned short)qr[d0][7]<<16)*c[3]; }
      g=sum_x32(g);
      if(g>v1){v3=v2;i3=i2;v2=v1;i2=i1;v1=g;i1=j;} else if(g>v2){v3=v2;i3=i2;v2=g;i2=j;} else if(g>v3){v3=g;i3=j;} }
    sel=(i1>=0?(1u<<i1):0u)|(i2>=0?(1u<<i2):0u)|(i3>=0?(1u<<i3):0u); }
  #define HOOK(P0,P1,t) do{ if(MODE==0){ const int j_=(t)>>2; if(j_<qb){ if(!((sel>>j_)&1u)){ _Pragma("unroll") for(int r=0;r<16;++r){P0[r]=-INFINITY;P1[r]=-INFINITY;} } } } \
    else { const lds_f32* bp_=auxl+64*(t)+4*hi; _Pragma("unroll") for(int g_=0;g_<4;++g_){ const f32x4_t b0_=*(const lds_f32x4*)(bp_+8*g_); const f32x4_t b1_=*(const lds_f32x4*)(bp_+32+8*g_); \
        P0[4*g_]+=b0_[0];P0[4*g_+1]+=b0_[1];P0[4*g_+2]+=b0_[2];P0[4*g_+3]+=b0_[3]; P1[4*g_]+=b1_[0];P1[4*g_+1]+=b1_[1];P1[4*g_+2]+=b1_[2];P1[4*g_+3]+=b1_[3]; } } }while(0)
  qkt(pA0,pA1,Kbase,qr,negm,r32,hi);asm volatile("s_nop 15\n\ts_nop 7":"+v"(pA0),"+v"(pA1));HOOK(pA0,pA1,0);CMASK(pA0,pA1,0);
  START(pA0,pA1);
  _Pragma("unroll") for(int r=0;r<16;++r)pA1[r]=__builtin_amdgcn_exp2f(pA1[r]);
  WAIT_BAR(0);
  DMA_K(3,0);DMA_V(1,SLOTB);
  ROT();
  kload8(kf,kp0+sl_cur);
  WAIT_BAR(2);
  s16x4 vlo[8],vhi[8]; u32x4 pw0,pw1,pw2,pw3;
  #define PKW(P,B) cvtpk_s(P[B],P[B+1])
  #define PAF(k) __builtin_bit_cast(bf16x8,pw##k)
  #define VFR(i) (bf16x8){vlo[i][0],vlo[i][1],vlo[i][2],vlo[i][3],vhi[i][0],vhi[i][1],vhi[i][2],vhi[i][3]}
  #define PIN(x) asm volatile("":"+v"(x))
  #define MX3(a,b,c) __builtin_fmaxf(__builtin_fmaxf((a),(b)),(c))
  #define GAPA(MF,A0,A1,A2,A3,W0,W1,PW) do{ MF; sacc+=A0; sacc+=A1; sacc+=A2; sacc+=A3; PIN(sacc); W0; W1; PIN(PW); SBAR(); }while(0)
  #define EX(v) __builtin_amdgcn_exp2f(v)
  #define GAPB(MF,X,B) do{ MF; X[B]=EX(X[B]); X[B+1]=EX(X[B+1]); X[B+2]=EX(X[B+2]); X[B+3]=EX(X[B+3]); PIN(X); SBAR(); }while(0)
  #define VRD(i) do{ vlo[i]=vtr(vp_+(((i)>>2)*4096+((i)&3)*1024)); vhi[i]=vtr(vp_+(((i)>>2)*4096+((i)&3)*1024+512)); }while(0)
  #define KRD(G,j) do{ if(G){ kload2(kf,kp0+sl_next,j); SBAR(); } }while(0)
  #define STEP(C0,C1,P0,P1,t,GK,GV,GL) do{ SBAR(); \
    const lds_cptr vp_=vp0+sl_prev; \
    VRD(0); SBAR(); float sacc=(P0[0]+P0[1]); \
    GAPA(C0=__builtin_amdgcn_mfma_f32_32x32x16_bf16(kf[0],qr[0],negm,0,0,0), P0[2],P0[3],P0[4],P0[5],     pw0[0]=PKW(P0,0), pw0[1]=PKW(P0,2), pw0); \
    VRD(4); SBAR(); GAPA(C1=__builtin_amdgcn_mfma_f32_32x32x16_bf16(kf[1],qr[0],negm,0,0,0), P0[6],P0[7],P0[8],P0[9],     pw0[2]=PKW(P0,4), pw0[3]=PKW(P0,6), pw0); \
    VRD(1); SBAR(); GAPA(C0=__builtin_amdgcn_mfma_f32_32x32x16_bf16(kf[2],qr[1],C0,0,0,0),   P0[10],P0[11],P0[12],P0[13], pw1[0]=PKW(P0,8), pw1[1]=PKW(P0,10), pw1); \
    VRD(5); SBAR(); GAPA(C1=__builtin_amdgcn_mfma_f32_32x32x16_bf16(kf[3],qr[1],C1,0,0,0),   P0[14],P0[15],P1[0],P1[1],   pw1[2]=PKW(P0,12),pw1[3]=PKW(P0,14), pw1); \
    VRD(2); SBAR(); GAPA(C0=__builtin_amdgcn_mfma_f32_32x32x16_bf16(kf[4],qr[2],C0,0,0,0),   P1[2],P1[3],P1[4],P1[5],     pw2[0]=PKW(P1,0), pw2[1]=PKW(P1,2), pw2); \
    VRD(6); SBAR(); GAPA(C1=__builtin_amdgcn_mfma_f32_32x32x16_bf16(kf[5],qr[2],C1,0,0,0),   P1[6],P1[7],P1[8],P1[9],     pw2[2]=PKW(P1,4), pw2[3]=PKW(P1,6), pw2); \
    VRD(3); SBAR(); GAPA(C0=__builtin_amdgcn_mfma_f32_32x32x16_bf16(kf[6],qr[3],C0,0,0,0),   P1[10],P1[11],P1[12],P1[13], pw3[0]=PKW(P1,8), pw3[1]=PKW(P1,10), pw3); \
    VRD(7); SBAR(); GAPA(C1=__builtin_amdgcn_mfma_f32_32x32x16_bf16(kf[7],qr[3],C1,0,0,0),   P1[14],P1[15],0.f,0.f,       pw3[2]=PKW(P1,12),pw3[3]=PKW(P1,14), pw3); \
    l_reg+=sacc; \
    if(GK){DMA_K((t)+3,sl_cur);} if(GV){DMA_V((t)+1,sl_next);} \
    HOOK(C0,C1,t); CMASK(C0,C1,t); \
    { float a=MX3(C0[0],C0[1],C1[0]),b=MX3(C0[2],C0[3],C1[1]); a=MX3(a,C1[2],C1[3]); \
      _Pragma("unroll") for(int r=4;r<16;r+=4){a=MX3(a,C0[r],C0[r+1]);b=MX3(b,C0[r+2],C0[r+3]);a=MX3(a,C1[r],C1[r+1]);b=MX3(b,C1[r+2],C1[r+3]);} \
      float rm=__builtin_fmaxf(a,b); { auto rr=__builtin_amdgcn_permlane32_swap(__float_as_uint(rm),__float_as_uint(rm),false,false); rm=__builtin_fmaxf(__uint_as_float(rr[0]),__uint_as_float(rr[1])); } \
      resc=false; \
      if(__builtin_expect(__any(rm>(float)THRL),0)){ const float dl=__builtin_fmaxf(rm,0.f); mhat+=dl; \
        _Pragma("unroll") for(int r=0;r<16;++r){C0[r]-=dl;C1[r]-=dl;} \
        _Pragma("unroll") for(int r=0;r<16;++r)negm[r]=-mhat; asm volatile("":"+v"(negm)); \
        const float f=__builtin_amdgcn_exp2f(-dl); l_reg*=f; if(hi==0)wsf[r32]=f; resc=true; } } \
    SBAR(); \
    GAPB(o[0]=__builtin_amdgcn_mfma_f32_32x32x16_bf16(PAF(0),VFR(0),o[0],0,0,0), C0,0); \
    GAPB(o[1]=__builtin_amdgcn_mfma_f32_32x32x16_bf16(PAF(0),VFR(4),o[1],0,0,0), C0,4); \
    KRD(GL,0); GAPB(o[0]=__builtin_amdgcn_mfma_f32_32x32x16_bf16(PAF(1),VFR(1),o[0],0,0,0), C0,8); \
    KRD(GL,1); GAPB(o[1]=__builtin_amdgcn_mfma_f32_32x32x16_bf16(PAF(1),VFR(5),o[1],0,0,0), C0,12); \
    KRD(GL,2); GAPB(o[0]=__builtin_amdgcn_mfma_f32_32x32x16_bf16(PAF(2),VFR(2),o[0],0,0,0), C1,0); \
    KRD(GL,3); GAPB(o[1]=__builtin_amdgcn_mfma_f32_32x32x16_bf16(PAF(2),VFR(6),o[1],0,0,0), C1,4); \
    GAPB(o[0]=__builtin_amdgcn_mfma_f32_32x32x16_bf16(PAF(3),VFR(3),o[0],0,0,0), C1,8); \
    GAPB(o[1]=__builtin_amdgcn_mfma_f32_32x32x16_bf16(PAF(3),VFR(7),o[1],0,0,0), C1,12); \
    }while(0)
  int t=1;
  #undef CMASK
  #define CMASK(P0,P1,t) do{}while(0)
  for(;t+5<NT;t+=2){
    STEP(pB0,pB1,pA0,pA1,t,true,true,true);     WAIT_BAR(2); RESC(); ROT();
    STEP(pA0,pA1,pB0,pB1,t+1,true,true,true);   WAIT_BAR(2); RESC(); ROT();
  }
  #undef CMASK
  #define CMASK(P0,P1,t) do{int jb_=(t)-(NT-4); if(jb_>=0)cmask(P0,P1,jb_,qrel,hi);}while(0)
  #define ENDW(tt) do{ if((tt)+3<NT){WAIT_BAR(2);} else if((tt)+2<NT){WAIT_BAR(1);} else {WAIT_BAR(0);} }while(0)
  for(;t+1<NT;t+=2){
    STEP(pB0,pB1,pA0,pA1,t,(t+3<NT),(t+1<NT),(t+1<NT));       ENDW(t);   RESC(); ROT();
    STEP(pA0,pA1,pB0,pB1,t+1,(t+4<NT),(t+2<NT),(t+2<NT));     ENDW(t+1); RESC(); ROT();
  }
  STEP(pB0,pB1,pA0,pA1,NT-1,false,false,false); RESC();
  { float sacc=pB0[0]+pB0[1]; _Pragma("unroll") for(int r=2;r<16;++r)sacc+=pB0[r]; _Pragma("unroll") for(int r=0;r<16;++r)sacc+=pB1[r]; l_reg+=sacc;
    pw0=(u32x4){PKW(pB0,0),PKW(pB0,2),PKW(pB0,4),PKW(pB0,6)};pw1=(u32x4){PKW(pB0,8),PKW(pB0,10),PKW(pB0,12),PKW(pB0,14)};pw2=(u32x4){PKW(pB1,0),PKW(pB1,2),PKW(pB1,4),PKW(pB1,6)};pw3=(u32x4){PKW(pB1,8),PKW(pB1,10),PKW(pB1,12),PKW(pB1,14)};
    SBAR(); pv(o,vb0+sl_cur,PAF(0),PAF(1),PAF(2),PAF(3)); }
  #undef PKW
  #undef PAF
  #undef VFR
  #undef PIN
  #undef MX3
  #undef GAPA
  #undef GAPB
  #undef EX
  #undef VRD
  #undef KRD
  #undef STEP
  #undef ENDW
  {auto rr=__builtin_amdgcn_permlane32_swap(__float_as_uint(l_reg),__float_as_uint(l_reg),false,false);l_reg=__uint_as_float(rr[0])+__uint_as_float(rr[1]);}
  if(hi==0)wsf[32+r32]=l_reg;asm volatile("s_waitcnt lgkmcnt(0)":::"memory");
  float rli[16];
  #pragma unroll
  for(int r=0;r<16;++r)rli[r]=__builtin_amdgcn_rcpf(wsf[32+crow(r,hi)]);
  bf16*Ow=O+(rowbase+q0+wid*QBLK)*DM+h*D;
  { bf16*stg=(bf16*)(shm+LDS_OST)+wid*2048;
    #pragma unroll
    for(int r=0;r<16;++r){const int orow=crow(r,hi);
      #pragma unroll
      for(int d0=0;d0<2;++d0)stg[orow*64+d0*32+r32]=__float2bfloat16(o[d0][r]*rli[r]);}
    asm volatile("s_waitcnt lgkmcnt(0)":::"memory");
    #pragma unroll
    for(int i=0;i<4;++i){const int row=i*8+(lane>>3),ch=lane&7; const u32x4 v=*(const u32x4*)(stg+row*64+ch*8); ATTN_STORE16(Ow+(long)row*DM+ch*8,v);} }
  asm volatile("s_waitcnt lgkmcnt(0)\n\ts_barrier":::"memory");
  #undef DMA_K
  #undef DMA_V
  #undef CMASK
  #undef HOOK
  #undef START
  #undef RESC
  #undef ROT
}
#undef SBAR
#undef WAIT_BAR
}

namespace attn_body {
#define SBAR() __builtin_amdgcn_sched_barrier(0)
__device__ __forceinline__ void mem_unit(int brow,int bglob,int h,int qb,bf16*QO,const bf16*__restrict__ MK,char*shm,const int wave_s){
  const int tid=tid_from_wave(wave_s),lane=tid&63,r32=lane&31,hi=lane>>5; const int wid=wave_s;
  const lds_cptr shm3=(lds_cptr)shm; const unsigned lds0=(unsigned)(uintptr_t)shm;
  typedef __attribute__((address_space(3))) u32x4 lds_u32x4;
  const bf16*kg=MK+(size_t)(bglob*256)*2048+h*128; const bf16*vg=kg+512;
  {
    const bf16*kp=kg+(size_t)(tid&255)*2048+(tid>>8)*8; const lds_cptr kl=shm3+((tid&255)>>6)*16384+(tid>>8)*1024+(tid&63)*16;
    const bf16*vp=vg+(size_t)(tid>>2)*2048+(tid&3)*8; const lds_cptr vl=shm3+65536+((tid>>2)>>6)*16384+((tid>>2)&63)*64+(tid&3)*16;
    #pragma unroll 2
    for(int i=0;i<8;i+=4){ u32x4 t0=*(const u32x4*)(kp+(i+0)*16),t1=*(const u32x4*)(kp+(i+1)*16),t2=*(const u32x4*)(kp+(i+2)*16),t3=*(const u32x4*)(kp+(i+3)*16);
      *(lds_u32x4*)(kl+(i+0)*2048)=t0; *(lds_u32x4*)(kl+(i+1)*2048)=t1; *(lds_u32x4*)(kl+(i+2)*2048)=t2; *(lds_u32x4*)(kl+(i+3)*2048)=t3; }
    #pragma unroll 2
    for(int i=0;i<8;i+=2){ u32x4 t0=*(const u32x4*)(vp+(i>>1)*32),t1=*(const u32x4*)(vp+(size_t)128*2048+(i>>1)*32);
      *(lds_u32x4*)(vl+(i>>1)*4096)=t0; *(lds_u32x4*)(vl+32768+(i>>1)*4096)=t1; } }
  bf16*Qw=QO+(size_t)(brow+qb*256+wid*32)*DM+h*128;
  bf16x8 qr[8];
  #pragma unroll
  for(int d0=0;d0<8;++d0)qr[d0]=*reinterpret_cast<const bf16x8*>(&Qw[(size_t)r32*DM+d0*16+hi*8]);
  asm volatile("s_waitcnt vmcnt(0) lgkmcnt(0)\n\ts_barrier":::"memory");
  lds_f32* wsf=(lds_f32*)(shm3+131072)+wid*64;
  float m=-INFINITY,l_reg=0.f; f32x16 o[4]; o[0]=f32x16{};o[1]=f32x16{};o[2]=f32x16{};o[3]=f32x16{};
  const int vbl=((lane>>4)&1)*32+(lane&3)*8+(4*hi+((lane&15)>>2))*64;
  #pragma unroll 1
  for(int kt=0;kt<4;++kt){
    f32x16 p0=f32x16{},p1=f32x16{};
    const lds_cptr kb=shm3+kt*16384+hi*1024+r32*16;
    #pragma unroll
    for(int d0=0;d0<8;++d0){
      const bf16x8 b0=*(const __attribute__((address_space(3))) bf16x8*)(kb+d0*2048);
      const bf16x8 b1=*(const __attribute__((address_space(3))) bf16x8*)(kb+d0*2048+512);
      p0=__builtin_amdgcn_mfma_f32_32x32x16_bf16(b0,qr[d0],p0,0,0,0); p1=__builtin_amdgcn_mfma_f32_32x32x16_bf16(b1,qr[d0],p1,0,0,0); }
    float rm=p0[0];
    #pragma unroll
    for(int r=0;r<16;++r){rm=__builtin_fmaxf(rm,p0[r]);rm=__builtin_fmaxf(rm,p1[r]);}
    rm=max_x32(rm);
    const float mn=__builtin_fmaxf(m,rm); const float alpha=__builtin_amdgcn_exp2f(m-mn); m=mn;
    float sacc=0.f;
    #pragma unroll
    for(int r=0;r<16;++r){p0[r]=__builtin_amdgcn_exp2f(p0[r]-mn);p1[r]=__builtin_amdgcn_exp2f(p1[r]-mn);sacc+=p0[r]+p1[r];}
    l_reg=l_reg*alpha+sacc;
    if(hi==0)wsf[r32]=alpha;
    asm volatile("s_waitcnt lgkmcnt(0)":::"memory");
    #pragma unroll
    for(int r=0;r<16;++r){ const float a=wsf[crow(r,hi)]; o[0][r]*=a;o[1][r]*=a;o[2][r]*=a;o[3][r]*=a; }
    u32x4 pw0,pw1,pw2,pw3;
    pw0=(u32x4){cvtpk_s(p0[0],p0[1]),cvtpk_s(p0[2],p0[3]),cvtpk_s(p0[4],p0[5]),cvtpk_s(p0[6],p0[7])};
    pw1=(u32x4){cvtpk_s(p0[8],p0[9]),cvtpk_s(p0[10],p0[11]),cvtpk_s(p0[12],p0[13]),cvtpk_s(p0[14],p0[15])};
    pw2=(u32x4){cvtpk_s(p1[0],p1[1]),cvtpk_s(p1[2],p1[3]),cvtpk_s(p1[4],p1[5]),cvtpk_s(p1[6],p1[7])};
    pw3=(u32x4){cvtpk_s(p1[8],p1[9]),cvtpk_s(p1[10],p1[11]),cvtpk_s(p1[12],p1[13]),cvtpk_s(p1[14],p1[15])};
    const int vb=(int)(lds0+65536+kt*16384)+vbl;
    SBAR(); pv(o,vb,__builtin_bit_cast(bf16x8,pw0),__builtin_bit_cast(bf16x8,pw1),__builtin_bit_cast(bf16x8,pw2),__builtin_bit_cast(bf16x8,pw3));
    pv(o+2,vb+8192,__builtin_bit_cast(bf16x8,pw0),__builtin_bit_cast(bf16x8,pw1),__builtin_bit_cast(bf16x8,pw2),__builtin_bit_cast(bf16x8,pw3));
    asm volatile("s_waitcnt lgkmcnt(0)":::"memory");
  }
  l_reg=sum_x32(l_reg);
  if(hi==0)wsf[32+r32]=l_reg; asm volatile("s_waitcnt lgkmcnt(0)":::"memory");
  asm volatile("s_waitcnt lgkmcnt(0)\n\ts_barrier":::"memory");
  { typedef __attribute__((address_space(3))) unsigned short lds_u16;
    lds_u16* stg=(lds_u16*)(shm3+wid*8192);
    #pragma unroll
    for(int r=0;r<16;++r){ const float rl=__builtin_amdgcn_rcpf(wsf[32+crow(r,hi)]); const int orow=crow(r,hi);
      #pragma unroll
      for(int db=0;db<4;++db){ const unsigned w=cvtpk_s(o[db][r]*rl,0.f); stg[orow*128+db*32+r32]=(unsigned short)w; } }
    asm volatile("s_waitcnt lgkmcnt(0)":::"memory");
    #pragma unroll
    for(int i=0;i<8;++i){ const int row=i*4+(lane>>4),ch=lane&15; const u32x4 v=*(const lds_u32x4*)(shm3+wid*8192+row*256+ch*16); *(u32x4*)(Qw+(size_t)row*DM+ch*8)=v; } }
  asm volatile("s_waitcnt lgkmcnt(0)\n\ts_barrier":::"memory");
}
#undef SBAR
}

constexpr int NWAVES = 8;
constexpr int TOK = 32768, DMOD = 1024, FF = 2816, HTOK = 16384, SEQL = 4096, PP = 8192, DIN = 8200, NLAYER = 2;
constexpr int C_QA = 0, C_PU = 512, C_QC = 1024, C_MQ = 1536, C_KA = 2048, C_VA = 2560, C_KC = 3072, C_VC = 3584, C_GATE = 4096;
constexpr float RMS_EPS = 1e-6f;
constexpr float LOG2E = 1.4426950408889634f;
constexpr float C2_64 = 0.125f * LOG2E, C2_128 = 0.08838834764831845f * LOG2E;
constexpr size_t MiB = 1u << 20;
constexpr size_t WS_FOXF = 1 * MiB, WS_CK2 = 2 * MiB, WS_KMEAN = 3 * MiB, WS_MEMN = 4 * MiB, WS_MEMKV = 8 * MiB, WS_POOLED = 16 * MiB, WS_H = 32 * MiB, WS_W = 96 * MiB,
                 WS_PROJ = 216 * MiB, WS_Z = 472 * MiB, WS_END = 504 * MiB;
constexpr size_t E_FFN_IN = (size_t)2 * FF * DMOD, E_FFN_OUT = (size_t)DMOD * FF, E_WIN = (size_t)8192 * DMOD, E_WBR = (size_t)4 * DMOD * 512, E_WOUT = (size_t)DMOD * DMOD, E_WPOOL = (size_t)512 * 512;
constexpr size_t O_FFN1_IN = 0, O_FFN1_OUT = O_FFN1_IN + E_FFN_IN, O_WIN = O_FFN1_OUT + E_FFN_OUT, O_WBR = O_WIN + E_WIN, O_WOUT = O_WBR + E_WBR, O_WPOOL = O_WOUT + E_WOUT,
                 O_FFN2_IN = O_WPOOL + E_WPOOL, O_FFN2_OUT = O_FFN2_IN + E_FFN_IN, E_LAYER = O_FFN2_OUT + E_FFN_OUT, O_WMEM = NLAYER * E_LAYER, E_WTOTAL = O_WMEM + (size_t)2048 * 1024;
static_assert(E_WTOTAL * 2 <= 120 * MiB, "weights fit");
constexpr int RING_BYTES = 131072, LDS_BYTES = 147456;

#define LAS __attribute__((address_space(3)))
typedef unsigned short bf16;
typedef unsigned v4u __attribute__((ext_vector_type(4)));
typedef float f32x4 __attribute__((ext_vector_type(4)));
#define LDS_WAIT() asm volatile("s_waitcnt lgkmcnt(0)" ::: "memory")
__device__ __forceinline__ unsigned pk2(float lo, float hi) { return pg8::cvt_pk_bf16(lo, hi); }
__device__ __forceinline__ float wave_sum(float v) {
    v += xor_lane<1>(v); v += xor_lane<2>(v); v += xor_lane<4>(v); v += xor_lane<8>(v); v += xor_lane<16>(v); v = sum_x32(v);
    return v;
}
__device__ __forceinline__ void ld8(const bf16* p, float (&v)[8]) { const v4u w = *(const v4u*)p;
    v[0] = pg8::bf_lo(w.x); v[1] = pg8::bf_hi(w.x); v[2] = pg8::bf_lo(w.y); v[3] = pg8::bf_hi(w.y); v[4] = pg8::bf_lo(w.z); v[5] = pg8::bf_hi(w.z); v[6] = pg8::bf_lo(w.w); v[7] = pg8::bf_hi(w.w); }
__device__ __forceinline__ void st8(bf16* p, const float (&v)[8]) { v4u w; w.x = pk2(v[0], v[1]); w.y = pk2(v[2], v[3]); w.z = pk2(v[4], v[5]); w.w = pk2(v[6], v[7]); *(v4u*)p = w; }

__device__ __forceinline__ void tr_item(const float* W, int ldw, int srccol0, int k0, bf16* WT, int ldk, int dstrow0, const float* kscale, LAS float* scr, int lane) {
#pragma unroll 8
    for (int i = 0; i < 32; ++i) { const int kk = 2 * i + (lane >> 5); float v = W[(size_t)(k0 + kk) * ldw + srccol0 + (lane & 31)]; if (kscale) v *= kscale[k0 + kk]; scr[kk * 33 + (lane & 31)] = v; }
    LDS_WAIT(); asm volatile("" ::: "memory");
    const int c = lane & 7;
#pragma unroll
    for (int j = 0; j < 4; ++j) { const int n = (lane >> 3) + 8 * j; const LAS float* s = scr + (8 * c) * 33 + n;
        v4u o; o.x = pk2(s[0 * 33], s[1 * 33]); o.y = pk2(s[2 * 33], s[3 * 33]); o.z = pk2(s[4 * 33], s[5 * 33]); o.w = pk2(s[6 * 33], s[7 * 33]);
        *(v4u*)(WT + (size_t)(dstrow0 + n) * ldk + k0 + 8 * c) = o; }
    LDS_WAIT(); asm volatile("" ::: "memory");
}

template <bool FOX> __device__ __forceinline__ void norm_rows(const float* x, const float* gain, bf16* H, int nrows, const float* w_in_l, float* foxf, int gw, int NGW, int lane) {
    f32x4 gv[4];
#pragma unroll
    for (int j = 0; j < 4; ++j) gv[j] = gain ? *((const f32x4*)gain + lane + 64 * j) : (f32x4){1.f, 1.f, 1.f, 1.f};
    f32x4 wf[FOX ? 16 : 1][2];
    if (FOX) {
#pragma unroll
        for (int j = 0; j < 4; ++j)
#pragma unroll
            for (int c = 0; c < 4; ++c) { const float* p = w_in_l + (size_t)(256 * j + 4 * lane + c) * DIN + 3072; wf[j * 4 + c][0] = *(const f32x4*)p; wf[j * 4 + c][1] = *(const f32x4*)(p + 4); }
    }
    for (int m = gw; m < nrows; m += NGW) {
        const f32x4* xr = (const f32x4*)(x + (size_t)m * DMOD) + lane;
        f32x4 v[4]; float s2 = 0.f;
#pragma unroll
        for (int j = 0; j < 4; ++j) { v[j] = xr[64 * j]; s2 += (v[j].x * v[j].x + v[j].y * v[j].y) + (v[j].z * v[j].z + v[j].w * v[j].w); }
        const float rstd = 1.0f / sqrtf(wave_sum(s2) * (1.f / DMOD) + RMS_EPS);
        unsigned long long* o8 = (unsigned long long*)(H + (size_t)m * DMOD) + lane;
#pragma unroll
        for (int j = 0; j < 4; ++j) { v[j] = v[j] * rstd * gv[j]; o8[64 * j] = (unsigned long long)pk2(v[j].x, v[j].y) | ((unsigned long long)pk2(v[j].z, v[j].w) << 32); }
        if (FOX) {
            float acc[8];
#pragma unroll
            for (int h = 0; h < 8; ++h) acc[h] = 0.f;
#pragma unroll
            for (int j = 0; j < 4; ++j)
#pragma unroll
                for (int c = 0; c < 4; ++c) { const float hv = v[j][c];
#pragma unroll
                    for (int h = 0; h < 4; ++h) { acc[h] += hv * wf[j * 4 + c][0][h]; acc[4 + h] += hv * wf[j * 4 + c][1][h]; } }
#pragma unroll
            for (int h = 0; h < 8; ++h) acc[h] = wave_sum(acc[h]);
            if (lane == 0) { *(f32x4*)(foxf + (size_t)m * 8) = (f32x4){acc[0], acc[1], acc[2], acc[3]}; *(f32x4*)(foxf + (size_t)m * 8 + 4) = (f32x4){acc[4], acc[5], acc[6], acc[7]}; }
        }
    }
}

template <int GL> __device__ __forceinline__ void gnorm8(float (&v)[8], const float (&g)[8], float scale) {
    float ss = 0.f;
#pragma unroll
    for (int i = 0; i < 8; ++i) ss += v[i] * v[i];
    ss += xor_lane<1>(ss); ss += xor_lane<2>(ss); ss += xor_lane<4>(ss); if (GL > 8) ss += xor_lane<8>(ss);
    const float r = scale / sqrtf(ss * (1.0f / (8 * GL)) + RMS_EPS);
#pragma unroll
    for (int i = 0; i < 8; ++i) v[i] = v[i] * r * g[i];
}
__device__ __forceinline__ void rot8(float (&v)[8], const float (&cc)[8], const float (&sn)[8], int li) {
    float oth[8];
#pragma unroll
    for (int i = 0; i < 8; ++i) oth[i] = xor_lane<1>(v[i]);
    if (li == 0) {
#pragma unroll
        for (int i = 0; i < 8; ++i) v[i] = v[i] * cc[i] - oth[i] * sn[i];
    } else if (li == 1) {
#pragma unroll
        for (int i = 0; i < 8; ++i) v[i] = v[i] * cc[i] + oth[i] * sn[i];
    }
}

__device__ __forceinline__ float logsig(float x) { return fminf(x, 0.f) - 0.6931471805599453f * __builtin_amdgcn_logf(1.0f + __builtin_amdgcn_exp2f(-1.4426950408889634f * fabsf(x))); }
struct Args { const float* in[24]; float* out; unsigned char* ws; };

__global__ void __launch_bounds__(NWAVES * 64, 2) hybrid_fwd(Args args) {
    extern __shared__ __attribute__((aligned(16))) unsigned char lds[];
    cg::grid_group grid = cg::this_grid();
    LAS unsigned char* ldsl = (LAS unsigned char*)lds;
    const int G = gridDim.x, bx = blockIdx.x;
    const int vcu = (G % 8 == 0) ? (bx % 8) * (G / 8) + bx / 8 : bx;
    const int NGW = G * NWAVES;
    const int wave_s = __builtin_amdgcn_readfirstlane((int)threadIdx.x >> 6);
#define LANE_STATE() const int tid = tid_from_wave(wave_s), lane = tid & 63, wave = wave_s, gw = vcu * NWAVES + wave; (void)tid; (void)lane; (void)gw
    unsigned char* ws = args.ws;
    const float* x_in = args.in[0]; const float* mem = args.in[1]; const int* positions = (const int*)args.in[2];
    float* xout = args.out;
    float* FOXF = (float*)(ws + WS_FOXF); float* CK2 = (float*)(ws + WS_CK2); float* KMEAN = (float*)(ws + WS_KMEAN);
    bf16* MEMN = (bf16*)(ws + WS_MEMN); bf16* MEMKV = (bf16*)(ws + WS_MEMKV); bf16* POOLED = (bf16*)(ws + WS_POOLED);
    bf16* H = (bf16*)(ws + WS_H); bf16* WB = (bf16*)(ws + WS_W); bf16* PROJ = (bf16*)(ws + WS_PROJ); bf16* HID = PROJ; bf16* Z = (bf16*)(ws + WS_Z);

    {
        LANE_STATE();
        LAS float* scr = (LAS float*)(ldsl + wave * 16384);
        constexpr int I_FI = 16 * 176, I_FO = 44 * 32, I_WI = 16 * 256, I_BR = 4 * 8 * 32, I_WO = 16 * 32, I_MEM = 16 * 32;
        constexpr int I_LAYER = 2 * I_FI + 2 * I_FO + I_WI + I_BR + I_WO + I_MEM;
        for (int it = gw; it < NLAYER * I_LAYER; it += NGW) {
            const int l = it / I_LAYER; int r = it % I_LAYER; bf16* WL = WB + (size_t)l * E_LAYER;
            if (r < 2 * I_FI) { const int which = r / I_FI; r %= I_FI; const float* W = args.in[which ? 22 : 4] + (size_t)l * DMOD * 2 * FF;
                const int kb = r / 176, nb = r % 176, n0 = 32 * nb, isu = n0 / FF, j = n0 % FF;
                tr_item(W, 2 * FF, n0, 64 * kb, WL + (which ? O_FFN2_IN : O_FFN1_IN), DMOD, 256 * (j / 128) + 128 * isu + (j % 128), nullptr, scr, lane); continue; }
            r -= 2 * I_FI;
            if (r < 2 * I_FO) { const int which = r / I_FO; r %= I_FO; const float* W = args.in[which ? 23 : 5] + (size_t)l * FF * DMOD;
                const int kb = r / 32, nb = r % 32;
                tr_item(W, DMOD, 32 * nb, 64 * kb, WL + (which ? O_FFN2_OUT : O_FFN1_OUT), FF, 32 * nb, nullptr, scr, lane); continue; }
            r -= 2 * I_FO;
            if (r < I_WI) { const float* W = args.in[7] + (size_t)l * DMOD * DIN; const int kb = r / 256, nb = r % 256, n0 = 32 * nb;
                int src;
                if (n0 >= 4096) src = n0 + 8; else { const int sec = n0 >> 9, o = n0 & 511;
                    const int sb = sec == 0 ? 0 : sec == 1 ? 3080 : sec == 2 ? 1536 : sec == 3 ? 3592 : sec == 4 ? 512 : sec == 5 ? 1024 : sec == 6 ? 2048 : 2560; src = sb + o; }
                tr_item(W, DIN, src, 64 * kb, WL + O_WIN, DMOD, n0, nullptr, scr, lane); continue; }
            r -= I_WI;
            if (r < I_BR) { const int br = r / 256; r %= 256; const float* W = args.in[19] + ((size_t)l * 4 + br) * 512 * DMOD; const int kb = r / 32, nb = r % 32;
                tr_item(W, DMOD, 32 * nb, 64 * kb, WL + O_WBR + (size_t)br * DMOD * 512, 512, 32 * nb, nullptr, scr, lane); continue; }
            r -= I_BR;
            if (r < I_WO) { const float* W = args.in[20] + (size_t)l * DMOD * DMOD; const int kb = r / 32, nb = r % 32;
                tr_item(W, DMOD, 32 * nb, 64 * kb, WL + O_WOUT, DMOD, 32 * nb, nullptr, scr, lane); continue; }
            r -= I_WO;
            { const float* W = args.in[14] + (size_t)l * DMOD * 1024; const int kb = r / 32, nb = r % 32;
                tr_item(W, 1024, 32 * nb, 64 * kb, WB + O_WMEM, DMOD, l * 1024 + 32 * nb, args.in[13] + l * DMOD, scr, lane); }
        }
        for (int e = gw * 64 + lane; e < NLAYER * 512 * 64; e += NGW * 64) {
            const int l = e / (512 * 64), r = e % (512 * 64), n = r / 64, k8 = (r % 64) * 8, g = n >> 7;
            float v[8];
            if ((k8 >> 7) == g) { const float* mp = args.in[17] + (((size_t)l * 4 + g) * 128 + (k8 & 127)) * 128 + (n & 127); const float sc = args.in[18][l * 512 + n];
#pragma unroll
                for (int i = 0; i < 8; ++i) v[i] = mp[i * 128] * sc;
            } else {
#pragma unroll
                for (int i = 0; i < 8; ++i) v[i] = 0.f;
            }
            st8(WB + (size_t)l * E_LAYER + O_WPOOL + (size_t)n * 512 + k8, v);
        }
        norm_rows<false>(mem, nullptr, MEMN, 2048, nullptr, nullptr, gw, NGW, lane);
        norm_rows<false>(x_in, args.in[3], H, TOK, nullptr, nullptr, gw, NGW, lane);
    }
    grid.sync();

    for (int st = 0; st < 3 * NLAYER; ++st) {
        const int l = st / 3, kind = st % 3;
        bf16* WL = WB + (size_t)l * E_LAYER;
        if (kind != 1) {
            const bool second = (kind == 2);
            const float* xsrc = (st == 0) ? x_in : xout;
            if (st != 0) { LANE_STATE(); norm_rows<false>(xsrc, args.in[second ? 21 : 3] + l * DMOD, H, TOK, nullptr, nullptr, gw, NGW, lane); grid.sync(); }
            { pg8::Gemm g{H, WL + (second ? O_FFN2_IN : O_FFN1_IN), TOK, 2 * FF, DMOD, DMOD, DMOD, 0, 0}; pg8::StaticOrder S; S.init(TOK, 2 * FF, G, bx);
              pg8::EpiSwiglu E{HID, FF};

#ifndef NO_G0
              pg8::gemm_phase<pg8::EpiSwiglu, pg8::StaticOrder, true, true>(ldsl, g, S, E, wave_s);
#endif
              }
            grid.sync();
            { pg8::Gemm g{HID, WL + (second ? O_FFN2_OUT : O_FFN1_OUT), TOK, DMOD, FF, FF, FF, 0, 0}; pg8::StaticOrder S; S.init(TOK, DMOD, G, bx);
              pg8::EpiResid E{xsrc, xout, DMOD, 0.5f};

#ifndef NO_G1
              pg8::gemm_phase<pg8::EpiResid, pg8::StaticOrder, true, true>(ldsl, g, S, E, wave_s);
#endif
              }
            grid.sync();
        } else {
            const float* w_in_l = args.in[7] + (size_t)l * DMOD * DIN;
#ifndef NO_FOXNORM
            { LANE_STATE(); norm_rows<true>(xout, args.in[6] + l * DMOD, H, TOK, w_in_l, FOXF, gw, NGW, lane); }
#endif
            if (l == 0) {
                pg8::Gemm g{MEMN, WB + O_WMEM, 2048, 2048, DMOD, DMOD, DMOD, 0, 0}; pg8::StaticOrder S; S.init(2048, 2048, G, bx);
                pg8::EpiBf16 E{MEMKV, 2048};

#ifndef NO_G2
              pg8::gemm_phase<pg8::EpiBf16, pg8::StaticOrder, true, true>(ldsl, g, S, E, wave_s);
#endif

            }
            grid.sync();
            for (int hf = 0; hf < 2; ++hf) {
                { pg8::Gemm g{H + (size_t)hf * HTOK * DMOD, WL + O_WIN, HTOK, 8192, DMOD, DMOD, DMOD, 0, 0}; pg8::StaticOrder S; S.init(HTOK, 8192, G, bx);
                  pg8::EpiBf16 E{PROJ, PP};

#ifndef NO_G3
              pg8::gemm_phase<pg8::EpiBf16, pg8::StaticOrder, true, true>(ldsl, g, S, E, wave_s);
#endif
              }
                grid.sync();
#ifndef NO_PP1
                {
                    LANE_STATE();
                    if (gw < 32) {
                        const int bl = gw >> 3, h = gw & 7; const float* f = FOXF + ((size_t)(hf * HTOK + bl * SEQL)) * 8 + h; const float bfv = args.in[8][l * 8 + h];
                        float run = 0.f;
                        for (int i = 0; i < 64; ++i) { const float xv = f[(size_t)(lane * 64 + i) * 8] + bfv; run += logsig(xv); }
                        float incl = run;
#pragma unroll
                        for (int o = 1; o < 64; o <<= 1) { const float t = __builtin_bit_cast(float, __builtin_amdgcn_ds_bpermute((lane - o) << 2, __builtin_bit_cast(int, incl))); if (lane >= o) incl += t; }
                        run = incl - run;
                        float* cp = CK2 + (size_t)(bl * 8 + h) * SEQL + lane * 64;
                        for (int i = 0; i < 64; ++i) { const float xv = f[(size_t)(lane * 64 + i) * 8] + bfv; run += logsig(xv); cp[i] = -run * LOG2E; }
                    }
                    if (hf == 0) {
                        float gk[8];
#pragma unroll
                        for (int i = 0; i < 8; ++i) gk[i] = args.in[16][l * 128 + (lane & 15) * 8 + i];
                        for (int r = gw; r < 2048; r += NGW) { bf16* p = MEMKV + (size_t)r * 2048 + l * 1024 + lane * 8; float v[8]; ld8(p, v); gnorm8<16>(v, gk, 1.0f); st8(p, v); }
                    }
                    float gqa[8], gka[8], gqc[8], gkc[8], gmq[8];
#pragma unroll
                    for (int i = 0; i < 8; ++i) { const int d = (lane & 7) * 8 + i; gqa[i] = args.in[9][l * 64 + d]; gka[i] = args.in[10][l * 64 + d]; gqc[i] = args.in[11][l * 64 + d]; gkc[i] = args.in[12][l * 64 + d];
                        gmq[i] = args.in[15][l * 128 + (lane & 15) * 8 + i]; }
                    const float invf = powf(500000.0f, -(float)(lane & 7) * 0.125f);
                    LAS float* scr = (LAS float*)ldsl;
                    for (int it = vcu; it < HTOK / 64; it += G) {
                        const int m0 = it * 64;
                        float kacc[8];
#pragma unroll
                        for (int i = 0; i < 8; ++i) kacc[i] = 0.f;
                        for (int tt = 0; tt < 8; ++tt) {
                            const int m = m0 + wave * 8 + tt, s = m & (SEQL - 1);
                            bf16* row = PROJ + (size_t)m * PP;
                            const float ang = (float)positions[hf * HTOK + m] * invf;
                            const float cs = cosf(ang), sn = sinf(ang);
                            float cc[8], ss[8];
#pragma unroll
                            for (int i = 0; i < 8; ++i) { cc[i] = __builtin_bit_cast(float, __builtin_amdgcn_readlane(__builtin_bit_cast(int, cs), i)); ss[i] = __builtin_bit_cast(float, __builtin_amdgcn_readlane(__builtin_bit_cast(int, sn), i)); }
                            float v[8];
                            ld8(row + C_QA + lane * 8, v); gnorm8<8>(v, gqa, 1.0f); rot8(v, cc, ss, lane & 7);
#pragma unroll
                            for (int i = 0; i < 8; ++i) v[i] *= C2_64;
                            st8(row + C_QA + lane * 8, v);
                            ld8(row + C_KA + lane * 8, v); gnorm8<8>(v, gka, 1.0f); rot8(v, cc, ss, lane & 7); st8(row + C_KA + lane * 8, v);
#pragma unroll
                            for (int i = 0; i < 8; ++i) kacc[i] += v[i];
                            ld8(row + C_QC + lane * 8, v); gnorm8<8>(v, gqc, C2_64); st8(row + C_QC + lane * 8, v);
                            ld8(row + C_KC + lane * 8, v); gnorm8<8>(v, gkc, 1.0f); st8(row + C_KC + lane * 8, v);
                            ld8(row + C_MQ + lane * 8, v); gnorm8<16>(v, gmq, C2_128); st8(row + C_MQ + lane * 8, v);
                            {
                                const int w = 2 << (lane >> 4); const int cnt = (s + 1 < w) ? s + 1 : w;
                                float u0[8], sm[8]; ld8(row + C_PU + lane * 8, u0);
#pragma unroll
                                for (int i = 0; i < 8; ++i) sm[i] = u0[i];
                                for (int j = 1; j < cnt; ++j) { float t[8]; ld8(row - (size_t)j * PP + C_PU + lane * 8, t);
#pragma unroll
                                    for (int i = 0; i < 8; ++i) sm[i] += t[i]; }
                                const float inv = 1.0f / (float)cnt;
#pragma unroll
                                for (int i = 0; i < 8; ++i) sm[i] = sm[i] * inv - u0[i];
                                st8(POOLED + (size_t)m * 512 + lane * 8, sm);
                            }
                        }
#pragma unroll
                        for (int i = 0; i < 8; ++i) scr[wave * 512 + lane * 8 + i] = kacc[i];
                        __syncthreads();
                        { float t = 0.f;
#pragma unroll
                          for (int w8 = 0; w8 < 8; ++w8) t += scr[w8 * 512 + tid];
                          const int bl = m0 >> 12, s0 = m0 & (SEQL - 1);
                          KMEAN[(size_t)((bl * 16 + (s0 >> 8)) * 4 + ((s0 >> 6) & 3)) * 512 + tid] = t * (1.0f / 256.0f); }
                        __syncthreads();
                    }
                }
#endif
                grid.sync();
                {
                    for (int ui = 4 * vcu; ui < 1024; ui += 4 * G)
                        for (int uj = 0; uj < 4; ++uj) {
                            const int p = (ui + uj) >> 1, type = p >> 8, pp = p & 255, bh = pp >> 3, s8 = pp & 7, bl = bh >> 3, h = bh & 7;
                            const int qb = (uj & 1) ? s8 : 15 - s8;
#ifndef NO_ATTN0
                            if (type == 0) attn_body::attn_unit<0, 8>(bl, h, qb, (const attn_body::bf16*)(PROJ + C_QA), (const attn_body::bf16*)(PROJ + C_KA), (const attn_body::bf16*)(PROJ + C_VA), (attn_body::bf16*)(PROJ + C_QA), KMEAN, (char*)lds, wave_s);
#endif
#ifndef NO_ATTN1
                            if (type == 1) attn_body::attn_unit<1, 8>(bl, h, qb, (const attn_body::bf16*)(PROJ + C_QC), (const attn_body::bf16*)(PROJ + C_KC), (const attn_body::bf16*)(PROJ + C_VC), (attn_body::bf16*)(PROJ + C_QC), CK2, (char*)lds, wave_s);
#endif
                        }
                    for (int u = vcu; u < 256; u += G) { const int bl = u >> 6, h = (u >> 4) & 3, qb = u & 15;
#ifndef NO_MEM
                        attn_body::mem_unit(bl * SEQL, hf * 4 + bl, h, qb, (attn_body::bf16*)(PROJ + C_MQ), (const attn_body::bf16*)(MEMKV + l * 1024), (char*)lds, wave_s);
#endif
                    }
                    { pg8::Gemm g{POOLED, WL + O_WPOOL, HTOK, 512, 512, 512, 512, 0, 0}; pg8::StaticOrder S; S.init(HTOK, 512, G, bx);
                      pg8::EpiBf16 E{PROJ + C_PU, PP};

#ifndef NO_G4
              pg8::gemm_phase<pg8::EpiBf16, pg8::StaticOrder, true, true>(ldsl, g, S, E, wave_s);
#endif
              }
                }
                grid.sync();
                { pg8::Gemm g{PROJ, WL + O_WBR, HTOK, DMOD, 512, PP, 512, 512, (long)DMOD * 512}; pg8::StaticOrder S; S.init(HTOK, DMOD, G, bx, 4);
                  pg8::EpiGate E{Z, DMOD, PROJ + C_GATE, PP};

#ifndef NO_G5
              pg8::gemm_phase<pg8::EpiGate, pg8::StaticOrder, true, true>(ldsl, g, S, E, wave_s);
#endif
              }
                grid.sync();
                { pg8::Gemm g{Z, WL + O_WOUT, HTOK, DMOD, DMOD, DMOD, DMOD, 0, 0}; pg8::StaticOrder S; S.init(HTOK, DMOD, G, bx);
                  float* xo = xout + (size_t)hf * HTOK * DMOD;
                  pg8::EpiResid E{xo, xo, DMOD, 1.0f};

#ifndef NO_G6
              pg8::gemm_phase<pg8::EpiResid, pg8::StaticOrder, true, true>(ldsl, g, S, E, wave_s);
#endif
              }
                grid.sync();
            }
        }
    }
}

extern "C" void kernel_launch(void* const* d_in, const int* in_sizes, int n_in, void* d_out, int out_size, void* d_ws, size_t ws_size, hipStream_t stream) {
    static int grid = 0;
    if (grid == 0) {
        if (n_in != 24 || out_size != TOK * DMOD || ws_size < WS_END) { fprintf(stderr, "kernel_launch: unexpected shapes (n_in %d out %d ws %zu)\n", n_in, out_size, ws_size); grid = -1; return; }
        int dev = 0, cus = 0, per_cu = 0;
        hipGetDevice(&dev); hipDeviceGetAttribute(&cus, hipDeviceAttributeMultiprocessorCount, dev);
        hipFuncSetAttribute((const void*)hybrid_fwd, hipFuncAttributeMaxDynamicSharedMemorySize, LDS_BYTES);
        hipOccupancyMaxActiveBlocksPerMultiprocessor(&per_cu, (const void*)hybrid_fwd, NWAVES * 64, LDS_BYTES);
        (void)hipGetLastError();
        if (per_cu < 1) per_cu = 1;
        grid = cus;
    }
    if (grid < 0) return;
    Args a{};
    for (int i = 0; i < 24; ++i) a.in[i] = (const float*)d_in[i];
    a.out = (float*)d_out; a.ws = (unsigned char*)d_ws;
    void* kargs[] = {&a};
    hipError_t e = hipLaunchCooperativeKernel((const void*)hybrid_fwd, dim3(grid), dim3(NWAVES * 64), kargs, LDS_BYTES, stream);
    if (e != hipSuccess) fprintf(stderr, "cooperative launch failed: %s (grid %d)\n", hipGetErrorString(e), grid);
}
```

```cpp
#include <hip/hip_runtime.h>
#include <hip/hip_cooperative_groups.h>
#include <hip/hip_bf16.h>
#include <cstdio>
#include <cstdint>
#include <cmath>
namespace cg = cooperative_groups;

__device__ __forceinline__ int tid_from_wave(int wave_s) { int l; asm volatile("v_mbcnt_lo_u32_b32 %0, -1, 0\n\tv_mbcnt_hi_u32_b32 %0, -1, %0" : "=v"(l)); return wave_s * 64 + l; }

template <int M> __device__ __forceinline__ float xor_lane(float v) {
    if constexpr (M < 32) { return __builtin_bit_cast(float, __builtin_amdgcn_ds_swizzle(__builtin_bit_cast(int, v), (M << 10) | 0x1f)); }
    else { const unsigned u = __builtin_bit_cast(unsigned, v); auto rr = __builtin_amdgcn_permlane32_swap(u, u, false, false); const unsigned a = rr[0], b = rr[1]; return __builtin_bit_cast(float, a == u ? b : a); }
}
__device__ __forceinline__ float sum_x32(float v) { const unsigned u = __builtin_bit_cast(unsigned, v); auto rr = __builtin_amdgcn_permlane32_swap(u, u, false, false); return __builtin_bit_cast(float, (unsigned)rr[0]) + __builtin_bit_cast(float, (unsigned)rr[1]); }
__device__ __forceinline__ float max_x32(float v) { const unsigned u = __builtin_bit_cast(unsigned, v); auto rr = __builtin_amdgcn_permlane32_swap(u, u, false, false); return __builtin_fmaxf(__builtin_bit_cast(float, (unsigned)rr[0]), __builtin_bit_cast(float, (unsigned)rr[1])); }

namespace pg8 {
#define PG8_LAS __attribute__((address_space(3)))
typedef unsigned short bf16_t;
typedef short bf16x8 __attribute__((ext_vector_type(8)));
typedef float f32x4 __attribute__((ext_vector_type(4)));
typedef unsigned u32x4 __attribute__((ext_vector_type(4)));
constexpr int BM = 256, BK = 64, HALF = 128, HTB = HALF * BK * 2  , STAGE_BYTES = 8 * HTB, NXCD = 8, WGM = 8;

__host__ __device__ __forceinline__ int lds_byte(int r, int c) { const int st = (r >> 4) * 2 + (c >> 5), rr = r & 15, cc = c & 31, ob = rr * 64 + cc * 2; return st * 1024 + (ob ^ (((ob >> 9) & 1) << 5)); }
__host__ __device__ __forceinline__ void stage_rc(int b, int& R, int& C) { const int st = b / 1024, sb = b % 1024, swz = sb ^ (((sb >> 9) & 1) << 5); R = (st >> 1) * 16 + swz / 64; C = (st & 1) * 32 + (swz % 64) / 2; }
__host__ __device__ __forceinline__ int perm32(int rho) { const int n = rho >> 4, i = rho & 15; return 8 * (i >> 2) + 4 * n + (i & 3); }

struct Unit { int pm, pn, z; };
struct Gemm { const bf16_t* A; const bf16_t* Bt; int M, N, K, lda, ldb; long azoff, bzoff;
    const bf16_t* A2 = nullptr; const bf16_t* Bt2 = nullptr; int K2 = 0; long a2z = 0, b2z = 0; };
__device__ __forceinline__ void unit_ptrs(const Gemm& g, const Unit& u, size_t tstepA, size_t tstepB, const char*& pa, const char*& pb, int& ntu) {
    if (g.K2 != 0) { const int zb = u.z >> 1;
        if (u.z & 1) { pa = (const char*)g.A2 + (size_t)u.pm * tstepA + (size_t)zb * g.a2z * 2; pb = (const char*)g.Bt2 + (size_t)u.pn * tstepB + (size_t)zb * g.b2z * 2; ntu = g.K2 / BK; }
        else { pa = (const char*)g.A + (size_t)u.pm * tstepA + (size_t)zb * g.azoff * 2; pb = (const char*)g.Bt + (size_t)u.pn * tstepB + (size_t)zb * g.bzoff * 2; ntu = g.K / BK; }
    } else { pa = (const char*)g.A + (size_t)u.pm * tstepA + (size_t)u.z * g.azoff * 2; pb = (const char*)g.Bt + (size_t)u.pn * tstepB + (size_t)u.z * g.bzoff * 2; ntu = g.K / BK; }
}

struct StaticOrder {
    int nM, nN, nwg, G, c, NZ;
    __host__ __device__ void init(int M, int N, int G_, int c_, int NZ_ = 1) { nM = M / BM; nN = N / BM; nwg = nM * nN; G = G_; c = c_; NZ = NZ_; }
    __host__ __device__ bool next(int i, Unit& u) const {
        const int zi = i % NZ, ii = i / NZ;
        const long L = (long)ii * G + c; if (L >= nwg) return false;
        int wgid = (int)L; { const int q = nwg / NXCD, r = nwg % NXCD, xcd = wgid % NXCD, off = wgid / NXCD; wgid = (xcd < r ? xcd * (q + 1) : r * (q + 1) + (xcd - r) * q) + off; }
        const int nig = WGM * nN, gid = wgid / nig, fm = gid * WGM, gsz = (nM - fm) < WGM ? (nM - fm) : WGM;
        u.pm = fm + ((wgid % nig) % gsz); u.pn = (wgid % nig) / gsz; u.z = zi; return true;
    }
    __device__ __forceinline__ void a_ready(const Unit&) const {}
    __device__ __forceinline__ void done(const Unit&) const {}
};

__device__ __forceinline__ unsigned cvt_pk_bf16(float lo, float hi) { unsigned r; asm volatile("v_cvt_pk_bf16_f32 %0, %1, %2" : "=v"(r) : "v"(lo), "v"(hi)); return r; }
__device__ __forceinline__ float bf_lo(unsigned w) { return __uint_as_float(w << 16); }
__device__ __forceinline__ float bf_hi(unsigned w) { return __uint_as_float(w & 0xffff0000u); }
__device__ __forceinline__ float sigm(float x) { return __builtin_amdgcn_rcpf(1.0f + __builtin_amdgcn_exp2f(-1.4426950408889634f * x)); }

struct EpiBf16 {
    static constexpr bool PERM = true, AFTER_DRAIN = false;
    bf16_t* O; int ldc;
    __device__ __forceinline__ void operator()(const f32x4 (&acc)[2][2][4][2], const Unit& u, int wr, int wc, int fr, int fq) const {
        const int row0 = u.pm * BM + wr * 64 + fr, col0 = u.pn * BM + wc * 32 + 8 * fq;
#pragma unroll
        for (int ai = 0; ai < 2; ++ai)
#pragma unroll
            for (int m = 0; m < 4; ++m) { bf16_t* rowp = O + (size_t)(row0 + ai * HALF + m * 16) * ldc + col0;
#pragma unroll
                for (int bj = 0; bj < 2; ++bj) { const f32x4 v0 = acc[ai][bj][m][0], v1 = acc[ai][bj][m][1];
                    u32x4 w; w.x = cvt_pk_bf16(v0[0], v0[1]); w.y = cvt_pk_bf16(v0[2], v0[3]); w.z = cvt_pk_bf16(v1[0], v1[1]); w.w = cvt_pk_bf16(v1[2], v1[3]);
                    *(u32x4*)(rowp + bj * HALF) = w; } }
    }
};
struct EpiSwiglu {
    static constexpr bool PERM = true, AFTER_DRAIN = false;
    bf16_t* O; int ldc;
    __device__ __forceinline__ void operator()(const f32x4 (&acc)[2][2][4][2], const Unit& u, int wr, int wc, int fr, int fq) const {
        const int row0 = u.pm * BM + wr * 64 + fr, col0 = u.pn * HALF + wc * 32 + 8 * fq;
#pragma unroll
        for (int ai = 0; ai < 2; ++ai)
#pragma unroll
            for (int m = 0; m < 4; ++m) { bf16_t* rowp = O + (size_t)(row0 + ai * HALF + m * 16) * ldc + col0;
                float r[8];
#pragma unroll
                for (int n = 0; n < 2; ++n)
#pragma unroll
                    for (int e = 0; e < 4; ++e) { const float g = acc[ai][0][m][n][e], uu = acc[ai][1][m][n][e]; r[n * 4 + e] = g * sigm(g) * uu; }
                u32x4 w; w.x = cvt_pk_bf16(r[0], r[1]); w.y = cvt_pk_bf16(r[2], r[3]); w.z = cvt_pk_bf16(r[4], r[5]); w.w = cvt_pk_bf16(r[6], r[7]);
                *(u32x4*)rowp = w; }
    }
};
struct EpiResid {
    static constexpr bool PERM = false, AFTER_DRAIN = false;
    const float* base; float* out; int ldc; float scale;
    __device__ __forceinline__ void operator()(const f32x4 (&acc)[2][2][4][2], const Unit& u, int wr, int wc, int fr, int fq) const {
        const int row0 = u.pm * BM + wr * 64 + fr, col0 = u.pn * BM + wc * 32 + 4 * fq;
#pragma unroll
        for (int ai = 0; ai < 2; ++ai) {
            f32x4 bs[4][2][2];
#pragma unroll
            for (int m = 0; m < 4; ++m) { const size_t off = (size_t)(row0 + ai * HALF + m * 16) * ldc + col0;
#pragma unroll
                for (int bj = 0; bj < 2; ++bj)
#pragma unroll
                    for (int n = 0; n < 2; ++n) bs[m][bj][n] = *(const f32x4*)(base + off + bj * HALF + n * 16); }
#pragma unroll
            for (int m = 0; m < 4; ++m) { const size_t off = (size_t)(row0 + ai * HALF + m * 16) * ldc + col0;
#pragma unroll
                for (int bj = 0; bj < 2; ++bj)
#pragma unroll
                    for (int n = 0; n < 2; ++n) *(f32x4*)(out + off + bj * HALF + n * 16) = bs[m][bj][n] + acc[ai][bj][m][n] * scale; }
            asm volatile("" ::: "memory");
        }
    }
};
struct EpiGate {
    static constexpr bool PERM = true, AFTER_DRAIN = false;
    bf16_t* Z; int ldz; bf16_t* GS;
    __device__ __forceinline__ void operator()(const f32x4 (&acc)[2][2][4][2], const Unit& u, int wr, int wc, int fr, int fq) const {
        int fr_ = fr, fq_ = fq; asm volatile("" : "+v"(fr_), "+v"(fq_));
        const int rl0 = wr * 64 + fr_, cl0 = wc * 32 + 8 * fq_, row0 = u.pm * BM + rl0, col0 = u.pn * BM + cl0, zb = u.z >> 1;
        if (!(u.z & 1)) {
#pragma unroll
            for (int ai = 0; ai < 2; ++ai)
#pragma unroll
                for (int m = 0; m < 4; ++m)
#pragma unroll
                    for (int bj = 0; bj < 2; ++bj) { const f32x4 v0 = acc[ai][bj][m][0], v1 = acc[ai][bj][m][1];
                        u32x4 w; w.x = cvt_pk_bf16(v0[0], v0[1]); w.y = cvt_pk_bf16(v0[2], v0[3]); w.z = cvt_pk_bf16(v1[0], v1[1]); w.w = cvt_pk_bf16(v1[2], v1[3]);
                        *(u32x4*)(GS + (size_t)(rl0 + ai * HALF + m * 16) * 256 + cl0 + bj * HALF) = w; }
            return;
        }
        asm volatile("s_waitcnt vmcnt(0) lgkmcnt(0)\n\tbuffer_inv sc1\n\ts_waitcnt vmcnt(0)" ::: "memory");
#pragma unroll
        for (int ai = 0; ai < 2; ++ai) {
            u32x4 gv[4][2], zv[4][2];
#pragma unroll
            for (int m = 0; m < 4; ++m)
#pragma unroll
                for (int bj = 0; bj < 2; ++bj) gv[m][bj] = *(const u32x4*)(GS + (size_t)(rl0 + ai * HALF + m * 16) * 256 + cl0 + bj * HALF);
            if (zb > 0) {
#pragma unroll
                for (int m = 0; m < 4; ++m)
#pragma unroll
                    for (int bj = 0; bj < 2; ++bj) zv[m][bj] = *(const u32x4*)(Z + (size_t)(row0 + ai * HALF + m * 16) * ldz + col0 + bj * HALF);
            }
#pragma unroll
            for (int m = 0; m < 4; ++m)
#pragma unroll
                for (int bj = 0; bj < 2; ++bj) {
                    const u32x4 g4 = gv[m][bj]; const f32x4 v0 = acc[ai][bj][m][0], v1 = acc[ai][bj][m][1];
                    float o[8];
                    o[0] = bf_lo(g4.x) * sigm(v0[0]); o[1] = bf_hi(g4.x) * sigm(v0[1]); o[2] = bf_lo(g4.y) * sigm(v0[2]); o[3] = bf_hi(g4.y) * sigm(v0[3]);
                    o[4] = bf_lo(g4.z) * sigm(v1[0]); o[5] = bf_hi(g4.z) * sigm(v1[1]); o[6] = bf_lo(g4.w) * sigm(v1[2]); o[7] = bf_hi(g4.w) * sigm(v1[3]);
                    if (zb > 0) { const u32x4 z4 = zv[m][bj];
                        o[0] += bf_lo(z4.x); o[1] += bf_hi(z4.x); o[2] += bf_lo(z4.y); o[3] += bf_hi(z4.y); o[4] += bf_lo(z4.z); o[5] += bf_hi(z4.z); o[6] += bf_lo(z4.w); o[7] += bf_hi(z4.w); }
                    u32x4 w; w.x = cvt_pk_bf16(o[0], o[1]); w.y = cvt_pk_bf16(o[2], o[3]); w.z = cvt_pk_bf16(o[4], o[5]); w.w = cvt_pk_bf16(o[6], o[7]);
                    *(u32x4*)(Z + (size_t)(row0 + ai * HALF + m * 16) * ldz + col0 + bj * HALF) = w; }
            asm volatile("" ::: "memory");
        }
    }
};

template <class Epi, class Sched, bool ALIGN_EPI = false, bool SP2 = false>
__device__ __forceinline__ void gemm_phase(PG8_LAS unsigned char* lds, const Gemm g, const Sched& S, const Epi& E, const int wave_s) {
    int tid_ = tid_from_wave(wave_s);
    const int tid = tid_, wid = __builtin_amdgcn_readfirstlane(tid >> 6), lane = tid & 63, wr = wid >> 2, wc = wid & 3, fr = lane & 15, fq = lane >> 4;
    const int lda = g.lda, ldb = g.ldb;
    unsigned voffA[2], voffB[2];
#pragma unroll
    for (int i = 0; i < 2; ++i) { int R, C; stage_rc(tid * 16 + i * 8192, R, C); const int Rb = Epi::PERM ? ((R & ~31) + perm32(R & 31)) : R;
        voffA[i] = (unsigned)(R * lda + C) * 2u; voffB[i] = (unsigned)(Rb * ldb + C) * 2u; }
    const size_t kstep = (size_t)(BK * 2);
    const size_t hstepA = (size_t)HALF * lda * 2, hstepB = (size_t)HALF * ldb * 2;
    const size_t tstepA = 2 * hstepA, tstepB = 2 * hstepB;
    const unsigned ldsw = (unsigned)wid * 1024u;
    const int aoff = lds_byte(wr * 64 + fr, fq * 8), boff = lds_byte(wc * 32 + fr, fq * 8);
#define PG8_SA(b, h) (((b) * 2 + (h)) * HTB)
#define PG8_SB(b, h) ((4 + (b) * 2 + (h)) * HTB)
#define PG8_STAGE(bufoff, gbase, voff) do { _Pragma("unroll") for (int _i = 0; _i < 2; ++_i) \
        __builtin_amdgcn_global_load_lds((const unsigned*)((const char*)(gbase) + (voff)[_i]), (PG8_LAS unsigned*)(lds + (bufoff) + ldsw + _i * 8192), 16, 0, 0); } while (0)
#define PG8_LDA(dst, b, h) do { _Pragma("unroll") for (int m = 0; m < 4; ++m) _Pragma("unroll") for (int k = 0; k < 2; ++k) dst[m][k] = *(const PG8_LAS bf16x8*)(lds + PG8_SA(b, h) + aoff + m * 2048 + k * 1024); } while (0)
#define PG8_LDB(dst, b, h) do { _Pragma("unroll") for (int n = 0; n < 2; ++n) _Pragma("unroll") for (int k = 0; k < 2; ++k) dst[n][k] = *(const PG8_LAS bf16x8*)(lds + PG8_SB(b, h) + boff + n * 2048 + k * 1024); } while (0)
#define PG8_MMA(ai, bj, At, Bt) do { __builtin_amdgcn_s_setprio(1); _Pragma("unroll") for (int m = 0; m < 4; ++m) _Pragma("unroll") for (int n = 0; n < 2; ++n) _Pragma("unroll") for (int k = 0; k < 2; ++k) \
        acc[ai][bj][m][n] = __builtin_amdgcn_mfma_f32_16x16x32_bf16(Bt[n][k], At[m][k], acc[ai][bj][m][n], 0, 0, 0); __builtin_amdgcn_s_setprio(0); } while (0)
#define PG8_WAIT_V(n) asm volatile("s_waitcnt vmcnt(" #n ")" ::: "memory")
#define PG8_WAIT_L(n) asm volatile("s_waitcnt lgkmcnt(" #n ")" ::: "memory")
#define PG8_BAR __builtin_amdgcn_s_barrier()
#define PG8_SCHED __builtin_amdgcn_sched_barrier(0)
    Unit cur, nxt; int ui = 0;
    if (!S.next(0, cur)) return;
    f32x4 acc[2][2][4][2];
#pragma unroll
    for (int a = 0; a < 2; ++a)
#pragma unroll
        for (int b = 0; b < 2; ++b)
#pragma unroll
            for (int m = 0; m < 4; ++m)
#pragma unroll
                for (int n = 0; n < 2; ++n) acc[a][b][m][n] = (f32x4){0.f, 0.f, 0.f, 0.f};
    bf16x8 At[4][2], B0[2][2], B1[2][2];
    const char* cA; const char* cB; int nt; unit_ptrs(g, cur, tstepA, tstepB, cA, cB, nt);
    S.a_ready(cur);
    if constexpr (SP2) {
        PG8_STAGE(PG8_SB(0, 0), cB, voffB); PG8_STAGE(PG8_SB(0, 1), cB + hstepB, voffB); PG8_STAGE(PG8_SA(0, 0), cA, voffA); PG8_STAGE(PG8_SA(0, 1), cA + hstepA, voffA);
        if (wr == 1) PG8_BAR;
        PG8_WAIT_V(2); PG8_BAR;
        PG8_STAGE(PG8_SB(1, 0), cB + kstep, voffB); PG8_STAGE(PG8_SA(1, 0), cA + kstep, voffA); PG8_STAGE(PG8_SB(1, 1), cB + hstepB + kstep, voffB);
        PG8_WAIT_V(6); PG8_BAR;
    } else {
        PG8_STAGE(PG8_SB(0, 0), cB, voffB); PG8_STAGE(PG8_SA(0, 0), cA, voffA); PG8_STAGE(PG8_SB(0, 1), cB + hstepB, voffB); PG8_STAGE(PG8_SA(0, 1), cA + hstepA, voffA);
        if (wr == 1) PG8_BAR;
        PG8_WAIT_V(4); PG8_BAR;
        PG8_STAGE(PG8_SB(1, 0), cB + kstep, voffB); PG8_STAGE(PG8_SA(1, 0), cA + kstep, voffA); PG8_STAGE(PG8_SB(1, 1), cB + hstepB + kstep, voffB);
        PG8_WAIT_V(6); PG8_BAR;
    }
    for (;;) {
        const bool has_next = S.next(ui + 1, nxt);
        const char* nA = cA; const char* nB = cB; int ntn = nt; if (has_next) unit_ptrs(g, nxt, tstepA, tstepB, nA, nB, ntn);
        for (int t = 0; t < nt; t += 2) {
            const bool last = (t == nt - 2);
            const char* a1 = cA + (size_t)(t + 1) * kstep;
            const char* a2 = last ? nA : cA + (size_t)(t + 2) * kstep; const char* b2 = last ? nB : cB + (size_t)(t + 2) * kstep;
            const char* a3 = a2 + kstep; const char* b3 = b2 + kstep;
            if (last && has_next) S.a_ready(nxt);
            if constexpr (SP2) {
            PG8_LDB(B0, 0, 0); PG8_LDB(B1, 0, 1); PG8_SCHED; PG8_LDA(At, 0, 0); PG8_STAGE(PG8_SA(1, 1), a1 + hstepA, voffA);
            PG8_WAIT_V(8); PG8_WAIT_L(0); PG8_BAR; PG8_MMA(0, 0, At, B0); PG8_MMA(0, 1, At, B1); PG8_BAR; PG8_SCHED;
            PG8_LDA(At, 0, 1); PG8_STAGE(PG8_SB(0, 0), b2, voffB); PG8_STAGE(PG8_SB(0, 1), b2 + hstepB, voffB); PG8_STAGE(PG8_SA(0, 0), a2, voffA);
            PG8_WAIT_V(8); PG8_WAIT_L(0); PG8_BAR; PG8_MMA(1, 0, At, B0); PG8_MMA(1, 1, At, B1); PG8_BAR; PG8_SCHED;
            PG8_LDB(B0, 1, 0); PG8_LDB(B1, 1, 1); PG8_SCHED; PG8_LDA(At, 1, 0); PG8_STAGE(PG8_SA(0, 1), a2 + hstepA, voffA);
            PG8_WAIT_V(8); PG8_WAIT_L(0); PG8_BAR; PG8_MMA(0, 0, At, B0); PG8_MMA(0, 1, At, B1); PG8_BAR; PG8_SCHED;
            PG8_LDA(At, 1, 1); PG8_STAGE(PG8_SB(1, 0), b3, voffB); PG8_STAGE(PG8_SB(1, 1), b3 + hstepB, voffB); PG8_STAGE(PG8_SA(1, 0), a3, voffA);
            PG8_WAIT_V(8); PG8_WAIT_L(0); PG8_BAR; PG8_MMA(1, 0, At, B0); PG8_MMA(1, 1, At, B1); PG8_BAR; PG8_SCHED;
            } else {
            PG8_LDB(B0, 0, 0); PG8_SCHED; PG8_LDA(At, 0, 0); PG8_STAGE(PG8_SA(1, 1), a1 + hstepA, voffA);
            PG8_WAIT_L(8); PG8_BAR; PG8_WAIT_L(0); PG8_MMA(0, 0, At, B0); PG8_BAR; PG8_SCHED;
            PG8_LDB(B1, 0, 1); PG8_STAGE(PG8_SB(0, 0), b2, voffB);
            PG8_BAR; PG8_WAIT_L(0); PG8_MMA(0, 1, At, B1); PG8_BAR;
            PG8_LDA(At, 0, 1); PG8_STAGE(PG8_SA(0, 0), a2, voffA);
            PG8_BAR; PG8_WAIT_L(0); PG8_MMA(1, 0, At, B0); PG8_BAR; PG8_SCHED;
            PG8_STAGE(PG8_SB(0, 1), b2 + hstepB, voffB);
            PG8_WAIT_V(6); PG8_BAR; PG8_MMA(1, 1, At, B1); PG8_BAR;
            PG8_LDB(B0, 1, 0); PG8_SCHED; PG8_LDA(At, 1, 0); PG8_STAGE(PG8_SA(0, 1), a2 + hstepA, voffA);
            PG8_WAIT_L(8); PG8_BAR; PG8_WAIT_L(0); PG8_MMA(0, 0, At, B0); PG8_BAR; PG8_SCHED;
            PG8_LDB(B1, 1, 1); PG8_STAGE(PG8_SB(1, 0), b3, voffB);
            PG8_BAR; PG8_WAIT_L(0); PG8_MMA(0, 1, At, B1); PG8_BAR;
            PG8_LDA(At, 1, 1); PG8_STAGE(PG8_SA(1, 0), a3, voffA);
            PG8_BAR; PG8_WAIT_L(0); PG8_MMA(1, 0, At, B0); PG8_BAR; PG8_SCHED;
            PG8_STAGE(PG8_SB(1, 1), b3 + hstepB, voffB);
            PG8_WAIT_V(6); PG8_BAR; PG8_MMA(1, 1, At, B1); PG8_BAR;
            }
        }
        if constexpr (ALIGN_EPI) { if (wr == 0) PG8_BAR; }
        if constexpr (!Epi::AFTER_DRAIN) { E(acc, cur, wr, wc, fr, fq); S.done(cur); }
        if (!has_next) break;
#pragma unroll
        for (int a = 0; a < 2; ++a)
#pragma unroll
            for (int b = 0; b < 2; ++b)
#pragma unroll
                for (int m = 0; m < 4; ++m)
#pragma unroll
                    for (int n = 0; n < 2; ++n) acc[a][b][m][n] = (f32x4){0.f, 0.f, 0.f, 0.f};
        cur = nxt; cA = nA; cB = nB; nt = ntn; ++ui;
        if constexpr (ALIGN_EPI) { if (wr == 1) PG8_BAR; }
    }
    PG8_WAIT_V(0);
    if constexpr (!ALIGN_EPI) { if (wr == 0) PG8_BAR; }
    PG8_BAR;
    if constexpr (Epi::AFTER_DRAIN) { E.fused(acc, cur, wr, wc, fr, fq, lds, wid, lane); S.done(cur); }
#undef PG8_SA
#undef PG8_SB
#undef PG8_STAGE
#undef PG8_LDA
#undef PG8_LDB
#undef PG8_MMA
#undef PG8_WAIT_V
#undef PG8_WAIT_L
#undef PG8_BAR
#undef PG8_SCHED
}
}

namespace attn_body {
using bf16=__hip_bfloat16;
using bf16x8=__attribute__((ext_vector_type(8)))short;
using s16x4=__attribute__((ext_vector_type(4)))short;
using f32x16=__attribute__((ext_vector_type(16)))float;
using u32x4=__attribute__((ext_vector_type(4)))unsigned;
constexpr int SEQ=4096,D=64,DM=5184,MKP=2112;
constexpr int NW=8,QBLK=32,QB=QBLK*NW,KVBLK=64,NQB=SEQ/QB;
constexpr int ATTN_PITCH=DM, ATTN_UNIT_ROWS=QB;
__device__ __forceinline__ int crow(int r,int hi){return (r&3)+8*(r>>2)+4*hi;}
#define SBAR() __builtin_amdgcn_sched_barrier(0)
__device__ __forceinline__ void cmask(f32x16&p0,f32x16&p1,int jb,int qrel,int hi){
  const float NEG=-INFINITY; int kb=64*jb+4*hi;
  #pragma unroll
  for(int r=0;r<16;++r){int kv=kb+(r&3)+8*(r>>2); if(kv>qrel)p0[r]=NEG; if(kv+32>qrel)p1[r]=NEG;}
}

constexpr int NSLOT=3, SLOTB=8192;
constexpr int LDS_K=0, LDS_V=NSLOT*SLOTB, LDS_WS=2*NSLOT*SLOTB, LDS_OST=LDS_WS+NW*64*4, LDS_BYTES=LDS_OST+NW*4096, LDS_AUX=86016;
constexpr float C2=0.125f*1.4426950408889634f;
__device__ __forceinline__ void glds16(const void*gsrc,unsigned lds_dst){unsigned keep;
  asm volatile("s_mov_b32 %0, m0\n\ts_mov_b32 m0, %2\n\ts_nop 0\n\tglobal_load_lds_dwordx4 %1, off\n\ts_mov_b32 m0, %0":"=&s"(keep):"v"(gsrc),"s"(lds_dst):"memory");}
__device__ __forceinline__ float max3f(float a,float b,float c){float r;asm("v_max3_f32 %0, %1, %2, %3":"=v"(r):"v"(a),"v"(b),"v"(c));return r;}
__device__ __forceinline__ float max2f(float a,float b){float r;asm("v_max_f32_e32 %0, %1, %2":"=v"(r):"v"(a),"v"(b));return r;}
__device__ __forceinline__ float fadd_s(float a,float b){float r;asm("v_add_f32_e32 %0, %1, %2":"=v"(r):"v"(a),"v"(b));return r;}
__device__ __forceinline__ float fsub_s(float a,float b){float r;asm("v_sub_f32_e32 %0, %1, %2":"=v"(r):"v"(a),"v"(b));return r;}
typedef float f32x4_t __attribute__((ext_vector_type(4))); typedef float f32x2_t __attribute__((ext_vector_type(2))); typedef __bf16 bf16x2_t __attribute__((ext_vector_type(2)));
__device__ __forceinline__ unsigned cvtpk_s(float lo,float hi){f32x2_t v={lo,hi};bf16x2_t b=__builtin_convertvector(v,bf16x2_t);return __builtin_bit_cast(unsigned,b);}
#define WAIT_BAR(N) asm volatile("s_waitcnt vmcnt(" #N ") lgkmcnt(0)\n\ts_barrier":::"memory")

__device__ __forceinline__ void qkt(f32x16&p0,f32x16&p1,const char*Kslot,const bf16x8*qr,const f32x16&negm,int r32,int hi){
  const char*kb=Kslot+hi*1024+r32*16;
  #pragma unroll
  for(int d0=0;d0<4;++d0){
    const bf16x8 b0=*reinterpret_cast<const bf16x8*>(kb+d0*2048);
    const bf16x8 b1=*reinterpret_cast<const bf16x8*>(kb+d0*2048+512);
    if(d0==0){p0=__builtin_amdgcn_mfma_f32_32x32x16_bf16(b0,qr[0],negm,0,0,0);p1=__builtin_amdgcn_mfma_f32_32x32x16_bf16(b1,qr[0],negm,0,0,0);}
    else{p0=__builtin_amdgcn_mfma_f32_32x32x16_bf16(b0,qr[d0],p0,0,0,0);p1=__builtin_amdgcn_mfma_f32_32x32x16_bf16(b1,qr[d0],p1,0,0,0);}}
}
typedef __attribute__((address_space(3))) const char* lds_cptr;
typedef short v4i16_t __attribute__((ext_vector_type(4)));
__device__ __forceinline__ void kload8(bf16x8*kf,lds_cptr kp){
  kf[0]=*(const __attribute__((address_space(3))) bf16x8*)(kp);      kf[1]=*(const __attribute__((address_space(3))) bf16x8*)(kp+512);
  kf[2]=*(const __attribute__((address_space(3))) bf16x8*)(kp+2048); kf[3]=*(const __attribute__((address_space(3))) bf16x8*)(kp+2560);
  kf[4]=*(const __attribute__((address_space(3))) bf16x8*)(kp+4096); kf[5]=*(const __attribute__((address_space(3))) bf16x8*)(kp+4608);
  kf[6]=*(const __attribute__((address_space(3))) bf16x8*)(kp+6144); kf[7]=*(const __attribute__((address_space(3))) bf16x8*)(kp+6656);
}
__device__ __forceinline__ void kload2(bf16x8*kf,lds_cptr kp,int j){ kf[2*j]=*(const __attribute__((address_space(3))) bf16x8*)(kp+j*2048); kf[2*j+1]=*(const __attribute__((address_space(3))) bf16x8*)(kp+j*2048+512); }
__device__ __forceinline__ s16x4 vtr(lds_cptr p){ return __builtin_bit_cast(s16x4,__builtin_amdgcn_ds_read_tr16_b64_v4i16((__attribute__((address_space(3))) v4i16_t*)p)); }
__device__ __forceinline__ float rowmax(const f32x16&p0,const f32x16&p1){
  float a=max3f(p0[0],p0[1],p1[0]),b=max3f(p0[2],p0[3],p1[1]);a=max3f(a,p1[2],p1[3]);
  #pragma unroll
  for(int r=4;r<16;r+=4){a=max3f(a,p0[r],p0[r+1]);b=max3f(b,p0[r+2],p0[r+3]);a=max3f(a,p1[r],p1[r+1]);b=max3f(b,p1[r+2],p1[r+3]);}
  const float m=max2f(a,b);
  auto rr=__builtin_amdgcn_permlane32_swap(__float_as_uint(m),__float_as_uint(m),false,false);
  return max2f(__uint_as_float(rr[0]),__uint_as_float(rr[1]));
}
__device__ __forceinline__ void pv(f32x16*o,int vb,bf16x8 pa0,bf16x8 pa1,bf16x8 pa2,bf16x8 pa3){
  #pragma unroll
  for(int d0=0;d0<2;++d0){s16x4 lo[4],hi[4];
    #pragma unroll
    for(int ks=0;ks<4;++ks){
      asm volatile("ds_read_b64_tr_b16 %0,%1 offset:%c2":"=&v"(lo[ks]):"v"(vb),"i"(d0*4096+ks*1024):"memory");
      asm volatile("ds_read_b64_tr_b16 %0,%1 offset:%c2":"=&v"(hi[ks]):"v"(vb),"i"(d0*4096+ks*1024+512):"memory");}
    asm volatile("s_waitcnt lgkmcnt(0)":::"memory");SBAR();
    #define PK(k) (bf16x8){lo[k][0],lo[k][1],lo[k][2],lo[k][3],hi[k][0],hi[k][1],hi[k][2],hi[k][3]}
    o[d0]=__builtin_amdgcn_mfma_f32_32x32x16_bf16(pa0,PK(0),o[d0],0,0,0);
    o[d0]=__builtin_amdgcn_mfma_f32_32x32x16_bf16(pa1,PK(1),o[d0],0,0,0);
    o[d0]=__builtin_amdgcn_mfma_f32_32x32x16_bf16(pa2,PK(2),o[d0],0,0,0);
    o[d0]=__builtin_amdgcn_mfma_f32_32x32x16_bf16(pa3,PK(3),o[d0],0,0,0);
    #undef PK
  }
}

#ifndef ATTN_STORE16
#define ATTN_STORE16(p,v) (*(u32x4*)(p)=(v))
#endif
typedef __attribute__((address_space(3))) float lds_f32; typedef __attribute__((address_space(3))) f32x4_t lds_f32x4;
template<int MODE,int THRL> __device__ __forceinline__ void attn_unit(int b,int h,int qb,const bf16*Q,const bf16*__restrict__ K,const bf16*__restrict__ V,bf16*O,const float*__restrict__ aux,char*shm,const int wave_s,const float skipb_unused){
  const int tid=tid_from_wave(wave_s),lane=tid&63,r32=lane&31,hi=lane>>5; const int wid=wave_s;
  const long rowbase=(long)b*SEQ; const int q0=qb*QB;
  const bf16*Qw=Q+(rowbase+q0+wid*QBLK)*DM+h*D;
  int t0=0;
  if(MODE==1){ if(qb>0){ const float skipb=*(const volatile __attribute__((address_space(3))) float*)((lds_cptr)shm+133136); const float*p=aux+(size_t)(b*8+h)*SEQ; const float cq=p[q0]; const bool sk=(lane<4*qb)&&(cq-p[(lane<4*qb?lane:0)*64+63]>=skipb);
      const unsigned long long mk=__ballot(sk); t0=(int)__builtin_ctzll(~mk); t0=__builtin_amdgcn_readfirstlane(t0)&~1; } }
  const bf16*Kh=K+(rowbase+(long)t0*64)*DM+h*D,*Vh=V+(rowbase+(long)t0*64)*DM+h*D;
  const unsigned lds0=(unsigned)(uintptr_t)shm;
  float*wsf=(float*)(shm+LDS_WS)+wid*64;
  const bf16*ksrc=Kh+(long)lane*DM+wid*8;
  const bf16*vsrc=Vh+(long)(16*(wid&3)+(lane>>2))*DM+(wid>>2)*32+(lane&3)*8;
  const unsigned kdst=lds0+LDS_K+wid*1024, vdst=lds0+LDS_V+wid*1024;
  #define DMA_K(t,slot) glds16(ksrc+(long)(t)*KVBLK*DM,(unsigned)__builtin_amdgcn_readfirstlane(kdst+(slot)))
  #define DMA_V(t,slot) glds16(vsrc+(long)(t)*KVBLK*DM,(unsigned)__builtin_amdgcn_readfirstlane(vdst+(slot)))
  const char*Kbase=shm+LDS_K; bf16x8 kf[8];
  const lds_cptr shm3=(lds_cptr)shm; const lds_cptr kp0=shm3+LDS_K+hi*1024+r32*16; const lds_cptr vp0=shm3+LDS_V+((lane>>4)&1)*32+(lane&3)*8+(4*hi+((lane&15)>>2))*64;
  const int NT=(q0+QB)/KVBLK-t0;
  lds_f32* auxl=(lds_f32*)(shm3+LDS_AUX);
  if(MODE==0){ for(int e=tid;e<qb*64;e+=512){ const int j=e>>6,dd=e&63; const float*p=aux+(size_t)((b*16+j)*4)*512+h*64+dd; auxl[e]=(p[0]+p[512])+(p[1024]+p[1536]); } }
  else { const float*p=aux+(size_t)(b*8+h)*SEQ+t0*64; for(int e=tid*4;e<NT*64;e+=2048){ *(lds_f32x4*)(auxl+e)=*(const f32x4_t*)(p+e); } }
  asm volatile("s_waitcnt vmcnt(0) lgkmcnt(0)\n\ts_barrier":::"memory");
  DMA_K(0,0);DMA_V(0,0);DMA_K(1,SLOTB);
  bf16x8 qr[4];
  #pragma unroll
  for(int d0=0;d0<4;++d0)qr[d0]=*reinterpret_cast<const bf16x8*>(&Qw[(long)r32*DM+d0*16+hi*8]);
  float mhat=0.f,l_reg=0.f;f32x16 o[2];o[0]=f32x16{};o[1]=f32x16{};f32x16 negm=f32x16{};if(MODE==0)asm volatile("":"+v"(negm));
  #define CINIT (MODE==0?negm:f32x16{})
  const int qrel=wid*QBLK+r32;
  #define CMASK(P0,P1,t) do{int jb_=(t)-(NT-4); if(jb_>=0)cmask(P0,P1,jb_,qrel,hi);}while(0)
  bool resc=false;
  #define START(P0,P1) do{ const float rm=rowmax(P0,P1); resc=false; \
    { const float dl=__builtin_fmaxf(rm,-30.f); mhat=fadd_s(mhat,dl); \
      _Pragma("unroll") for(int r=0;r<16;++r){P0[r]=fsub_s(P0[r],dl);P1[r]=fsub_s(P1[r],dl);} \
      if(MODE==0){ _Pragma("unroll") for(int r=0;r<16;++r)negm[r]=-mhat; asm volatile("":"+v"(negm)); } } \
    _Pragma("unroll") for(int r=0;r<16;++r)P0[r]=__builtin_amdgcn_exp2f(P0[r]); }while(0)
  #define RESC() do{ if(resc){ asm volatile("s_waitcnt lgkmcnt(0)":::"memory"); \
      _Pragma("unroll") for(int d_=0;d_<2;++d_) _Pragma("unroll") for(int r=0;r<16;++r)o[d_][r]*=wsf[crow(r,hi)]; } }while(0)
  f32x16 pA0,pA1,pB0,pB1;
  int sl_prev=0,sl_cur=0,sl_next=SLOTB;
  #define ROT() do{sl_prev=sl_cur;sl_cur=sl_next;sl_next=(sl_next==(NSLOT-1)*SLOTB)?0:sl_next+SLOTB;}while(0)
  DMA_K(2,2*SLOTB);
  WAIT_BAR(3);
  unsigned sel=0u;
  if(MODE==0){ float v1=-3.0e38f,v2=-3.0e38f,v3=-3.0e38f; int i1=-1,i2=-1,i3=-1;
    for(int j=0;j<qb;++j){ const lds_f32* km=auxl+j*64+hi*8; float g=0.f;
      _Pragma("unroll") for(int d0=0;d0<4;++d0){ const f32x4_t a=*(const lds_f32x4*)(km+d0*16), c=*(const lds_f32x4*)(km+d0*16+4);
        g+=__uint_as_float((unsigned)(unsigned short)qr[d0][0]<<16)*a[0]; g+=__uint_as_float((unsigned)(unsigned short)qr[d0][1]<<16)*a[1]; g+=__uint_as_float((unsigned)(unsigned short)qr[d0][2]<<16)*a[2]; g+=__uint_as_float((unsigned)(unsigned short)qr[d0][3]<<16)*a[3];
        g+=__uint_as_float((unsigned)(unsigned short)qr[d0][4]<<16)*c[0]; g+=__uint_as_float((unsigned)(unsigned short)qr[d0][5]<<16)*c[1]; g+=__uint_as_float((unsigned)(unsigned short)qr[d0][6]<<16)*c[2]; g+=__uint_as_float((unsigned)(unsigned short)qr[d0][7]<<16)*c[3]; }
      g=sum_x32(g);
      if(g>v1){v3=v2;i3=i2;v2=v1;i2=i1;v1=g;i1=j;} else if(g>v2){v3=v2;i3=i2;v2=g;i2=j;} else if(g>v3){v3=g;i3=j;} }
    sel=(i1>=0?(1u<<i1):0u)|(i2>=0?(1u<<i2):0u)|(i3>=0?(1u<<i3):0u); }
  #define HOOK(P0,P1,t) do{ if(MODE==0){ const int j_=(t)>>2; if(j_<qb){ if(!((sel>>j_)&1u)){ _Pragma("unroll") for(int r=0;r<16;++r){P0[r]=-INFINITY;P1[r]=-INFINITY;} } } } \
    else { const lds_f32* bp_=auxl+64*(t)+4*hi; const float nm_=-mhat; _Pragma("unroll") for(int g_=0;g_<4;++g_){ const f32x4_t b0_=*(const lds_f32x4*)(bp_+8*g_)+nm_; const f32x4_t b1_=*(const lds_f32x4*)(bp_+32+8*g_)+nm_; \
        P0[4*g_]+=b0_[0];P0[4*g_+1]+=b0_[1];P0[4*g_+2]+=b0_[2];P0[4*g_+3]+=b0_[3]; P1[4*g_]+=b1_[0];P1[4*g_+1]+=b1_[1];P1[4*g_+2]+=b1_[2];P1[4*g_+3]+=b1_[3]; } } }while(0)
  qkt(pA0,pA1,Kbase,qr,CINIT,r32,hi);asm volatile("s_nop 15\n\ts_nop 7":"+v"(pA0),"+v"(pA1));HOOK(pA0,pA1,0);CMASK(pA0,pA1,0);
  START(pA0,pA1);
  _Pragma("unroll") for(int r=0;r<16;++r)pA1[r]=__builtin_amdgcn_exp2f(pA1[r]);
  WAIT_BAR(0);
  DMA_K(3,0);DMA_V(1,SLOTB);
  ROT();
  kload8(kf,kp0+sl_cur);
  WAIT_BAR(2);
  s16x4 vlo[8],vhi[8]; u32x4 pw0,pw1,pw2,pw3;
  #define PKW(P,B) cvtpk_s(P[B],P[B+1])
  #define PAF(k) __builtin_bit_cast(bf16x8,pw##k)
  #define VFR(i) (bf16x8){vlo[i][0],vlo[i][1],vlo[i][2],vlo[i][3],vhi[i][0],vhi[i][1],vhi[i][2],vhi[i][3]}
  #define PIN(x) asm volatile("":"+v"(x))
  #define MX3(a,b,c) __builtin_fmaxf(__builtin_fmaxf((a),(b)),(c))
  #define GAPA(MF,A0,A1,A2,A3,W0,W1,PW) do{ MF; sacc+=A0; sacc+=A1; sacc+=A2; sacc+=A3; PIN(sacc); W0; W1; PIN(PW); SBAR(); }while(0)
  #define EX(v) __builtin_amdgcn_exp2f(v)
  #define GAPB(MF,X,B) do{ MF; X[B]=EX(X[B]); X[B+1]=EX(X[B+1]); X[B+2]=EX(X[B+2]); X[B+3]=EX(X[B+3]); PIN(X); SBAR(); }while(0)
  #define VRD(i) do{ vlo[i]=vtr(vp_+(((i)>>2)*4096+((i)&3)*1024)); vhi[i]=vtr(vp_+(((i)>>2)*4096+((i)&3)*1024+512)); }while(0)
  #define KRD(G,j) do{ if(G){ kload2(kf,kp0+sl_next,j); SBAR(); } }while(0)
  #define STEP(C0,C1,P0,P1,t,GK,GV,GL) do{ SBAR(); \
    const lds_cptr vp_=vp0+sl_prev; \
    VRD(0); SBAR(); float sacc=(P0[0]+P0[1]); \
    GAPA(C0=__builtin_amdgcn_mfma_f32_32x32x16_bf16(kf[0],qr[0],CINIT,0,0,0), P0[2],P0[3],P0[4],P0[5],     pw0[0]=PKW(P0,0), pw0[1]=PKW(P0,2), pw0); \
    VRD(4); SBAR(); GAPA(C1=__builtin_amdgcn_mfma_f32_32x32x16_bf16(kf[1],qr[0],CINIT,0,0,0), P0[6],P0[7],P0[8],P0[9],     pw0[2]=PKW(P0,4), pw0[3]=PKW(P0,6), pw0); \
    VRD(1); SBAR(); GAPA(C0=__builtin_amdgcn_mfma_f32_32x32x16_bf16(kf[2],qr[1],C0,0,0,0),   P0[10],P0[11],P0[12],P0[13], pw1[0]=PKW(P0,8), pw1[1]=PKW(P0,10), pw1); \
    VRD(5); SBAR(); GAPA(C1=__builtin_amdgcn_mfma_f32_32x32x16_bf16(kf[3],qr[1],C1,0,0,0),   P0[14],P0[15],P1[0],P1[1],   pw1[2]=PKW(P0,12),pw1[3]=PKW(P0,14), pw1); \
    VRD(2); SBAR(); GAPA(C0=__builtin_amdgcn_mfma_f32_32x32x16_bf16(kf[4],qr[2],C0,0,0,0),   P1[2],P1[3],P1[4],P1[5],     pw2[0]=PKW(P1,0), pw2[1]=PKW(P1,2), pw2); \
    VRD(6); SBAR(); GAPA(C1=__builtin_amdgcn_mfma_f32_32x32x16_bf16(kf[5],qr[2],C1,0,0,0),   P1[6],P1[7],P1[8],P1[9],     pw2[2]=PKW(P1,4), pw2[3]=PKW(P1,6), pw2); \
    VRD(3); SBAR(); GAPA(C0=__builtin_amdgcn_mfma_f32_32x32x16_bf16(kf[6],qr[3],C0,0,0,0),   P1[10],P1[11],P1[12],P1[13], pw3[0]=PKW(P1,8), pw3[1]=PKW(P1,10), pw3); \
    VRD(7); SBAR(); GAPA(C1=__builtin_amdgcn_mfma_f32_32x32x16_bf16(kf[7],qr[3],C1,0,0,0),   P1[14],P1[15],0.f,0.f,       pw3[2]=PKW(P1,12),pw3[3]=PKW(P1,14), pw3); \
    l_reg+=sacc; \
    if(GK){DMA_K((t)+3,sl_cur);} if(GV){DMA_V((t)+1,sl_next);} \
    HOOK(C0,C1,t); CMASK(C0,C1,t); \
    { float a=MX3(C0[0],C0[1],C1[0]),b=MX3(C0[2],C0[3],C1[1]); a=MX3(a,C1[2],C1[3]); \
      _Pragma("unroll") for(int r=4;r<16;r+=4){a=MX3(a,C0[r],C0[r+1]);b=MX3(b,C0[r+2],C0[r+3]);a=MX3(a,C1[r],C1[r+1]);b=MX3(b,C1[r+2],C1[r+3]);} \
      float rm=__builtin_fmaxf(a,b); { auto rr=__builtin_amdgcn_permlane32_swap(__float_as_uint(rm),__float_as_uint(rm),false,false); rm=__builtin_fmaxf(__uint_as_float(rr[0]),__uint_as_float(rr[1])); } \
      resc=false; \
      if(__builtin_expect(__any(rm>(float)THRL),0)){ const float dl=__builtin_fmaxf(rm,0.f); mhat+=dl; \
        _Pragma("unroll") for(int r=0;r<16;++r){C0[r]-=dl;C1[r]-=dl;} \
        if(MODE==0){ _Pragma("unroll") for(int r=0;r<16;++r)negm[r]=-mhat; asm volatile("":"+v"(negm)); } \
        const float f=__builtin_amdgcn_exp2f(-dl); l_reg*=f; if(hi==0)wsf[r32]=f; resc=true; } } \
    SBAR(); \
    GAPB(o[0]=__builtin_amdgcn_mfma_f32_32x32x16_bf16(PAF(0),VFR(0),o[0],0,0,0), C0,0); \
    GAPB(o[1]=__builtin_amdgcn_mfma_f32_32x32x16_bf16(PAF(0),VFR(4),o[1],0,0,0), C0,4); \
    KRD(GL,0); GAPB(o[0]=__builtin_amdgcn_mfma_f32_32x32x16_bf16(PAF(1),VFR(1),o[0],0,0,0), C0,8); \
    KRD(GL,1); GAPB(o[1]=__builtin_amdgcn_mfma_f32_32x32x16_bf16(PAF(1),VFR(5),o[1],0,0,0), C0,12); \
    KRD(GL,2); GAPB(o[0]=__builtin_amdgcn_mfma_f32_32x32x16_bf16(PAF(2),VFR(2),o[0],0,0,0), C1,0); \
    KRD(GL,3); GAPB(o[1]=__builtin_amdgcn_mfma_f32_32x32x16_bf16(PAF(2),VFR(6),o[1],0,0,0), C1,4); \
    GAPB(o[0]=__builtin_amdgcn_mfma_f32_32x32x16_bf16(PAF(3),VFR(3),o[0],0,0,0), C1,8); \
    GAPB(o[1]=__builtin_amdgcn_mfma_f32_32x32x16_bf16(PAF(3),VFR(7),o[1],0,0,0), C1,12); \
    }while(0)
  int t=1;
  #undef CMASK
  #define CMASK(P0,P1,t) do{}while(0)
  for(;t+5<NT;t+=2){
    STEP(pB0,pB1,pA0,pA1,t,true,true,true);     WAIT_BAR(2); RESC(); ROT();
    STEP(pA0,pA1,pB0,pB1,t+1,true,true,true);   WAIT_BAR(2); RESC(); ROT();
  }
  #undef CMASK
  #define CMASK(P0,P1,t) do{int jb_=(t)-(NT-4); if(jb_>=0)cmask(P0,P1,jb_,qrel,hi);}while(0)
  #define ENDW(tt) do{ if((tt)+3<NT){WAIT_BAR(2);} else if((tt)+2<NT){WAIT_BAR(1);} else {WAIT_BAR(0);} }while(0)
  for(;t+1<NT;t+=2){
    STEP(pB0,pB1,pA0,pA1,t,(t+3<NT),(t+1<NT),(t+1<NT));       ENDW(t);   RESC(); ROT();
    STEP(pA0,pA1,pB0,pB1,t+1,(t+4<NT),(t+2<NT),(t+2<NT));     ENDW(t+1); RESC(); ROT();
  }
  STEP(pB0,pB1,pA0,pA1,NT-1,false,false,false); RESC();
  { float sacc=pB0[0]+pB0[1]; _Pragma("unroll") for(int r=2;r<16;++r)sacc+=pB0[r]; _Pragma("unroll") for(int r=0;r<16;++r)sacc+=pB1[r]; l_reg+=sacc;
    pw0=(u32x4){PKW(pB0,0),PKW(pB0,2),PKW(pB0,4),PKW(pB0,6)};pw1=(u32x4){PKW(pB0,8),PKW(pB0,10),PKW(pB0,12),PKW(pB0,14)};pw2=(u32x4){PKW(pB1,0),PKW(pB1,2),PKW(pB1,4),PKW(pB1,6)};pw3=(u32x4){PKW(pB1,8),PKW(pB1,10),PKW(pB1,12),PKW(pB1,14)};
    SBAR(); const int vb0=(int)(lds0+LDS_V)+((lane>>4)&1)*32+(lane&3)*8+(4*hi+((lane&15)>>2))*64; pv(o,vb0+sl_cur,PAF(0),PAF(1),PAF(2),PAF(3)); }
  #undef PKW
  #undef PAF
  #undef VFR
  #undef PIN
  #undef MX3
  #undef GAPA
  #undef GAPB
  #undef EX
  #undef VRD
  #undef KRD
  #undef STEP
  #undef ENDW
  {auto rr=__builtin_amdgcn_permlane32_swap(__float_as_uint(l_reg),__float_as_uint(l_reg),false,false);l_reg=__uint_as_float(rr[0])+__uint_as_float(rr[1]);}
  if(hi==0)wsf[32+r32]=l_reg;asm volatile("s_waitcnt lgkmcnt(0)":::"memory");
  float rli[16];
  #pragma unroll
  for(int r=0;r<16;++r)rli[r]=__builtin_amdgcn_rcpf(wsf[32+crow(r,hi)]);
  bf16*Ow=O+(rowbase+q0+wid*QBLK)*DM+h*D;
  { bf16*stg=(bf16*)(shm+LDS_OST)+wid*2048;
    #pragma unroll
    for(int r=0;r<16;++r){const int orow=crow(r,hi);
      #pragma unroll
      for(int d0=0;d0<2;++d0)stg[orow*64+d0*32+r32]=__float2bfloat16(o[d0][r]*rli[r]);}
    asm volatile("s_waitcnt lgkmcnt(0)":::"memory");
    #pragma unroll
    for(int i=0;i<4;++i){const int row=i*8+(lane>>3),ch=lane&7; const u32x4 v=*(const u32x4*)(stg+row*64+ch*8); ATTN_STORE16(Ow+(long)row*DM+ch*8,v);} }
  asm volatile("s_waitcnt lgkmcnt(0)\n\ts_barrier":::"memory");
  #undef DMA_K
  #undef DMA_V
  #undef CMASK
  #undef HOOK
  #undef CINIT
  #undef START
  #undef RESC
  #undef ROT
}
#undef SBAR
#undef WAIT_BAR
}

namespace attn_body {
#define SBAR() __builtin_amdgcn_sched_barrier(0)
__device__ __forceinline__ void mem_unit(int brow,int bglob,int h,int qb,bf16*QO,const bf16*__restrict__ MK,char*shm,const int wave_s){
  const int tid=tid_from_wave(wave_s),lane=tid&63,r32=lane&31,hi=lane>>5; const int wid=wave_s;
  const lds_cptr shm3=(lds_cptr)shm; const unsigned lds0=(unsigned)(uintptr_t)shm;
  typedef __attribute__((address_space(3))) u32x4 lds_u32x4;
  const bf16*kg=MK+(size_t)(bglob*256)*MKP+h*128; const bf16*vg=kg+512;
  {
    const bf16*kp=kg+(size_t)(tid&255)*MKP+(tid>>8)*8; const lds_cptr kl=shm3+((tid&255)>>6)*16384+(tid>>8)*1024+(tid&63)*16;
    const bf16*vp=vg+(size_t)(tid>>2)*MKP+(tid&3)*8; const lds_cptr vl=shm3+65536+((tid>>2)>>6)*16384+((tid>>2)&63)*64+(tid&3)*16;
    #pragma unroll 2
    for(int i=0;i<8;i+=4){ u32x4 t0=*(const u32x4*)(kp+(i+0)*16),t1=*(const u32x4*)(kp+(i+1)*16),t2=*(const u32x4*)(kp+(i+2)*16),t3=*(const u32x4*)(kp+(i+3)*16);
      *(lds_u32x4*)(kl+(i+0)*2048)=t0; *(lds_u32x4*)(kl+(i+1)*2048)=t1; *(lds_u32x4*)(kl+(i+2)*2048)=t2; *(lds_u32x4*)(kl+(i+3)*2048)=t3; }
    #pragma unroll 2
    for(int i=0;i<8;i+=2){ u32x4 t0=*(const u32x4*)(vp+(i>>1)*32),t1=*(const u32x4*)(vp+(size_t)128*MKP+(i>>1)*32);
      *(lds_u32x4*)(vl+(i>>1)*4096)=t0; *(lds_u32x4*)(vl+32768+(i>>1)*4096)=t1; } }
  bf16*Qw=QO+(size_t)(brow+qb*256+wid*32)*DM+h*128;
  bf16x8 qr[8];
  #pragma unroll
  for(int d0=0;d0<8;++d0)qr[d0]=*reinterpret_cast<const bf16x8*>(&Qw[(size_t)r32*DM+d0*16+hi*8]);
  asm volatile("s_waitcnt vmcnt(0) lgkmcnt(0)\n\ts_barrier":::"memory");
  lds_f32* wsf=(lds_f32*)(shm3+131072)+wid*64;
  float m=-INFINITY,l_reg=0.f; f32x16 o[4]; o[0]=f32x16{};o[1]=f32x16{};o[2]=f32x16{};o[3]=f32x16{};
  const int vbl=((lane>>4)&1)*32+(lane&3)*8+(4*hi+((lane&15)>>2))*64;
  #pragma unroll 1
  for(int kt=0;kt<4;++kt){
    f32x16 p0=f32x16{},p1=f32x16{};
    const lds_cptr kb=shm3+kt*16384+hi*1024+r32*16;
    #pragma unroll
    for(int d0=0;d0<8;++d0){
      const bf16x8 b0=*(const __attribute__((address_space(3))) bf16x8*)(kb+d0*2048);
      const bf16x8 b1=*(const __attribute__((address_space(3))) bf16x8*)(kb+d0*2048+512);
      p0=__builtin_amdgcn_mfma_f32_32x32x16_bf16(b0,qr[d0],p0,0,0,0); p1=__builtin_amdgcn_mfma_f32_32x32x16_bf16(b1,qr[d0],p1,0,0,0); }
    float rm=p0[0];
    #pragma unroll
    for(int r=0;r<16;++r){rm=__builtin_fmaxf(rm,p0[r]);rm=__builtin_fmaxf(rm,p1[r]);}
    rm=max_x32(rm);
    const float mn=__builtin_fmaxf(m,rm); const float alpha=__builtin_amdgcn_exp2f(m-mn); m=mn;
    float sacc=0.f;
    #pragma unroll
    for(int r=0;r<16;++r){p0[r]=__builtin_amdgcn_exp2f(p0[r]-mn);p1[r]=__builtin_amdgcn_exp2f(p1[r]-mn);sacc+=p0[r]+p1[r];}
    l_reg=l_reg*alpha+sacc;
    if(hi==0)wsf[r32]=alpha;
    asm volatile("s_waitcnt lgkmcnt(0)":::"memory");
    #pragma unroll
    for(int r=0;r<16;++r){ const float a=wsf[crow(r,hi)]; o[0][r]*=a;o[1][r]*=a;o[2][r]*=a;o[3][r]*=a; }
    u32x4 pw0,pw1,pw2,pw3;
    pw0=(u32x4){cvtpk_s(p0[0],p0[1]),cvtpk_s(p0[2],p0[3]),cvtpk_s(p0[4],p0[5]),cvtpk_s(p0[6],p0[7])};
    pw1=(u32x4){cvtpk_s(p0[8],p0[9]),cvtpk_s(p0[10],p0[11]),cvtpk_s(p0[12],p0[13]),cvtpk_s(p0[14],p0[15])};
    pw2=(u32x4){cvtpk_s(p1[0],p1[1]),cvtpk_s(p1[2],p1[3]),cvtpk_s(p1[4],p1[5]),cvtpk_s(p1[6],p1[7])};
    pw3=(u32x4){cvtpk_s(p1[8],p1[9]),cvtpk_s(p1[10],p1[11]),cvtpk_s(p1[12],p1[13]),cvtpk_s(p1[14],p1[15])};
    const int vb=(int)(lds0+65536+kt*16384)+vbl;
    SBAR(); pv(o,vb,__builtin_bit_cast(bf16x8,pw0),__builtin_bit_cast(bf16x8,pw1),__builtin_bit_cast(bf16x8,pw2),__builtin_bit_cast(bf16x8,pw3));
    pv(o+2,vb+8192,__builtin_bit_cast(bf16x8,pw0),__builtin_bit_cast(bf16x8,pw1),__builtin_bit_cast(bf16x8,pw2),__builtin_bit_cast(bf16x8,pw3));
    asm volatile("s_waitcnt lgkmcnt(0)":::"memory");
  }
  l_reg=sum_x32(l_reg);
  if(hi==0)wsf[32+r32]=l_reg; asm volatile("s_waitcnt lgkmcnt(0)":::"memory");
  asm volatile("s_waitcnt lgkmcnt(0)\n\ts_barrier":::"memory");
  { typedef __attribute__((address_space(3))) unsigned short lds_u16;
    lds_u16* stg=(lds_u16*)(shm3+wid*8192);
    #pragma unroll
    for(int r=0;r<16;++r){ const float rl=__builtin_amdgcn_rcpf(wsf[32+crow(r,hi)]); const int orow=crow(r,hi);
      #pragma unroll
      for(int db=0;db<4;++db){ const unsigned w=cvtpk_s(o[db][r]*rl,0.f); stg[orow*128+db*32+r32]=(unsigned short)w; } }
    asm volatile("s_waitcnt lgkmcnt(0)":::"memory");
    #pragma unroll
    for(int i=0;i<8;++i){ const int row=i*4+(lane>>4),ch=lane&15; const u32x4 v=*(const lds_u32x4*)(shm3+wid*8192+row*256+ch*16); *(u32x4*)(Qw+(size_t)row*DM+ch*8)=v; } }
  asm volatile("s_waitcnt lgkmcnt(0)\n\ts_barrier":::"memory");
}
#undef SBAR
}

constexpr int NWAVES = 8;
constexpr int TOK = 32768, DMOD = 1024, FF = 2816, SEQL = 4096, PP = 5184, MKP = 2112, DIN = 8200, NLAYER = 2;
constexpr int C_QA = 0, C_PU = 512, C_QC = 1024, C_MQ = 1536, C_KA = 2048, C_VA = 2560, C_KC = 3072, C_VC = 3584, C_H = 4096, C_Z = 2048;
constexpr float RMS_EPS = 1e-6f;
constexpr float LOG2E = 1.4426950408889634f;
constexpr float C2_64 = 0.125f * LOG2E, C2_128 = 0.08838834764831845f * LOG2E;
constexpr size_t MiB = 1u << 20;
constexpr size_t WS_FOXF = 1 * MiB, WS_CK2 = 2 * MiB, WS_KMEAN = 3 * MiB, WS_MEMN = 4 * MiB, WS_MEMKV = 8 * MiB, WS_POOLED = 17 * MiB, WS_W = 49 * MiB,
                 WS_PROJ = 173 * MiB, WS_HF = WS_PROJ + 176 * MiB, WS_END = 497 * MiB;
static_assert((size_t)2048 * MKP * 2 <= 9 * MiB && (size_t)TOK * PP * 2 <= 324 * MiB && (size_t)TOK * FF * 2 <= 176 * MiB && (size_t)TOK * 512 * 2 <= 32 * MiB && (size_t)256 * 65536 * 2 <= 32 * MiB, "workspace map");
constexpr size_t E_FFN_IN = (size_t)2 * FF * DMOD, E_FFN_OUT = (size_t)DMOD * FF, E_WIN = (size_t)8192 * DMOD, E_WBR = (size_t)4 * DMOD * 1024  , E_WOUT = (size_t)DMOD * DMOD, E_WPOOL = (size_t)512 * 512;
constexpr size_t O_FFN1_IN = 0, O_FFN1_OUT = O_FFN1_IN + E_FFN_IN, O_WIN = O_FFN1_OUT + E_FFN_OUT, O_WBR = O_WIN + E_WIN, O_WOUT = O_WBR + E_WBR, O_WPOOL = O_WOUT + E_WOUT,
                 O_FFN2_IN = O_WPOOL + E_WPOOL, O_FFN2_OUT = O_FFN2_IN + E_FFN_IN, E_LAYER = O_FFN2_OUT + E_FFN_OUT, O_WMEM = NLAYER * E_LAYER, E_WTOTAL = O_WMEM + (size_t)2048 * 1024;
static_assert(E_WTOTAL * 2 <= 124 * MiB, "weights fit");
constexpr int RING_BYTES = 131072, LDS_BYTES = 147456;

#define LAS __attribute__((address_space(3)))
typedef unsigned short bf16;
typedef unsigned v4u __attribute__((ext_vector_type(4)));
typedef float f32x4 __attribute__((ext_vector_type(4)));
#define LDS_WAIT() asm volatile("s_waitcnt lgkmcnt(0)" ::: "memory")
__device__ __forceinline__ unsigned pk2(float lo, float hi) { return pg8::cvt_pk_bf16(lo, hi); }
__device__ __forceinline__ float wave_sum(float v) {
    v += xor_lane<1>(v); v += xor_lane<2>(v); v += xor_lane<4>(v); v += xor_lane<8>(v); v += xor_lane<16>(v); v = sum_x32(v);
    return v;
}
__device__ __forceinline__ void ld8(const bf16* p, float (&v)[8]) { const v4u w = *(const v4u*)p;
    v[0] = pg8::bf_lo(w.x); v[1] = pg8::bf_hi(w.x); v[2] = pg8::bf_lo(w.y); v[3] = pg8::bf_hi(w.y); v[4] = pg8::bf_lo(w.z); v[5] = pg8::bf_hi(w.z); v[6] = pg8::bf_lo(w.w); v[7] = pg8::bf_hi(w.w); }
__device__ __forceinline__ void un8(const v4u& w, float (&v)[8]) {
    v[0] = pg8::bf_lo(w.x); v[1] = pg8::bf_hi(w.x); v[2] = pg8::bf_lo(w.y); v[3] = pg8::bf_hi(w.y); v[4] = pg8::bf_lo(w.z); v[5] = pg8::bf_hi(w.z); v[6] = pg8::bf_lo(w.w); v[7] = pg8::bf_hi(w.w); }
__device__ __forceinline__ void st8(bf16* p, const float (&v)[8]) { v4u w; w.x = pk2(v[0], v[1]); w.y = pk2(v[2], v[3]); w.z = pk2(v[4], v[5]); w.w = pk2(v[6], v[7]); *(v4u*)p = w; }

__device__ __forceinline__ void tr_item(const float* W, int ldw, int srccol0, int k0, bf16* WT, int ldk, int dstrow0, const float* kscale, LAS float* scr, int lane) {
#pragma unroll
    for (int i = 0; i < 32; ++i) { const int kk = 2 * i + (lane >> 5); float v = W[(size_t)(k0 + kk) * ldw + srccol0 + (lane & 31)]; if (kscale) v *= kscale[k0 + kk]; scr[kk * 33 + (lane & 31)] = v; }
    LDS_WAIT(); asm volatile("" ::: "memory");
    const int c = lane & 7;
#pragma unroll
    for (int j = 0; j < 4; ++j) { const int n = (lane >> 3) + 8 * j; const LAS float* s = scr + (8 * c) * 33 + n;
        v4u o; o.x = pk2(s[0 * 33], s[1 * 33]); o.y = pk2(s[2 * 33], s[3 * 33]); o.z = pk2(s[4 * 33], s[5 * 33]); o.w = pk2(s[6 * 33], s[7 * 33]);
        *(v4u*)(WT + (size_t)(dstrow0 + n) * ldk + k0 + 8 * c) = o; }
    LDS_WAIT(); asm volatile("" ::: "memory");
}

template <bool FOX> __device__ __forceinline__ void norm_rows(const float* x, const float* gain, bf16* H, int ldh, int nrows, const float* w_in_l, float* foxf, int gw, int NGW, int lane) {
    f32x4 gv[4];
#pragma unroll
    for (int j = 0; j < 4; ++j) gv[j] = gain ? *((const f32x4*)gain + lane + 64 * j) : (f32x4){1.f, 1.f, 1.f, 1.f};
    f32x4 wf[FOX ? 16 : 1][2];
    if (FOX) {
#pragma unroll
        for (int j = 0; j < 4; ++j)
#pragma unroll
            for (int c = 0; c < 4; ++c) { const float* p = w_in_l + (size_t)(256 * j + 4 * lane + c) * DIN + 3072; wf[j * 4 + c][0] = *(const f32x4*)p; wf[j * 4 + c][1] = *(const f32x4*)(p + 4); }
    }
    f32x4 nv[4];
    if (gw < nrows) { const f32x4* xr = (const f32x4*)(x + (size_t)gw * DMOD) + lane;
#pragma unroll
        for (int j = 0; j < 4; ++j) nv[j] = xr[64 * j]; }
    for (int m = gw; m < nrows; m += NGW) {
        f32x4 v[4]; float s2 = 0.f;
#pragma unroll
        for (int j = 0; j < 4; ++j) { v[j] = nv[j]; s2 += (v[j].x * v[j].x + v[j].y * v[j].y) + (v[j].z * v[j].z + v[j].w * v[j].w); }
        if (m + NGW < nrows) { const f32x4* xr = (const f32x4*)(x + (size_t)(m + NGW) * DMOD) + lane;
#pragma unroll
            for (int j = 0; j < 4; ++j) nv[j] = xr[64 * j]; }
        const float rstd = 1.0f / sqrtf(wave_sum(s2) * (1.f / DMOD) + RMS_EPS);
        unsigned long long* o8 = (unsigned long long*)(H + (size_t)m * ldh) + lane;
#pragma unroll
        for (int j = 0; j < 4; ++j) { v[j] = v[j] * rstd * gv[j]; o8[64 * j] = (unsigned long long)pk2(v[j].x, v[j].y) | ((unsigned long long)pk2(v[j].z, v[j].w) << 32); }
        if (FOX) {
            float acc[8];
#pragma unroll
            for (int h = 0; h < 8; ++h) acc[h] = 0.f;
#pragma unroll
            for (int j = 0; j < 4; ++j)
#pragma unroll
                for (int c = 0; c < 4; ++c) { const float hv = v[j][c];
#pragma unroll
                    for (int h = 0; h < 4; ++h) { acc[h] += hv * wf[j * 4 + c][0][h]; acc[4 + h] += hv * wf[j * 4 + c][1][h]; } }
#pragma unroll
            for (int h = 0; h < 8; ++h) acc[h] = wave_sum(acc[h]);
            if (lane < 8) { const float sv = lane == 0 ? acc[0] : lane == 1 ? acc[1] : lane == 2 ? acc[2] : lane == 3 ? acc[3] : lane == 4 ? acc[4] : lane == 5 ? acc[5] : lane == 6 ? acc[6] : acc[7];
                foxf[(size_t)((m >> 12) * 8 + lane) * SEQL + (m & (SEQL - 1))] = sv; }
        }
    }
}

template <int GL> __device__ __forceinline__ void gnorm8(float (&v)[8], const float (&g)[8], float scale) {
    float ss = 0.f;
#pragma unroll
    for (int i = 0; i < 8; ++i) ss += v[i] * v[i];
    ss += xor_lane<1>(ss); ss += xor_lane<2>(ss); ss += xor_lane<4>(ss); if (GL > 8) ss += xor_lane<8>(ss);
    const float r = scale / sqrtf(ss * (1.0f / (8 * GL)) + RMS_EPS);
#pragma unroll
    for (int i = 0; i < 8; ++i) v[i] = v[i] * r * g[i];
}
__device__ __forceinline__ void rot8(float (&v)[8], const float (&cc)[8], const float (&sn)[8], int li) {
    float oth[8];
#pragma unroll
    for (int i = 0; i < 8; ++i) oth[i] = xor_lane<1>(v[i]);
    if (li == 0) {
#pragma unroll
        for (int i = 0; i < 8; ++i) v[i] = v[i] * cc[i] - oth[i] * sn[i];
    } else if (li == 1) {
#pragma unroll
        for (int i = 0; i < 8; ++i) v[i] = v[i] * cc[i] + oth[i] * sn[i];
    }
}

#define XB_TMO      128
#define XB_XCNT(j)  (256  + 64 * (j))
#define XB_XSUB(j)  (1280 + 64 * (j))
#define XB_XGEN(j)  (2304 + 64 * (j))
#define XB_TOP      3328
#define XB_TOPGEN   3392
#define XCD_BAR_WORDS 3456
#define XB_SPIN_CAP (1u << 18)

__device__ __forceinline__ unsigned xb_ld(unsigned* p)              { return __hip_atomic_load(p, __ATOMIC_RELAXED, __HIP_MEMORY_SCOPE_AGENT); }
__device__ __forceinline__ unsigned xb_add(unsigned* p, unsigned v) { return __hip_atomic_fetch_add(p, v, __ATOMIC_RELAXED, __HIP_MEMORY_SCOPE_AGENT); }
__device__ __forceinline__ unsigned xb_xcc_id() { return (unsigned)__builtin_amdgcn_s_getreg((3 << 11) | 20) & 0xFu; }
#define XB_SPIN(cond, bar) do { unsigned _sp = 0; while (cond) { __builtin_amdgcn_s_sleep(1); \
    if ((++_sp & 255u) == 0u) { if (xb_ld(&(bar)[XB_TMO])) break; if (_sp > XB_SPIN_CAP) { atomicAdd(&(bar)[XB_TMO], 1u); break; } } } } while (0)

struct XcdBarrier {
    unsigned* bar; unsigned x;
    volatile LAS unsigned* st;
};

__device__ __forceinline__ XcdBarrier xcd_barrier_post(unsigned* bar, volatile LAS unsigned* st, int wave_s) {
    XcdBarrier b; b.bar = bar; b.x = xb_xcc_id(); b.st = st;
    if (tid_from_wave(wave_s) == 0) (void)xb_add(&bar[XB_XCNT(b.x)], 1u);
    return b;
}
__device__ __forceinline__ void xcd_barrier_complete(unsigned* bar, unsigned x, unsigned& nloc, unsigned& nx) {
    const unsigned G = gridDim.x * gridDim.y * gridDim.z;
    unsigned sum, cnt, mine, sp = 0u;
    for (;;) {
        sum = 0u; cnt = 0u; mine = 0u;
#pragma unroll
        for (unsigned j = 0; j < 16; ++j) { const unsigned c = xb_ld(&bar[XB_XCNT(j)]); sum += c; cnt += (c > 0u) ? 1u : 0u; mine = (j == x) ? c : mine; }
        if (sum == G) break;
        __builtin_amdgcn_s_sleep(1);
        if ((++sp & 255u) == 0u) { if (xb_ld(&bar[XB_TMO])) break; if (sp > XB_SPIN_CAP) { atomicAdd(&bar[XB_TMO], 1u); break; } }
    }
    nloc = mine > 0u ? mine : 1u; nx = cnt > 0u ? cnt : 1u;
}

__device__ __forceinline__ void xcd_barrier(const XcdBarrier& b, int wave_s) {
    asm volatile("s_waitcnt vmcnt(0)" ::: "memory");
    __syncthreads();
    if (tid_from_wave(wave_s) == 0) {
        unsigned* bar = b.bar;
        __builtin_amdgcn_s_waitcnt(0);
        unsigned nloc = b.st[0], nx = b.st[1];
        if (nloc == 0u) { xcd_barrier_complete(bar, b.x, nloc, nx); b.st[0] = nloc; b.st[1] = nx; }
        const unsigned old = xb_add(&bar[XB_XSUB(b.x)], 1u);
        const unsigned gen = old / nloc;
        if (old + 1u == (gen + 1u) * nloc) {
            __builtin_amdgcn_fence(__ATOMIC_RELEASE, "agent");
            asm volatile("s_waitcnt vmcnt(0)" ::: "memory");
            const unsigned og = xb_add(&bar[XB_TOP], 1u);
            const unsigned tg = og / nx;
            if (og + 1u == (tg + 1u) * nx) xb_add(&bar[XB_TOPGEN], 1u);
            else XB_SPIN(xb_ld(&bar[XB_TOPGEN]) == tg, bar);
            __builtin_amdgcn_fence(__ATOMIC_ACQUIRE, "agent");
            xb_add(&bar[XB_XGEN(b.x)], 1u);
            asm volatile("s_waitcnt vmcnt(0)" ::: "memory");
        } else {
            XB_SPIN(xb_ld(&bar[XB_XGEN(b.x)]) == gen, bar);
            __builtin_amdgcn_fence(__ATOMIC_ACQUIRE, "agent");
            asm volatile("s_waitcnt vmcnt(0)" ::: "memory");
        }
    }
    __syncthreads();
}

__device__ __forceinline__ float logsig(float x) { return fminf(x, 0.f) - 0.6931471805599453f * __builtin_amdgcn_logf(1.0f + __builtin_amdgcn_exp2f(-1.4426950408889634f * fabsf(x))); }
struct Args { const float* in[24]; float* out; unsigned char* ws; };

__global__ void __launch_bounds__(NWAVES * 64, 2) hybrid_fwd(Args args) {
    extern __shared__ __attribute__((aligned(16))) unsigned char lds[];
    cg::grid_group grid = cg::this_grid();
    LAS unsigned char* ldsl = (LAS unsigned char*)lds;
    const int G = gridDim.x, bx = blockIdx.x;
    const int vcu = (G % 8 == 0) ? (bx % 8) * (G / 8) + bx / 8 : bx;
    const int NGW = G * NWAVES;
    const int wave_s = __builtin_amdgcn_readfirstlane((int)threadIdx.x >> 6);
    if (tid_from_wave(wave_s) < 2) ((volatile LAS unsigned*)(ldsl + 133120))[tid_from_wave(wave_s)] = 0u;
    __syncthreads();
    XcdBarrier xbar = xcd_barrier_post((unsigned*)args.ws, (volatile LAS unsigned*)(ldsl + 133120), wave_s);
#define GSYNC() xcd_barrier(xbar, wave_s)
#define LANE_STATE() const int tid = tid_from_wave(wave_s), lane = tid & 63, wave = wave_s, gw = vcu * NWAVES + wave; (void)tid; (void)lane; (void)gw
    unsigned char* ws = args.ws;
    const float* x_in = args.in[0]; const float* mem = args.in[1]; const int* positions = (const int*)args.in[2];
    float* xout = args.out;
    float* FOXF = (float*)(ws + WS_FOXF); float* CK2 = (float*)(ws + WS_CK2); float* KMEAN = (float*)(ws + WS_KMEAN);
    bf16* MEMN = (bf16*)(ws + WS_MEMN); bf16* MEMKV = (bf16*)(ws + WS_MEMKV); bf16* POOLED = (bf16*)(ws + WS_POOLED);
    bf16* HF = (bf16*)(ws + WS_HF); bf16* WB = (bf16*)(ws + WS_W); bf16* PROJ = (bf16*)(ws + WS_PROJ); bf16* HID = PROJ; bf16* GS = POOLED;

#ifdef PROBE_PHASE
    unsigned long long probe_acc = 0, probe_t0 = 0;
#define PB(k) do { if ((k) == PROBE_PHASE) probe_t0 = __builtin_amdgcn_s_memrealtime(); } while (0)
#define PE(k) do { if ((k) == PROBE_PHASE) probe_acc += __builtin_amdgcn_s_memrealtime() - probe_t0; } while (0)
#else
#define PB(k) do {} while (0)
#define PE(k) do {} while (0)
#endif
    PB(0);
    {
        LANE_STATE();
        LAS float* scr = (LAS float*)(ldsl + wave * 16384);
        constexpr int I_FI = 16 * 176, I_FO = 44 * 32, I_WI = 16 * 256, I_BR = 4 * 8 * 32, I_WO = 16 * 32, I_MEM = 16 * 32;
        constexpr int I_LAYER = 2 * I_FI + 2 * I_FO + I_WI + I_BR + I_WO + I_MEM;
        for (int it = gw; it < NLAYER * I_LAYER; it += NGW) {
            const int l = it / I_LAYER; int r = it % I_LAYER; bf16* WL = WB + (size_t)l * E_LAYER;
            if (r < 2 * I_FI) { const int which = r / I_FI; r %= I_FI; const float* W = args.in[which ? 22 : 4] + (size_t)l * DMOD * 2 * FF;
                const int kb = r / 176, nb = r % 176, n0 = 32 * nb, isu = n0 / FF, j = n0 % FF;
                tr_item(W, 2 * FF, n0, 64 * kb, WL + (which ? O_FFN2_IN : O_FFN1_IN), DMOD, 256 * (j / 128) + 128 * isu + (j % 128), nullptr, scr, lane); continue; }
            r -= 2 * I_FI;
            if (r < 2 * I_FO) { const int which = r / I_FO; r %= I_FO; const float* W = args.in[which ? 23 : 5] + (size_t)l * FF * DMOD;
                const int kb = r / 32, nb = r % 32;
                tr_item(W, DMOD, 32 * nb, 64 * kb, WL + (which ? O_FFN2_OUT : O_FFN1_OUT), FF, 32 * nb, nullptr, scr, lane); continue; }
            r -= 2 * I_FO;
            if (r < I_WI) { const float* W = args.in[7] + (size_t)l * DMOD * DIN; const int kb = r / 256, nb = r % 256, n0 = 32 * nb;
                int src;
                if (n0 >= 4096) src = n0 + 8; else { const int sec = n0 >> 9, o = n0 & 511;
                    const int sb = sec == 0 ? 0 : sec == 1 ? 3080 : sec == 2 ? 1536 : sec == 3 ? 3592 : sec == 4 ? 512 : sec == 5 ? 1024 : sec == 6 ? 2048 : 2560; src = sb + o; }
                tr_item(W, DIN, src, 64 * kb, WL + O_WIN, DMOD, n0, nullptr, scr, lane); continue; }
            r -= I_WI;
            if (r < I_BR) { const int br = r / 256; r %= 256; const float* W = args.in[19] + ((size_t)l * 4 + br) * 512 * DMOD; const int kb = r / 32, nb = r % 32;
                tr_item(W, DMOD, 32 * nb, 64 * kb, WL + O_WBR + (size_t)br * DMOD * 1024, 1024, 32 * nb, nullptr, scr, lane); continue; }
            r -= I_BR;
            if (r < I_WO) { const float* W = args.in[20] + (size_t)l * DMOD * DMOD; const int kb = r / 32, nb = r % 32;
                tr_item(W, DMOD, 32 * nb, 64 * kb, WL + O_WOUT, DMOD, 32 * nb, nullptr, scr, lane); continue; }
            r -= I_WO;
            { const float* W = args.in[14] + (size_t)l * DMOD * 1024; const int kb = r / 32, nb = r % 32;
                tr_item(W, 1024, 32 * nb, 64 * kb, WB + O_WMEM, DMOD, l * 1024 + 32 * nb, args.in[13] + l * DMOD, scr, lane); }
        }
        for (int e = gw * 64 + lane; e < NLAYER * 512 * 64; e += NGW * 64) {
            const int l = e / (512 * 64), r = e % (512 * 64), n = r / 64, k8 = (r % 64) * 8, g = n >> 7;
            float v[8];
            if ((k8 >> 7) == g) { const float* mp = args.in[17] + (((size_t)l * 4 + g) * 128 + (k8 & 127)) * 128 + (n & 127); const float sc = args.in[18][l * 512 + n];
#pragma unroll
                for (int i = 0; i < 8; ++i) v[i] = mp[i * 128] * sc;
            } else {
#pragma unroll
                for (int i = 0; i < 8; ++i) v[i] = 0.f;
            }
            st8(WB + (size_t)l * E_LAYER + O_WPOOL + (size_t)n * 512 + k8, v);
        }
        norm_rows<false>(mem, nullptr, MEMN, DMOD, 2048, nullptr, nullptr, gw, NGW, lane);
        norm_rows<false>(x_in, args.in[3], HF, DMOD, TOK, nullptr, nullptr, gw, NGW, lane);
    }
    GSYNC();
    if (args.out == nullptr) grid.sync();
    PE(0);

    for (int st = 0; st < 3 * NLAYER; ++st) {
        const int l = st / 3, kind = st % 3;
        bf16* WL = WB + (size_t)l * E_LAYER;
        if (kind != 1) {
            const bool second = (kind == 2);
            const float* xsrc = (st == 0) ? x_in : xout;
            if (st != 0) { PB(1); LANE_STATE(); norm_rows<false>(xsrc, args.in[second ? 21 : 3] + l * DMOD, HF, DMOD, TOK, nullptr, nullptr, gw, NGW, lane); GSYNC(); PE(1); }
            PB(2);
            { pg8::Gemm g{HF, WL + (second ? O_FFN2_IN : O_FFN1_IN), TOK, 2 * FF, DMOD, DMOD, DMOD, 0, 0}; pg8::StaticOrder S; S.init(TOK, 2 * FF, G, bx);
              pg8::EpiSwiglu E{HID, FF};

#ifndef NO_G0
              pg8::gemm_phase<pg8::EpiSwiglu, pg8::StaticOrder, true, true>(ldsl, g, S, E, wave_s);
#endif
              }
            GSYNC(); PE(2); PB(3);
            { pg8::Gemm g{HID, WL + (second ? O_FFN2_OUT : O_FFN1_OUT), TOK, DMOD, FF, FF, FF, 0, 0}; pg8::StaticOrder S; S.init(TOK, DMOD, G, bx);
              pg8::EpiResid E{xsrc, xout, DMOD, 0.5f};

#ifndef NO_G1
              pg8::gemm_phase<pg8::EpiResid, pg8::StaticOrder, true, true>(ldsl, g, S, E, wave_s);
#endif
              }
            GSYNC(); PE(3);
        } else {
            const float* w_in_l = args.in[7] + (size_t)l * DMOD * DIN;
            PB(4);
#ifndef NO_FOXNORM
            { LANE_STATE(); norm_rows<true>(xout, args.in[6] + l * DMOD, PROJ + C_H, PP, TOK, w_in_l, FOXF, gw, NGW, lane); }
#endif
            if (l == 0) {
                pg8::Gemm g{MEMN, WB + O_WMEM, 2048, 2048, DMOD, DMOD, DMOD, 0, 0}; pg8::StaticOrder S; S.init(2048, 2048, G, bx);
                pg8::EpiBf16 E{MEMKV, MKP};

#ifndef NO_G2
              pg8::gemm_phase<pg8::EpiBf16, pg8::StaticOrder, true, true>(ldsl, g, S, E, wave_s);
#endif

            }
            GSYNC(); PE(4);
            {
                PB(5);
                { pg8::Gemm g{PROJ + C_H, WL + O_WIN, TOK, 4096, DMOD, PP, DMOD, 0, 0}; pg8::StaticOrder S; S.init(TOK, 4096, G, bx);
                  pg8::EpiBf16 E{PROJ, PP};

#ifndef NO_G3
              pg8::gemm_phase<pg8::EpiBf16, pg8::StaticOrder, true, true>(ldsl, g, S, E, wave_s);
#endif
              }
                GSYNC(); PE(5); PB(6);
#ifndef NO_PP1
                {
                    LANE_STATE();
                    if (gw < 64) {
                        const int bl = gw >> 3, h = gw & 7; const float bfv = args.in[8][l * 8 + h];
                        const f32x4* f4 = (const f32x4*)(FOXF + (size_t)(bl * 8 + h) * SEQL + lane * 64);
                        f32x4 lf[16]; float run = 0.f;
#pragma unroll
                        for (int i = 0; i < 16; ++i) lf[i] = f4[i];
#pragma unroll
                        for (int i = 0; i < 16; ++i) {
#pragma unroll
                            for (int e = 0; e < 4; ++e) { lf[i][e] = logsig(lf[i][e] + bfv); run += lf[i][e]; } }
                        float incl = run;
#pragma unroll
                        for (int o = 1; o < 64; o <<= 1) { const float t = __builtin_bit_cast(float, __builtin_amdgcn_ds_bpermute((lane - o) << 2, __builtin_bit_cast(int, incl))); if (lane >= o) incl += t; }
                        run = incl - run;
                        f32x4* cp = (f32x4*)(CK2 + (size_t)(bl * 8 + h) * SEQL + lane * 64);
#pragma unroll
                        for (int i = 0; i < 16; ++i) { f32x4 o4;
#pragma unroll
                            for (int e = 0; e < 4; ++e) { run += lf[i][e]; o4[e] = -run * LOG2E; }
                            cp[i] = o4; }
                    }
                    {
                        float gk[8];
#pragma unroll
                        for (int i = 0; i < 8; ++i) gk[i] = args.in[16][l * 128 + (lane & 15) * 8 + i];
                        for (int r = gw; r < 2048; r += NGW) { bf16* p = MEMKV + (size_t)r * MKP + l * 1024 + lane * 8; float v[8]; ld8(p, v); gnorm8<16>(v, gk, 1.0f); st8(p, v); }
                    }
                    float gqa[8], gka[8], gqc[8], gkc[8], gmq[8];
#pragma unroll
                    for (int i = 0; i < 8; ++i) { const int d = (lane & 7) * 8 + i; gqa[i] = args.in[9][l * 64 + d]; gka[i] = args.in[10][l * 64 + d]; gqc[i] = args.in[11][l * 64 + d]; gkc[i] = args.in[12][l * 64 + d];
                        gmq[i] = args.in[15][l * 128 + (lane & 15) * 8 + i]; }
                    const float invf = powf(500000.0f, -(float)(lane & 7) * 0.125f);
                    LAS float* scr = (LAS float*)ldsl;
                    for (int it = vcu; it < TOK / 64; it += G) {
                        const int m0 = it * 64;
                        float kacc[8];
#pragma unroll
                        for (int i = 0; i < 8; ++i) kacc[i] = 0.f;
                        for (int tt = 0; tt < 8; ++tt) {
                            const int m = m0 + wave * 8 + tt, s = m & (SEQL - 1);
                            bf16* row = PROJ + (size_t)m * PP;
                            const int w = 2 << (lane >> 4); const int cnt = (s + 1 < w) ? s + 1 : w;
                            const v4u rqa = *(const v4u*)(row + C_QA + lane * 8), rka = *(const v4u*)(row + C_KA + lane * 8), rqc = *(const v4u*)(row + C_QC + lane * 8),
                                      rkc = *(const v4u*)(row + C_KC + lane * 8), rmq = *(const v4u*)(row + C_MQ + lane * 8), rpu = *(const v4u*)(row + C_PU + lane * 8);
                            v4u rw[15];
#pragma unroll
                            for (int j = 1; j < 16; ++j) rw[j - 1] = (j < cnt) ? *(const v4u*)(row - (size_t)j * PP + C_PU + lane * 8) : (v4u){0u, 0u, 0u, 0u};
                            const float ang = (float)positions[m] * invf;
                            const float cs = cosf(ang), sn = sinf(ang);
                            float cc[8], ss[8];
#pragma unroll
                            for (int i = 0; i < 8; ++i) { cc[i] = __builtin_bit_cast(float, __builtin_amdgcn_readlane(__builtin_bit_cast(int, cs), i)); ss[i] = __builtin_bit_cast(float, __builtin_amdgcn_readlane(__builtin_bit_cast(int, sn), i)); }
                            float v[8];
                            un8(rqa, v); gnorm8<8>(v, gqa, 1.0f); rot8(v, cc, ss, lane & 7);
#pragma unroll
                            for (int i = 0; i < 8; ++i) v[i] *= C2_64;
                            st8(row + C_QA + lane * 8, v);
                            un8(rka, v); gnorm8<8>(v, gka, 1.0f); rot8(v, cc, ss, lane & 7); st8(row + C_KA + lane * 8, v);
#pragma unroll
                            for (int i = 0; i < 8; ++i) kacc[i] += v[i];
                            un8(rqc, v); gnorm8<8>(v, gqc, C2_64); st8(row + C_QC + lane * 8, v);
                            un8(rkc, v); gnorm8<8>(v, gkc, 1.0f); st8(row + C_KC + lane * 8, v);
                            un8(rmq, v); gnorm8<16>(v, gmq, C2_128); st8(row + C_MQ + lane * 8, v);
                            {
                                float u0[8], sm[8]; un8(rpu, u0);
#pragma unroll
                                for (int i = 0; i < 8; ++i) sm[i] = u0[i];
#pragma unroll
                                for (int j = 0; j < 15; ++j) { float t[8]; un8(rw[j], t);
#pragma unroll
                                    for (int i = 0; i < 8; ++i) sm[i] += t[i]; }
                                const float inv = 1.0f / (float)cnt;
#pragma unroll
                                for (int i = 0; i < 8; ++i) sm[i] = sm[i] * inv - u0[i];
                                st8(POOLED + (size_t)m * 512 + lane * 8, sm);
                            }
                        }
#pragma unroll
                        for (int i = 0; i < 8; ++i) scr[wave * 512 + lane * 8 + i] = kacc[i];
                        __syncthreads();
                        { float t = 0.f;
#pragma unroll
                          for (int w8 = 0; w8 < 8; ++w8) t += scr[w8 * 512 + tid];
                          const int bl = m0 >> 12, s0 = m0 & (SEQL - 1);
                          KMEAN[(size_t)((bl * 16 + (s0 >> 8)) * 4 + ((s0 >> 6) & 3)) * 512 + tid] = t * (1.0f / 256.0f); }
                        __syncthreads();
                    }
                }
#endif
                GSYNC(); PE(6); PB(7);
                {
                    float skipb;
                    { float mq = 0.f, mk = 0.f; for (int i = 0; i < 64; ++i) { mq = fmaxf(mq, fabsf(args.in[11][l * 64 + i])); mk = fmaxf(mk, fabsf(args.in[12][l * 64 + i])); }
                      skipb = 2.0f * (C2_64 * 64.0f * 1.01f * mq * mk) + 48.0f; *(volatile LAS float*)(ldsl + 133136) = skipb; __syncthreads(); }
                    for (int ui = vcu; ui < 512; ui += G)
                        for (int uj = 0; uj < 2; ++uj) {
                            const int pp = ui, bh = pp >> 3, s8 = pp & 7, bl = bh >> 3, h = bh & 7;
                            const int qb = (uj & 1) ? s8 : 15 - s8;
#ifndef NO_ATTN0
                            attn_body::attn_unit<0, 8>(bl, h, qb, (const attn_body::bf16*)(PROJ + C_QA), (const attn_body::bf16*)(PROJ + C_KA), (const attn_body::bf16*)(PROJ + C_VA), (attn_body::bf16*)(PROJ + C_QA), KMEAN, (char*)lds, wave_s, 0.f);
#endif
                        }
                    for (int u = vcu; u < 512; u += G) { const int bl = u >> 6, h = (u >> 4) & 3, qb = u & 15;
#ifndef NO_MEM
                        attn_body::mem_unit(bl * SEQL, bl, h, qb, (attn_body::bf16*)(PROJ + C_MQ), (const attn_body::bf16*)(MEMKV + l * 1024), (char*)lds, wave_s);
#endif
                    }
                    { pg8::Gemm g{POOLED, WL + O_WPOOL, TOK, 512, 512, 512, 512, 0, 0}; pg8::StaticOrder S; S.init(TOK, 512, G, bx);
                      pg8::EpiBf16 E{PROJ + C_PU, PP};

#ifndef NO_G4
              pg8::gemm_phase<pg8::EpiBf16, pg8::StaticOrder, true, true>(ldsl, g, S, E, wave_s);
#endif
              }
                    {
                        for (int guard = 0; guard < 1200; ++guard) {
                            { int z_; asm volatile("s_mov_b32 %0, 0" : "=s"(z_));
                              if (tid_from_wave(wave_s) == 0) *(volatile LAS unsigned*)(ldsl + 133144 + z_) = atomicAdd((unsigned*)args.ws + 3584 + 64 * l + z_, 1u); }
                            __syncthreads();
                            const int fu = __builtin_amdgcn_readfirstlane((int)*(volatile LAS unsigned*)(ldsl + 133144));
                            __syncthreads();
                            if (fu >= 1024) break;
                            const int qb = 15 - (fu >> 6), bh = fu & 63, bl = bh >> 3, h = bh & 7;
#ifndef NO_ATTN1
                            attn_body::attn_unit<1, 24>(bl, h, qb, (const attn_body::bf16*)(PROJ + C_QC), (const attn_body::bf16*)(PROJ + C_KC), (const attn_body::bf16*)(PROJ + C_VC), (attn_body::bf16*)(PROJ + C_QC), CK2, (char*)lds, wave_s, 0.f);
#endif
                        }
                    }
                }
                GSYNC(); PE(7); PB(8);
                { pg8::Gemm g{PROJ, WL + O_WBR, TOK, DMOD, 512, PP, DMOD, 512, (long)DMOD * DMOD, PROJ + C_H, WL + O_WIN + (size_t)4096 * DMOD, DMOD, 0, (long)DMOD * DMOD}; pg8::StaticOrder S; S.init(TOK, DMOD, G, bx, 8);
                  pg8::EpiGate E{PROJ + C_Z, PP, GS + (size_t)bx * 65536};

#ifndef NO_G5
              pg8::gemm_phase<pg8::EpiGate, pg8::StaticOrder, false, true>(ldsl, g, S, E, wave_s);
#endif
              }
                GSYNC(); PE(8); PB(9);
                { pg8::Gemm g{PROJ + C_Z, WL + O_WOUT, TOK, DMOD, DMOD, PP, DMOD, 0, 0}; pg8::StaticOrder S; S.init(TOK, DMOD, G, bx);
                  float* xo = xout;
                  pg8::EpiResid E{xo, xo, DMOD, 1.0f};

#ifndef NO_G6
              pg8::gemm_phase<pg8::EpiResid, pg8::StaticOrder, true, true>(ldsl, g, S, E, wave_s);
#endif
              }
                GSYNC(); PE(9);
            }
        }
    }
#ifdef PROBE_SYNC
    for (int i = 0; i < 20; ++i) GSYNC();
#endif
#ifdef PROBE_PHASE
    { const unsigned long long tend = __builtin_amdgcn_s_memrealtime() + probe_acc; while (__builtin_amdgcn_s_memrealtime() < tend) __builtin_amdgcn_s_sleep(8); }
#endif
}

extern "C" void kernel_launch(void* const* d_in, const int* in_sizes, int n_in, void* d_out, int out_size, void* d_ws, size_t ws_size, hipStream_t stream) {
    static int grid = 0;
    if (grid == 0) {
        if (n_in != 24 || out_size != TOK * DMOD || ws_size < WS_END) { fprintf(stderr, "kernel_launch: unexpected shapes (n_in %d out %d ws %zu)\n", n_in, out_size, ws_size); grid = -1; return; }
        int dev = 0, cus = 0, per_cu = 0;
        hipGetDevice(&dev); hipDeviceGetAttribute(&cus, hipDeviceAttributeMultiprocessorCount, dev);
        hipFuncSetAttribute((const void*)hybrid_fwd, hipFuncAttributeMaxDynamicSharedMemorySize, LDS_BYTES);
        hipOccupancyMaxActiveBlocksPerMultiprocessor(&per_cu, (const void*)hybrid_fwd, NWAVES * 64, LDS_BYTES);
        (void)hipGetLastError();
        if (per_cu < 1) per_cu = 1;
        grid = cus;
    }
    if (grid < 0) return;
    if (hipMemsetAsync(d_ws, 0, 16384, stream) != hipSuccess) { fprintf(stderr, "kernel_launch: memset of the barrier words failed\n"); return; }
    Args a{};
    for (int i = 0; i < 24; ++i) a.in[i] = (const float*)d_in[i];
    a.out = (float*)d_out; a.ws = (unsigned char*)d_ws;
    void* kargs[] = {&a};
    hipError_t e = hipLaunchCooperativeKernel((const void*)hybrid_fwd, dim3(grid), dim3(NWAVES * 64), kargs, LDS_BYTES, stream);
    if (e != hipSuccess) fprintf(stderr, "cooperative launch failed: %s (grid %d)\n", hipGetErrorString(e), grid);
}
```

```cpp
#include <hip/hip_runtime.h>
#include <hip/hip_cooperative_groups.h>
#include <hip/hip_bf16.h>
#include <cstdio>
#include <cstdint>
#include <cmath>
namespace cg = cooperative_groups;

__device__ __forceinline__ int tid_from_wave(int wave_s) { int l; asm volatile("v_mbcnt_lo_u32_b32 %0, -1, 0\n\tv_mbcnt_hi_u32_b32 %0, -1, %0" : "=v"(l)); return wave_s * 64 + l; }

template <int M> __device__ __forceinline__ float xor_lane(float v) {
    if constexpr (M < 32) { return __builtin_bit_cast(float, __builtin_amdgcn_ds_swizzle(__builtin_bit_cast(int, v), (M << 10) | 0x1f)); }
    else { const unsigned u = __builtin_bit_cast(unsigned, v); auto rr = __builtin_amdgcn_permlane32_swap(u, u, false, false); const unsigned a = rr[0], b = rr[1]; return __builtin_bit_cast(float, a == u ? b : a); }
}
__device__ __forceinline__ float sum_x32(float v) { const unsigned u = __builtin_bit_cast(unsigned, v); auto rr = __builtin_amdgcn_permlane32_swap(u, u, false, false); return __builtin_bit_cast(float, (unsigned)rr[0]) + __builtin_bit_cast(float, (unsigned)rr[1]); }
__device__ __forceinline__ float max_x32(float v) { const unsigned u = __builtin_bit_cast(unsigned, v); auto rr = __builtin_amdgcn_permlane32_swap(u, u, false, false); return __builtin_fmaxf(__builtin_bit_cast(float, (unsigned)rr[0]), __builtin_bit_cast(float, (unsigned)rr[1])); }

namespace pg8 {
#define PG8_LAS __attribute__((address_space(3)))
typedef unsigned short bf16_t;
typedef short bf16x8 __attribute__((ext_vector_type(8)));
typedef float f32x4 __attribute__((ext_vector_type(4)));
typedef unsigned u32x4 __attribute__((ext_vector_type(4)));
constexpr int BM = 256, BK = 64, HALF = 128, HTB = HALF * BK * 2  , STAGE_BYTES = 8 * HTB, NXCD = 8, WGM = 8;

__host__ __device__ __forceinline__ int lds_byte(int r, int c) { const int st = (r >> 4) * 2 + (c >> 5), rr = r & 15, cc = c & 31, ob = rr * 64 + cc * 2; return st * 1024 + (ob ^ (((ob >> 9) & 1) << 5)); }
__host__ __device__ __forceinline__ void stage_rc(int b, int& R, int& C) { const int st = b / 1024, sb = b % 1024, swz = sb ^ (((sb >> 9) & 1) << 5); R = (st >> 1) * 16 + swz / 64; C = (st & 1) * 32 + (swz % 64) / 2; }
__host__ __device__ __forceinline__ int perm32(int rho) { const int n = rho >> 4, i = rho & 15; return 8 * (i >> 2) + 4 * n + (i & 3); }

struct Unit { int pm, pn, z; };
struct Gemm { const bf16_t* A; const bf16_t* Bt; int M, N, K, lda, ldb; long azoff, bzoff;
    const bf16_t* A2 = nullptr; const bf16_t* Bt2 = nullptr; int K2 = 0; long a2z = 0, b2z = 0; };
__device__ __forceinline__ void unit_ptrs(const Gemm& g, const Unit& u, size_t tstepA, size_t tstepB, const char*& pa, const char*& pb, int& ntu) {
    if (g.K2 != 0) { const int zb = u.z >> 1;
        if (u.z & 1) { pa = (const char*)g.A2 + (size_t)u.pm * tstepA + (size_t)zb * g.a2z * 2; pb = (const char*)g.Bt2 + (size_t)u.pn * tstepB + (size_t)zb * g.b2z * 2; ntu = g.K2 / BK; }
        else { pa = (const char*)g.A + (size_t)u.pm * tstepA + (size_t)zb * g.azoff * 2; pb = (const char*)g.Bt + (size_t)u.pn * tstepB + (size_t)zb * g.bzoff * 2; ntu = g.K / BK; }
    } else { pa = (const char*)g.A + (size_t)u.pm * tstepA + (size_t)u.z * g.azoff * 2; pb = (const char*)g.Bt + (size_t)u.pn * tstepB + (size_t)u.z * g.bzoff * 2; ntu = g.K / BK; }
}

struct StaticOrder {
    int nM, nN, nwg, G, c, NZ;
    __host__ __device__ void init(int M, int N, int G_, int c_, int NZ_ = 1) { nM = M / BM; nN = N / BM; nwg = nM * nN; G = G_; c = c_; NZ = NZ_; }
    __host__ __device__ bool next(int i, Unit& u) const {
        const int zi = i % NZ, ii = i / NZ;
        const long L = (long)ii * G + c; if (L >= nwg) return false;
        int wgid = (int)L; { const int q = nwg / NXCD, r = nwg % NXCD, xcd = wgid % NXCD, off = wgid / NXCD; wgid = (xcd < r ? xcd * (q + 1) : r * (q + 1) + (xcd - r) * q) + off; }
        const int nig = WGM * nN, gid = wgid / nig, fm = gid * WGM, gsz = (nM - fm) < WGM ? (nM - fm) : WGM;
        u.pm = fm + ((wgid % nig) % gsz); u.pn = (wgid % nig) / gsz; u.z = zi; return true;
    }
    __device__ __forceinline__ void a_ready(const Unit&) const {}
    __device__ __forceinline__ void done(const Unit&) const {}
};

__device__ __forceinline__ unsigned cvt_pk_bf16(float lo, float hi) { unsigned r; asm volatile("v_cvt_pk_bf16_f32 %0, %1, %2" : "=v"(r) : "v"(lo), "v"(hi)); return r; }
__device__ __forceinline__ float bf_lo(unsigned w) { return __uint_as_float(w << 16); }
__device__ __forceinline__ float bf_hi(unsigned w) { return __uint_as_float(w & 0xffff0000u); }
__device__ __forceinline__ float sigm(float x) { return __builtin_amdgcn_rcpf(1.0f + __builtin_amdgcn_exp2f(-1.4426950408889634f * x)); }

struct EpiBf16 {
    static constexpr bool PERM = true, AFTER_DRAIN = false;
    bf16_t* O; int ldc;
    __device__ __forceinline__ void operator()(const f32x4 (&acc)[2][2][4][2], const Unit& u, int wr, int wc, int fr, int fq) const {
        const int row0 = u.pm * BM + wr * 64 + fr, col0 = u.pn * BM + wc * 32 + 8 * fq;
#pragma unroll
        for (int ai = 0; ai < 2; ++ai)
#pragma unroll
            for (int m = 0; m < 4; ++m) { bf16_t* rowp = O + (size_t)(row0 + ai * HALF + m * 16) * ldc + col0;
#pragma unroll
                for (int bj = 0; bj < 2; ++bj) { const f32x4 v0 = acc[ai][bj][m][0], v1 = acc[ai][bj][m][1];
                    u32x4 w; w.x = cvt_pk_bf16(v0[0], v0[1]); w.y = cvt_pk_bf16(v0[2], v0[3]); w.z = cvt_pk_bf16(v1[0], v1[1]); w.w = cvt_pk_bf16(v1[2], v1[3]);
                    *(u32x4*)(rowp + bj * HALF) = w; } }
    }
};
struct EpiSwiglu {
    static constexpr bool PERM = true, AFTER_DRAIN = false;
    bf16_t* O; int ldc;
    __device__ __forceinline__ void operator()(const f32x4 (&acc)[2][2][4][2], const Unit& u, int wr, int wc, int fr, int fq) const {
        const int row0 = u.pm * BM + wr * 64 + fr, col0 = u.pn * HALF + wc * 32 + 8 * fq;
#pragma unroll
        for (int ai = 0; ai < 2; ++ai)
#pragma unroll
            for (int m = 0; m < 4; ++m) { bf16_t* rowp = O + (size_t)(row0 + ai * HALF + m * 16) * ldc + col0;
                float r[8];
#pragma unroll
                for (int n = 0; n < 2; ++n)
#pragma unroll
                    for (int e = 0; e < 4; ++e) { const float g = acc[ai][0][m][n][e], uu = acc[ai][1][m][n][e]; r[n * 4 + e] = g * sigm(g) * uu; }
                u32x4 w; w.x = cvt_pk_bf16(r[0], r[1]); w.y = cvt_pk_bf16(r[2], r[3]); w.z = cvt_pk_bf16(r[4], r[5]); w.w = cvt_pk_bf16(r[6], r[7]);
                *(u32x4*)rowp = w; }
    }
};
struct EpiResid {
    static constexpr bool PERM = false, AFTER_DRAIN = false;
    const float* base; float* out; int ldc; float scale;
    __device__ __forceinline__ void operator()(const f32x4 (&acc)[2][2][4][2], const Unit& u, int wr, int wc, int fr, int fq) const {
        const int row0 = u.pm * BM + wr * 64 + fr, col0 = u.pn * BM + wc * 32 + 4 * fq;
#pragma unroll
        for (int ai = 0; ai < 2; ++ai) {
            f32x4 bs[4][2][2];
#pragma unroll
            for (int m = 0; m < 4; ++m) { const size_t off = (size_t)(row0 + ai * HALF + m * 16) * ldc + col0;
#pragma unroll
                for (int bj = 0; bj < 2; ++bj)
#pragma unroll
                    for (int n = 0; n < 2; ++n) bs[m][bj][n] = *(const f32x4*)(base + off + bj * HALF + n * 16); }
#pragma unroll
            for (int m = 0; m < 4; ++m) { const size_t off = (size_t)(row0 + ai * HALF + m * 16) * ldc + col0;
#pragma unroll
                for (int bj = 0; bj < 2; ++bj)
#pragma unroll
                    for (int n = 0; n < 2; ++n) *(f32x4*)(out + off + bj * HALF + n * 16) = bs[m][bj][n] + acc[ai][bj][m][n] * scale; }
            asm volatile("" ::: "memory");
        }
    }
};
__device__ __forceinline__ u32x4 ld16_l2(const bf16_t* p) { const unsigned long long* q = (const unsigned long long*)p;
    const unsigned long long a = __hip_atomic_load(q, __ATOMIC_RELAXED, __HIP_MEMORY_SCOPE_AGENT), b = __hip_atomic_load(q + 1, __ATOMIC_RELAXED, __HIP_MEMORY_SCOPE_AGENT);
    return (u32x4){(unsigned)a, (unsigned)(a >> 32), (unsigned)b, (unsigned)(b >> 32)}; }
struct EpiGate {
    static constexpr bool PERM = true, AFTER_DRAIN = false;
    bf16_t* Z; int ldz; bf16_t* GS;
    __device__ __forceinline__ void operator()(const f32x4 (&acc)[2][2][4][2], const Unit& u, int wr, int wc, int fr, int fq) const {
        int fr_ = fr, fq_ = fq; asm volatile("" : "+v"(fr_), "+v"(fq_));
        const int rl0 = wr * 64 + fr_, cl0 = wc * 32 + 8 * fq_, row0 = u.pm * BM + rl0, col0 = u.pn * BM + cl0, zb = u.z >> 1;
        if (!(u.z & 1)) {
#pragma unroll
            for (int ai = 0; ai < 2; ++ai)
#pragma unroll
                for (int m = 0; m < 4; ++m)
#pragma unroll
                    for (int bj = 0; bj < 2; ++bj) { const f32x4 v0 = acc[ai][bj][m][0], v1 = acc[ai][bj][m][1];
                        u32x4 w; w.x = cvt_pk_bf16(v0[0], v0[1]); w.y = cvt_pk_bf16(v0[2], v0[3]); w.z = cvt_pk_bf16(v1[0], v1[1]); w.w = cvt_pk_bf16(v1[2], v1[3]);
                        *(u32x4*)(GS + (size_t)(rl0 + ai * HALF + m * 16) * 256 + cl0 + bj * HALF) = w; }
            return;
        }
#pragma unroll
        for (int ai = 0; ai < 2; ++ai) {
            u32x4 gv[4][2], zv[4][2];
#pragma unroll
            for (int m = 0; m < 4; ++m)
#pragma unroll
                for (int bj = 0; bj < 2; ++bj) gv[m][bj] = ld16_l2(GS + (size_t)(rl0 + ai * HALF + m * 16) * 256 + cl0 + bj * HALF);
            if (zb > 0) {
#pragma unroll
                for (int m = 0; m < 4; ++m)
#pragma unroll
                    for (int bj = 0; bj < 2; ++bj) zv[m][bj] = ld16_l2(Z + (size_t)(row0 + ai * HALF + m * 16) * ldz + col0 + bj * HALF);
            }
#pragma unroll
            for (int m = 0; m < 4; ++m)
#pragma unroll
                for (int bj = 0; bj < 2; ++bj) {
                    const u32x4 g4 = gv[m][bj]; const f32x4 v0 = acc[ai][bj][m][0], v1 = acc[ai][bj][m][1];
                    float o[8];
                    o[0] = bf_lo(g4.x) * sigm(v0[0]); o[1] = bf_hi(g4.x) * sigm(v0[1]); o[2] = bf_lo(g4.y) * sigm(v0[2]); o[3] = bf_hi(g4.y) * sigm(v0[3]);
                    o[4] = bf_lo(g4.z) * sigm(v1[0]); o[5] = bf_hi(g4.z) * sigm(v1[1]); o[6] = bf_lo(g4.w) * sigm(v1[2]); o[7] = bf_hi(g4.w) * sigm(v1[3]);
                    if (zb > 0) { const u32x4 z4 = zv[m][bj];
                        o[0] += bf_lo(z4.x); o[1] += bf_hi(z4.x); o[2] += bf_lo(z4.y); o[3] += bf_hi(z4.y); o[4] += bf_lo(z4.z); o[5] += bf_hi(z4.z); o[6] += bf_lo(z4.w); o[7] += bf_hi(z4.w); }
                    u32x4 w; w.x = cvt_pk_bf16(o[0], o[1]); w.y = cvt_pk_bf16(o[2], o[3]); w.z = cvt_pk_bf16(o[4], o[5]); w.w = cvt_pk_bf16(o[6], o[7]);
                    *(u32x4*)(Z + (size_t)(row0 + ai * HALF + m * 16) * ldz + col0 + bj * HALF) = w; }
            asm volatile("" ::: "memory");
        }
    }
};

template <class Epi, class Sched, bool ALIGN_EPI = false, bool SP2 = false>
__device__ __forceinline__ void gemm_phase(PG8_LAS unsigned char* lds, const Gemm g, const Sched& S, const Epi& E, const int wave_s) {
    int tid_ = tid_from_wave(wave_s);
    const int tid = tid_, wid = __builtin_amdgcn_readfirstlane(tid >> 6), lane = tid & 63, wr = wid >> 2, wc = wid & 3, fr = lane & 15, fq = lane >> 4;
    const int lda = g.lda, ldb = g.ldb;
    unsigned voffA[2], voffB[2];
#pragma unroll
    for (int i = 0; i < 2; ++i) { int R, C; stage_rc(tid * 16 + i * 8192, R, C); const int Rb = Epi::PERM ? ((R & ~31) + perm32(R & 31)) : R;
        voffA[i] = (unsigned)(R * lda + C) * 2u; voffB[i] = (unsigned)(Rb * ldb + C) * 2u; }
    const size_t kstep = (size_t)(BK * 2);
    const size_t hstepA = (size_t)HALF * lda * 2, hstepB = (size_t)HALF * ldb * 2;
    const size_t tstepA = 2 * hstepA, tstepB = 2 * hstepB;
    const unsigned ldsw = (unsigned)wid * 1024u;
    const int aoff = lds_byte(wr * 64 + fr, fq * 8), boff = lds_byte(wc * 32 + fr, fq * 8);
#define PG8_SA(b, h) (((b) * 2 + (h)) * HTB)
#define PG8_SB(b, h) ((4 + (b) * 2 + (h)) * HTB)
#define PG8_STAGE(bufoff, gbase, voff) do { _Pragma("unroll") for (int _i = 0; _i < 2; ++_i) \
        __builtin_amdgcn_global_load_lds((const unsigned*)((const char*)(gbase) + (voff)[_i]), (PG8_LAS unsigned*)(lds + (bufoff) + ldsw + _i * 8192), 16, 0, 0); } while (0)
#define PG8_LDA(dst, b, h) do { _Pragma("unroll") for (int m = 0; m < 4; ++m) _Pragma("unroll") for (int k = 0; k < 2; ++k) dst[m][k] = *(const PG8_LAS bf16x8*)(lds + PG8_SA(b, h) + aoff + m * 2048 + k * 1024); } while (0)
#define PG8_LDB(dst, b, h) do { _Pragma("unroll") for (int n = 0; n < 2; ++n) _Pragma("unroll") for (int k = 0; k < 2; ++k) dst[n][k] = *(const PG8_LAS bf16x8*)(lds + PG8_SB(b, h) + boff + n * 2048 + k * 1024); } while (0)
#define PG8_MMA(ai, bj, At, Bt) do { __builtin_amdgcn_s_setprio(1); _Pragma("unroll") for (int m = 0; m < 4; ++m) _Pragma("unroll") for (int n = 0; n < 2; ++n) _Pragma("unroll") for (int k = 0; k < 2; ++k) \
        acc[ai][bj][m][n] = __builtin_amdgcn_mfma_f32_16x16x32_bf16(Bt[n][k], At[m][k], acc[ai][bj][m][n], 0, 0, 0); __builtin_amdgcn_s_setprio(0); } while (0)
#define PG8_WAIT_V(n) asm volatile("s_waitcnt vmcnt(" #n ")" ::: "memory")
#define PG8_WAIT_L(n) asm volatile("s_waitcnt lgkmcnt(" #n ")" ::: "memory")
#define PG8_BAR __builtin_amdgcn_s_barrier()
#define PG8_SCHED __builtin_amdgcn_sched_barrier(0)
    Unit cur, nxt; int ui = 0;
    if (!S.next(0, cur)) return;
    f32x4 acc[2][2][4][2];
#pragma unroll
    for (int a = 0; a < 2; ++a)
#pragma unroll
        for (int b = 0; b < 2; ++b)
#pragma unroll
            for (int m = 0; m < 4; ++m)
#pragma unroll
                for (int n = 0; n < 2; ++n) acc[a][b][m][n] = (f32x4){0.f, 0.f, 0.f, 0.f};
    bf16x8 At[4][2], B0[2][2], B1[2][2];
    const char* cA; const char* cB; int nt; unit_ptrs(g, cur, tstepA, tstepB, cA, cB, nt);
    S.a_ready(cur);
    if constexpr (SP2) {
        PG8_STAGE(PG8_SB(0, 0), cB, voffB); PG8_STAGE(PG8_SB(0, 1), cB + hstepB, voffB); PG8_STAGE(PG8_SA(0, 0), cA, voffA); PG8_STAGE(PG8_SA(0, 1), cA + hstepA, voffA);
        if (wr == 1) PG8_BAR;
        PG8_WAIT_V(2); PG8_BAR;
        PG8_STAGE(PG8_SB(1, 0), cB + kstep, voffB); PG8_STAGE(PG8_SA(1, 0), cA + kstep, voffA); PG8_STAGE(PG8_SB(1, 1), cB + hstepB + kstep, voffB);
        PG8_WAIT_V(6); PG8_BAR;
    } else {
        PG8_STAGE(PG8_SB(0, 0), cB, voffB); PG8_STAGE(PG8_SA(0, 0), cA, voffA); PG8_STAGE(PG8_SB(0, 1), cB + hstepB, voffB); PG8_STAGE(PG8_SA(0, 1), cA + hstepA, voffA);
        if (wr == 1) PG8_BAR;
        PG8_WAIT_V(4); PG8_BAR;
        PG8_STAGE(PG8_SB(1, 0), cB + kstep, voffB); PG8_STAGE(PG8_SA(1, 0), cA + kstep, voffA); PG8_STAGE(PG8_SB(1, 1), cB + hstepB + kstep, voffB);
        PG8_WAIT_V(6); PG8_BAR;
    }
    for (;;) {
        const bool has_next = S.next(ui + 1, nxt);
        const char* nA = cA; const char* nB = cB; int ntn = nt; if (has_next) unit_ptrs(g, nxt, tstepA, tstepB, nA, nB, ntn);
        for (int t = 0; t < nt; t += 2) {
            const bool last = (t == nt - 2);
            const char* a1 = cA + (size_t)(t + 1) * kstep;
            const char* a2 = last ? nA : cA + (size_t)(t + 2) * kstep; const char* b2 = last ? nB : cB + (size_t)(t + 2) * kstep;
            const char* a3 = a2 + kstep; const char* b3 = b2 + kstep;
            if (last && has_next) S.a_ready(nxt);
            if constexpr (SP2) {
            PG8_LDB(B0, 0, 0); PG8_LDB(B1, 0, 1); PG8_SCHED; PG8_LDA(At, 0, 0); PG8_STAGE(PG8_SA(1, 1), a1 + hstepA, voffA);
            PG8_WAIT_V(8); PG8_WAIT_L(0); PG8_BAR; PG8_MMA(0, 0, At, B0); PG8_MMA(0, 1, At, B1); PG8_BAR; PG8_SCHED;
            PG8_LDA(At, 0, 1); PG8_STAGE(PG8_SB(0, 0), b2, voffB); PG8_STAGE(PG8_SB(0, 1), b2 + hstepB, voffB); PG8_STAGE(PG8_SA(0, 0), a2, voffA);
            PG8_WAIT_V(8); PG8_WAIT_L(0); PG8_BAR; PG8_MMA(1, 0, At, B0); PG8_MMA(1, 1, At, B1); PG8_BAR; PG8_SCHED;
            PG8_LDB(B0, 1, 0); PG8_LDB(B1, 1, 1); PG8_SCHED; PG8_LDA(At, 1, 0); PG8_STAGE(PG8_SA(0, 1), a2 + hstepA, voffA);
            PG8_WAIT_V(8); PG8_WAIT_L(0); PG8_BAR; PG8_MMA(0, 0, At, B0); PG8_MMA(0, 1, At, B1); PG8_BAR; PG8_SCHED;
            PG8_LDA(At, 1, 1); PG8_STAGE(PG8_SB(1, 0), b3, voffB); PG8_STAGE(PG8_SB(1, 1), b3 + hstepB, voffB); PG8_STAGE(PG8_SA(1, 0), a3, voffA);
            PG8_WAIT_V(8); PG8_WAIT_L(0); PG8_BAR; PG8_MMA(1, 0, At, B0); PG8_MMA(1, 1, At, B1); PG8_BAR; PG8_SCHED;
            } else {
            PG8_LDB(B0, 0, 0); PG8_SCHED; PG8_LDA(At, 0, 0); PG8_STAGE(PG8_SA(1, 1), a1 + hstepA, voffA);
            PG8_WAIT_L(8); PG8_BAR; PG8_WAIT_L(0); PG8_MMA(0, 0, At, B0); PG8_BAR; PG8_SCHED;
            PG8_LDB(B1, 0, 1); PG8_STAGE(PG8_SB(0, 0), b2, voffB);
            PG8_BAR; PG8_WAIT_L(0); PG8_MMA(0, 1, At, B1); PG8_BAR;
            PG8_LDA(At, 0, 1); PG8_STAGE(PG8_SA(0, 0), a2, voffA);
            PG8_BAR; PG8_WAIT_L(0); PG8_MMA(1, 0, At, B0); PG8_BAR; PG8_SCHED;
            PG8_STAGE(PG8_SB(0, 1), b2 + hstepB, voffB);
            PG8_WAIT_V(6); PG8_BAR; PG8_MMA(1, 1, At, B1); PG8_BAR;
            PG8_LDB(B0, 1, 0); PG8_SCHED; PG8_LDA(At, 1, 0); PG8_STAGE(PG8_SA(0, 1), a2 + hstepA, voffA);
            PG8_WAIT_L(8); PG8_BAR; PG8_WAIT_L(0); PG8_MMA(0, 0, At, B0); PG8_BAR; PG8_SCHED;
            PG8_LDB(B1, 1, 1); PG8_STAGE(PG8_SB(1, 0), b3, voffB);
            PG8_BAR; PG8_WAIT_L(0); PG8_MMA(0, 1, At, B1); PG8_BAR;
            PG8_LDA(At, 1, 1); PG8_STAGE(PG8_SA(1, 0), a3, voffA);
            PG8_BAR; PG8_WAIT_L(0); PG8_MMA(1, 0, At, B0); PG8_BAR; PG8_SCHED;
            PG8_STAGE(PG8_SB(1, 1), b3 + hstepB, voffB);
            PG8_WAIT_V(6); PG8_BAR; PG8_MMA(1, 1, At, B1); PG8_BAR;
            }
        }
        if constexpr (ALIGN_EPI) { if (wr == 0) PG8_BAR; }
        if constexpr (!Epi::AFTER_DRAIN) { E(acc, cur, wr, wc, fr, fq); S.done(cur); }
        if (!has_next) break;
#pragma unroll
        for (int a = 0; a < 2; ++a)
#pragma unroll
            for (int b = 0; b < 2; ++b)
#pragma unroll
                for (int m = 0; m < 4; ++m)
#pragma unroll
                    for (int n = 0; n < 2; ++n) acc[a][b][m][n] = (f32x4){0.f, 0.f, 0.f, 0.f};
        cur = nxt; cA = nA; cB = nB; nt = ntn; ++ui;
        if constexpr (ALIGN_EPI) { if (wr == 1) PG8_BAR; }
    }
    PG8_WAIT_V(0);
    if constexpr (!ALIGN_EPI) { if (wr == 0) PG8_BAR; }
    PG8_BAR;
    if constexpr (Epi::AFTER_DRAIN) { E.fused(acc, cur, wr, wc, fr, fq, lds, wid, lane); S.done(cur); }
#undef PG8_SA
#undef PG8_SB
#undef PG8_STAGE
#undef PG8_LDA
#undef PG8_LDB
#undef PG8_MMA
#undef PG8_WAIT_V
#undef PG8_WAIT_L
#undef PG8_BAR
#undef PG8_SCHED
}
}

namespace attn_body {
using bf16=__hip_bfloat16;
using bf16x8=__attribute__((ext_vector_type(8)))short;
using s16x4=__attribute__((ext_vector_type(4)))short;
using f32x16=__attribute__((ext_vector_type(16)))float;
using u32x4=__attribute__((ext_vector_type(4)))unsigned;
constexpr int SEQ=4096,D=64,DM=5184,MKP=2112;
constexpr int NW=8,QBLK=32,QB=QBLK*NW,KVBLK=64,NQB=SEQ/QB;
constexpr int ATTN_PITCH=DM, ATTN_UNIT_ROWS=QB;
__device__ __forceinline__ int crow(int r,int hi){return (r&3)+8*(r>>2)+4*hi;}
#define SBAR() __builtin_amdgcn_sched_barrier(0)
__device__ __forceinline__ void cmask(f32x16&p0,f32x16&p1,int jb,int qrel,int hi){
  const float NEG=-INFINITY; int kb=64*jb+4*hi;
  #pragma unroll
  for(int r=0;r<16;++r){int kv=kb+(r&3)+8*(r>>2); if(kv>qrel)p0[r]=NEG; if(kv+32>qrel)p1[r]=NEG;}
}

constexpr int NSLOT=3, SLOTB=8192;
constexpr int LDS_K=0, LDS_V=NSLOT*SLOTB, LDS_WS=2*NSLOT*SLOTB, LDS_OST=LDS_WS+NW*64*4, LDS_BYTES=LDS_OST+NW*4096, LDS_AUX=86016;
constexpr float C2=0.125f*1.4426950408889634f;
__device__ __forceinline__ void glds16(const void*gsrc,unsigned lds_dst){unsigned keep;
  asm volatile("s_mov_b32 %0, m0\n\ts_mov_b32 m0, %2\n\ts_nop 0\n\tglobal_load_lds_dwordx4 %1, off\n\ts_mov_b32 m0, %0":"=&s"(keep):"v"(gsrc),"s"(lds_dst):"memory");}
__device__ __forceinline__ float max3f(float a,float b,float c){float r;asm("v_max3_f32 %0, %1, %2, %3":"=v"(r):"v"(a),"v"(b),"v"(c));return r;}
__device__ __forceinline__ float max2f(float a,float b){float r;asm("v_max_f32_e32 %0, %1, %2":"=v"(r):"v"(a),"v"(b));return r;}
__device__ __forceinline__ float fadd_s(float a,float b){float r;asm("v_add_f32_e32 %0, %1, %2":"=v"(r):"v"(a),"v"(b));return r;}
__device__ __forceinline__ float fsub_s(float a,float b){float r;asm("v_sub_f32_e32 %0, %1, %2":"=v"(r):"v"(a),"v"(b));return r;}
typedef float f32x4_t __attribute__((ext_vector_type(4))); typedef float f32x2_t __attribute__((ext_vector_type(2))); typedef __bf16 bf16x2_t __attribute__((ext_vector_type(2)));
__device__ __forceinline__ unsigned cvtpk_s(float lo,float hi){f32x2_t v={lo,hi};bf16x2_t b=__builtin_convertvector(v,bf16x2_t);return __builtin_bit_cast(unsigned,b);}
#define WAIT_BAR(N) asm volatile("s_waitcnt vmcnt(" #N ") lgkmcnt(0)\n\ts_barrier":::"memory")

__device__ __forceinline__ void qkt(f32x16&p0,f32x16&p1,const char*Kslot,const bf16x8*qr,const f32x16&negm,int r32,int hi){
  const char*kb=Kslot+hi*1024+r32*16;
  #pragma unroll
  for(int d0=0;d0<4;++d0){
    const bf16x8 b0=*reinterpret_cast<const bf16x8*>(kb+d0*2048);
    const bf16x8 b1=*reinterpret_cast<const bf16x8*>(kb+d0*2048+512);
    if(d0==0){p0=__builtin_amdgcn_mfma_f32_32x32x16_bf16(b0,qr[0],negm,0,0,0);p1=__builtin_amdgcn_mfma_f32_32x32x16_bf16(b1,qr[0],negm,0,0,0);}
    else{p0=__builtin_amdgcn_mfma_f32_32x32x16_bf16(b0,qr[d0],p0,0,0,0);p1=__builtin_amdgcn_mfma_f32_32x32x16_bf16(b1,qr[d0],p1,0,0,0);}}
}
typedef __attribute__((address_space(3))) const char* lds_cptr;
typedef short v4i16_t __attribute__((ext_vector_type(4)));
__device__ __forceinline__ void kload8(bf16x8*kf,lds_cptr kp){
  kf[0]=*(const __attribute__((address_space(3))) bf16x8*)(kp);      kf[1]=*(const __attribute__((address_space(3))) bf16x8*)(kp+512);
  kf[2]=*(const __attribute__((address_space(3))) bf16x8*)(kp+2048); kf[3]=*(const __attribute__((address_space(3))) bf16x8*)(kp+2560);
  kf[4]=*(const __attribute__((address_space(3))) bf16x8*)(kp+4096); kf[5]=*(const __attribute__((address_space(3))) bf16x8*)(kp+4608);
  kf[6]=*(const __attribute__((address_space(3))) bf16x8*)(kp+6144); kf[7]=*(const __attribute__((address_space(3))) bf16x8*)(kp+6656);
}
__device__ __forceinline__ void kload2(bf16x8*kf,lds_cptr kp,int j){ kf[2*j]=*(const __attribute__((address_space(3))) bf16x8*)(kp+j*2048); kf[2*j+1]=*(const __attribute__((address_space(3))) bf16x8*)(kp+j*2048+512); }
__device__ __forceinline__ s16x4 vtr(lds_cptr p){ return __builtin_bit_cast(s16x4,__builtin_amdgcn_ds_read_tr16_b64_v4i16((__attribute__((address_space(3))) v4i16_t*)p)); }
__device__ __forceinline__ float rowmax(const f32x16&p0,const f32x16&p1){
  float a=max3f(p0[0],p0[1],p1[0]),b=max3f(p0[2],p0[3],p1[1]);a=max3f(a,p1[2],p1[3]);
  #pragma unroll
  for(int r=4;r<16;r+=4){a=max3f(a,p0[r],p0[r+1]);b=max3f(b,p0[r+2],p0[r+3]);a=max3f(a,p1[r],p1[r+1]);b=max3f(b,p1[r+2],p1[r+3]);}
  const float m=max2f(a,b);
  auto rr=__builtin_amdgcn_permlane32_swap(__float_as_uint(m),__float_as_uint(m),false,false);
  return max2f(__uint_as_float(rr[0]),__uint_as_float(rr[1]));
}
__device__ __forceinline__ void pv(f32x16*o,int vb,bf16x8 pa0,bf16x8 pa1,bf16x8 pa2,bf16x8 pa3){
  #pragma unroll
  for(int d0=0;d0<2;++d0){s16x4 lo[4],hi[4];
    #pragma unroll
    for(int ks=0;ks<4;++ks){
      asm volatile("ds_read_b64_tr_b16 %0,%1 offset:%c2":"=&v"(lo[ks]):"v"(vb),"i"(d0*4096+ks*1024):"memory");
      asm volatile("ds_read_b64_tr_b16 %0,%1 offset:%c2":"=&v"(hi[ks]):"v"(vb),"i"(d0*4096+ks*1024+512):"memory");}
    asm volatile("s_waitcnt lgkmcnt(0)":::"memory");SBAR();
    #define PK(k) (bf16x8){lo[k][0],lo[k][1],lo[k][2],lo[k][3],hi[k][0],hi[k][1],hi[k][2],hi[k][3]}
    o[d0]=__builtin_amdgcn_mfma_f32_32x32x16_bf16(pa0,PK(0),o[d0],0,0,0);
    o[d0]=__builtin_amdgcn_mfma_f32_32x32x16_bf16(pa1,PK(1),o[d0],0,0,0);
    o[d0]=__builtin_amdgcn_mfma_f32_32x32x16_bf16(pa2,PK(2),o[d0],0,0,0);
    o[d0]=__builtin_amdgcn_mfma_f32_32x32x16_bf16(pa3,PK(3),o[d0],0,0,0);
    #undef PK
  }
}

#ifndef ATTN_STORE16
#define ATTN_STORE16(p,v) (*(u32x4*)(p)=(v))
#endif
typedef __attribute__((address_space(3))) float lds_f32; typedef __attribute__((address_space(3))) f32x4_t lds_f32x4;
template<int MODE,int THRL> __device__ __forceinline__ void attn_unit(int b,int h,int qb,const bf16*Q,const bf16*__restrict__ K,const bf16*__restrict__ V,bf16*O,const float*__restrict__ aux,char*shm,const int wave_s,const float skipb_unused){
  const int tid=tid_from_wave(wave_s),lane=tid&63,r32=lane&31,hi=lane>>5; const int wid=wave_s;
  const long rowbase=(long)b*SEQ; const int q0=qb*QB;
  const bf16*Qw=Q+(rowbase+q0+wid*QBLK)*DM+h*D;
  int t0=0;
  if(MODE==1){ if(qb>0){ const float skipb=*(const volatile __attribute__((address_space(3))) float*)((lds_cptr)shm+133136); const float*p=aux+(size_t)(b*8+h)*SEQ; const float cq=p[q0]; const bool sk=(lane<4*qb)&&(cq-p[(lane<4*qb?lane:0)*64+63]>=skipb);
      const unsigned long long mk=__ballot(sk); t0=(int)__builtin_ctzll(~mk); t0=__builtin_amdgcn_readfirstlane(t0)&~1; } }
  const bf16*Kh=K+(rowbase+(long)t0*64)*DM+h*D,*Vh=V+(rowbase+(long)t0*64)*DM+h*D;
  const unsigned lds0=(unsigned)(uintptr_t)shm;
  float*wsf=(float*)(shm+LDS_WS)+wid*64;
  const bf16*ksrc=Kh+(long)lane*DM+wid*8;
  const bf16*vsrc=Vh+(long)(16*(wid&3)+(lane>>2))*DM+(wid>>2)*32+(lane&3)*8;
  const unsigned kdst=lds0+LDS_K+wid*1024, vdst=lds0+LDS_V+wid*1024;
  #define DMA_K(t,slot) glds16(ksrc+(long)(t)*KVBLK*DM,(unsigned)__builtin_amdgcn_readfirstlane(kdst+(slot)))
  #define DMA_V(t,slot) glds16(vsrc+(long)(t)*KVBLK*DM,(unsigned)__builtin_amdgcn_readfirstlane(vdst+(slot)))
  const char*Kbase=shm+LDS_K; bf16x8 kf[8];
  const lds_cptr shm3=(lds_cptr)shm; const lds_cptr kp0=shm3+LDS_K+hi*1024+r32*16; const lds_cptr vp0=shm3+LDS_V+((lane>>4)&1)*32+(lane&3)*8+(4*hi+((lane&15)>>2))*64;
  const int NT=(q0+QB)/KVBLK-t0;
  lds_f32* auxl=(lds_f32*)(shm3+LDS_AUX);
  if(MODE==0){ for(int e=tid;e<qb*64;e+=512){ const int j=e>>6,dd=e&63; const float*p=aux+(size_t)((b*16+j)*4)*512+h*64+dd; auxl[e]=(p[0]+p[512])+(p[1024]+p[1536]); } }
  else { const float*p=aux+(size_t)(b*8+h)*SEQ+t0*64; for(int e=tid*4;e<NT*64;e+=2048){ *(lds_f32x4*)(auxl+e)=*(const f32x4_t*)(p+e); } }
  asm volatile("s_waitcnt vmcnt(0) lgkmcnt(0)\n\ts_barrier":::"memory");
  DMA_K(0,0);DMA_V(0,0);DMA_K(1,SLOTB);
  bf16x8 qr[4];
  #pragma unroll
  for(int d0=0;d0<4;++d0)qr[d0]=*reinterpret_cast<const bf16x8*>(&Qw[(long)r32*DM+d0*16+hi*8]);
  float mhat=0.f,l_reg=0.f;f32x16 o[2];o[0]=f32x16{};o[1]=f32x16{};f32x16 negm=f32x16{};if(MODE==0)asm volatile("":"+v"(negm));
  #define CINIT (MODE==0?negm:f32x16{})
  const int qrel=wid*QBLK+r32;
  #define CMASK(P0,P1,t) do{int jb_=(t)-(NT-4); if(jb_>=0)cmask(P0,P1,jb_,qrel,hi);}while(0)
  bool resc=false;
  #define START(P0,P1) do{ const float rm=rowmax(P0,P1); resc=false; \
    { const float dl=__builtin_fmaxf(rm,-30.f); mhat=fadd_s(mhat,dl); \
      _Pragma("unroll") for(int r=0;r<16;++r){P0[r]=fsub_s(P0[r],dl);P1[r]=fsub_s(P1[r],dl);} \
      if(MODE==0){ _Pragma("unroll") for(int r=0;r<16;++r)negm[r]=-mhat; asm volatile("":"+v"(negm)); } } \
    _Pragma("unroll") for(int r=0;r<16;++r)P0[r]=__builtin_amdgcn_exp2f(P0[r]); }while(0)
  #define RESC() do{ if(resc){ asm volatile("s_waitcnt lgkmcnt(0)":::"memory"); \
      _Pragma("unroll") for(int d_=0;d_<2;++d_) _Pragma("unroll") for(int r=0;r<16;++r)o[d_][r]*=wsf[crow(r,hi)]; } }while(0)
  f32x16 pA0,pA1,pB0,pB1;
  int sl_prev=0,sl_cur=0,sl_next=SLOTB;
  #define ROT() do{sl_prev=sl_cur;sl_cur=sl_next;sl_next=(sl_next==(NSLOT-1)*SLOTB)?0:sl_next+SLOTB;}while(0)
  DMA_K(2,2*SLOTB);
  WAIT_BAR(3);
  unsigned sel=0u;
  if(MODE==0){ float v1=-3.0e38f,v2=-3.0e38f,v3=-3.0e38f; int i1=-1,i2=-1,i3=-1;
    for(int j=0;j<qb;++j){ const lds_f32* km=auxl+j*64+hi*8; float g=0.f;
      _Pragma("unroll") for(int d0=0;d0<4;++d0){ const f32x4_t a=*(const lds_f32x4*)(km+d0*16), c=*(const lds_f32x4*)(km+d0*16+4);
        g+=__uint_as_float((unsigned)(unsigned short)qr[d0][0]<<16)*a[0]; g+=__uint_as_float((unsigned)(unsigned short)qr[d0][1]<<16)*a[1]; g+=__uint_as_float((unsigned)(unsigned short)qr[d0][2]<<16)*a[2]; g+=__uint_as_float((unsigned)(unsigned short)qr[d0][3]<<16)*a[3];
        g+=__uint_as_float((unsigned)(unsigned short)qr[d0][4]<<16)*c[0]; g+=__uint_as_float((unsigned)(unsigned short)qr[d0][5]<<16)*c[1]; g+=__uint_as_float((unsigned)(unsigned short)qr[d0][6]<<16)*c[2]; g+=__uint_as_float((unsigned)(unsigned short)qr[d0][7]<<16)*c[3]; }
      g=sum_x32(g);
      if(g>v1){v3=v2;i3=i2;v2=v1;i2=i1;v1=g;i1=j;} else if(g>v2){v3=v2;i3=i2;v2=g;i2=j;} else if(g>v3){v3=g;i3=j;} }
    sel=(i1>=0?(1u<<i1):0u)|(i2>=0?(1u<<i2):0u)|(i3>=0?(1u<<i3):0u); }
  #define HOOK(P0,P1,t) do{ if(MODE==0){ const int j_=(t)>>2; if(j_<qb){ if(!((sel>>j_)&1u)){ _Pragma("unroll") for(int r=0;r<16;++r){P0[r]=-INFINITY;P1[r]=-INFINITY;} } } } \
    else { const lds_f32* bp_=auxl+64*(t)+4*hi; const float nm_=-mhat; _Pragma("unroll") for(int g_=0;g_<4;++g_){ const f32x4_t b0_=*(const lds_f32x4*)(bp_+8*g_)+nm_; const f32x4_t b1_=*(const lds_f32x4*)(bp_+32+8*g_)+nm_; \
        P0[4*g_]+=b0_[0];P0[4*g_+1]+=b0_[1];P0[4*g_+2]+=b0_[2];P0[4*g_+3]+=b0_[3]; P1[4*g_]+=b1_[0];P1[4*g_+1]+=b1_[1];P1[4*g_+2]+=b1_[2];P1[4*g_+3]+=b1_[3]; } } }while(0)
  qkt(pA0,pA1,Kbase,qr,CINIT,r32,hi);asm volatile("s_nop 15\n\ts_nop 7":"+v"(pA0),"+v"(pA1));HOOK(pA0,pA1,0);CMASK(pA0,pA1,0);
  START(pA0,pA1);
  _Pragma("unroll") for(int r=0;r<16;++r)pA1[r]=__builtin_amdgcn_exp2f(pA1[r]);
  WAIT_BAR(0);
  DMA_K(3,0);DMA_V(1,SLOTB);
  ROT();
  kload8(kf,kp0+sl_cur);
  WAIT_BAR(2);
  s16x4 vlo[8],vhi[8]; u32x4 pw0,pw1,pw2,pw3;
  #define PKW(P,B) cvtpk_s(P[B],P[B+1])
  #define PAF(k) __builtin_bit_cast(bf16x8,pw##k)
  #define VFR(i) (bf16x8){vlo[i][0],vlo[i][1],vlo[i][2],vlo[i][3],vhi[i][0],vhi[i][1],vhi[i][2],vhi[i][3]}
  #define PIN(x) asm volatile("":"+v"(x))
  #define MX3(a,b,c) __builtin_fmaxf(__builtin_fmaxf((a),(b)),(c))
  #define GAPA(MF,A0,A1,A2,A3,W0,W1,PW) do{ MF; sacc+=A0; sacc+=A1; sacc+=A2; sacc+=A3; PIN(sacc); W0; W1; PIN(PW); SBAR(); }while(0)
  #define EX(v) __builtin_amdgcn_exp2f(v)
  #define GAPB(MF,X,B) do{ MF; X[B]=EX(X[B]); X[B+1]=EX(X[B+1]); X[B+2]=EX(X[B+2]); X[B+3]=EX(X[B+3]); PIN(X); SBAR(); }while(0)
  #define VRD(i) do{ vlo[i]=vtr(vp_+(((i)>>2)*4096+((i)&3)*1024)); vhi[i]=vtr(vp_+(((i)>>2)*4096+((i)&3)*1024+512)); }while(0)
  #define KRD(G,j) do{ if(G){ kload2(kf,kp0+sl_next,j); SBAR(); } }while(0)
  #define STEP(C0,C1,P0,P1,t,GK,GV,GL) do{ SBAR(); \
    const lds_cptr vp_=vp0+sl_prev; \
    VRD(0); SBAR(); float sacc=(P0[0]+P0[1]); \
    GAPA(C0=__builtin_amdgcn_mfma_f32_32x32x16_bf16(kf[0],qr[0],CINIT,0,0,0), P0[2],P0[3],P0[4],P0[5],     pw0[0]=PKW(P0,0), pw0[1]=PKW(P0,2), pw0); \
    VRD(4); SBAR(); GAPA(C1=__builtin_amdgcn_mfma_f32_32x32x16_bf16(kf[1],qr[0],CINIT,0,0,0), P0[6],P0[7],P0[8],P0[9],     pw0[2]=PKW(P0,4), pw0[3]=PKW(P0,6), pw0); \
    VRD(1); SBAR(); GAPA(C0=__builtin_amdgcn_mfma_f32_32x32x16_bf16(kf[2],qr[1],C0,0,0,0),   P0[10],P0[11],P0[12],P0[13], pw1[0]=PKW(P0,8), pw1[1]=PKW(P0,10), pw1); \
    VRD(5); SBAR(); GAPA(C1=__builtin_amdgcn_mfma_f32_32x32x16_bf16(kf[3],qr[1],C1,0,0,0),   P0[14],P0[15],P1[0],P1[1],   pw1[2]=PKW(P0,12),pw1[3]=PKW(P0,14), pw1); \
    VRD(2); SBAR(); GAPA(C0=__builtin_amdgcn_mfma_f32_32x32x16_bf16(kf[4],qr[2],C0,0,0,0),   P1[2],P1[3],P1[4],P1[5],     pw2[0]=PKW(P1,0), pw2[1]=PKW(P1,2), pw2); \
    VRD(6); SBAR(); GAPA(C1=__builtin_amdgcn_mfma_f32_32x32x16_bf16(kf[5],qr[2],C1,0,0,0),   P1[6],P1[7],P1[8],P1[9],     pw2[2]=PKW(P1,4), pw2[3]=PKW(P1,6), pw2); \
    VRD(3); SBAR(); GAPA(C0=__builtin_amdgcn_mfma_f32_32x32x16_bf16(kf[6],qr[3],C0,0,0,0),   P1[10],P1[11],P1[12],P1[13], pw3[0]=PKW(P1,8), pw3[1]=PKW(P1,10), pw3); \
    VRD(7); SBAR(); GAPA(C1=__builtin_amdgcn_mfma_f32_32x32x16_bf16(kf[7],qr[3],C1,0,0,0),   P1[14],P1[15],0.f,0.f,       pw3[2]=PKW(P1,12),pw3[3]=PKW(P1,14), pw3); \
    l_reg+=sacc; \
    if(GK){DMA_K((t)+3,sl_cur);} if(GV){DMA_V((t)+1,sl_next);} \
    HOOK(C0,C1,t); CMASK(C0,C1,t); \
    { float a=MX3(C0[0],C0[1],C1[0]),b=MX3(C0[2],C0[3],C1[1]); a=MX3(a,C1[2],C1[3]); \
      _Pragma("unroll") for(int r=4;r<16;r+=4){a=MX3(a,C0[r],C0[r+1]);b=MX3(b,C0[r+2],C0[r+3]);a=MX3(a,C1[r],C1[r+1]);b=MX3(b,C1[r+2],C1[r+3]);} \
      float rm=__builtin_fmaxf(a,b); { auto rr=__builtin_amdgcn_permlane32_swap(__float_as_uint(rm),__float_as_uint(rm),false,false); rm=__builtin_fmaxf(__uint_as_float(rr[0]),__uint_as_float(rr[1])); } \
      resc=false; \
      if(__builtin_expect(__any(rm>(float)THRL),0)){ const float dl=__builtin_fmaxf(rm,0.f); mhat+=dl; \
        _Pragma("unroll") for(int r=0;r<16;++r){C0[r]-=dl;C1[r]-=dl;} \
        if(MODE==0){ _Pragma("unroll") for(int r=0;r<16;++r)negm[r]=-mhat; asm volatile("":"+v"(negm)); } \
        const float f=__builtin_amdgcn_exp2f(-dl); l_reg*=f; if(hi==0)wsf[r32]=f; resc=true; } } \
    SBAR(); \
    GAPB(o[0]=__builtin_amdgcn_mfma_f32_32x32x16_bf16(PAF(0),VFR(0),o[0],0,0,0), C0,0); \
    GAPB(o[1]=__builtin_amdgcn_mfma_f32_32x32x16_bf16(PAF(0),VFR(4),o[1],0,0,0), C0,4); \
    KRD(GL,0); GAPB(o[0]=__builtin_amdgcn_mfma_f32_32x32x16_bf16(PAF(1),VFR(1),o[0],0,0,0), C0,8); \
    KRD(GL,1); GAPB(o[1]=__builtin_amdgcn_mfma_f32_32x32x16_bf16(PAF(1),VFR(5),o[1],0,0,0), C0,12); \
    KRD(GL,2); GAPB(o[0]=__builtin_amdgcn_mfma_f32_32x32x16_bf16(PAF(2),VFR(2),o[0],0,0,0), C1,0); \
    KRD(GL,3); GAPB(o[1]=__builtin_amdgcn_mfma_f32_32x32x16_bf16(PAF(2),VFR(6),o[1],0,0,0), C1,4); \
    GAPB(o[0]=__builtin_amdgcn_mfma_f32_32x32x16_bf16(PAF(3),VFR(3),o[0],0,0,0), C1,8); \
    GAPB(o[1]=__builtin_amdgcn_mfma_f32_32x32x16_bf16(PAF(3),VFR(7),o[1],0,0,0), C1,12); \
    }while(0)
  int t=1;
  #undef CMASK
  #define CMASK(P0,P1,t) do{}while(0)
  for(;t+5<NT;t+=2){
    STEP(pB0,pB1,pA0,pA1,t,true,true,true);     WAIT_BAR(2); RESC(); ROT();
    STEP(pA0,pA1,pB0,pB1,t+1,true,true,true);   WAIT_BAR(2); RESC(); ROT();
  }
  #undef CMASK
  #define CMASK(P0,P1,t) do{int jb_=(t)-(NT-4); if(jb_>=0)cmask(P0,P1,jb_,qrel,hi);}while(0)
  #define ENDW(tt) do{ if((tt)+3<NT){WAIT_BAR(2);} else if((tt)+2<NT){WAIT_BAR(1);} else {WAIT_BAR(0);} }while(0)
  for(;t+1<NT;t+=2){
    STEP(pB0,pB1,pA0,pA1,t,(t+3<NT),(t+1<NT),(t+1<NT));       ENDW(t);   RESC(); ROT();
    STEP(pA0,pA1,pB0,pB1,t+1,(t+4<NT),(t+2<NT),(t+2<NT));     ENDW(t+1); RESC(); ROT();
  }
  STEP(pB0,pB1,pA0,pA1,NT-1,false,false,false); RESC();
  { float sacc=pB0[0]+pB0[1]; _Pragma("unroll") for(int r=2;r<16;++r)sacc+=pB0[r]; _Pragma("unroll") for(int r=0;r<16;++r)sacc+=pB1[r]; l_reg+=sacc;
    pw0=(u32x4){PKW(pB0,0),PKW(pB0,2),PKW(pB0,4),PKW(pB0,6)};pw1=(u32x4){PKW(pB0,8),PKW(pB0,10),PKW(pB0,12),PKW(pB0,14)};pw2=(u32x4){PKW(pB1,0),PKW(pB1,2),PKW(pB1,4),PKW(pB1,6)};pw3=(u32x4){PKW(pB1,8),PKW(pB1,10),PKW(pB1,12),PKW(pB1,14)};
    SBAR(); const int vb0=(int)(lds0+LDS_V)+((lane>>4)&1)*32+(lane&3)*8+(4*hi+((lane&15)>>2))*64; pv(o,vb0+sl_cur,PAF(0),PAF(1),PAF(2),PAF(3)); }
  #undef PKW
  #undef PAF
  #undef VFR
  #undef PIN
  #undef MX3
  #undef GAPA
  #undef GAPB
  #undef EX
  #undef VRD
  #undef KRD
  #undef STEP
  #undef ENDW
  {auto rr=__builtin_amdgcn_permlane32_swap(__float_as_uint(l_reg),__float_as_uint(l_reg),false,false);l_reg=__uint_as_float(rr[0])+__uint_as_float(rr[1]);}
  if(hi==0)wsf[32+r32]=l_reg;asm volatile("s_waitcnt lgkmcnt(0)":::"memory");
  float rli[16];
  #pragma unroll
  for(int r=0;r<16;++r)rli[r]=__builtin_amdgcn_rcpf(wsf[32+crow(r,hi)]);
  bf16*Ow=O+(rowbase+q0+wid*QBLK)*DM+h*D;
  { bf16*stg=(bf16*)(shm+LDS_OST)+wid*2048;
    #pragma unroll
    for(int r=0;r<16;++r){const int orow=crow(r,hi);
      #pragma unroll
      for(int d0=0;d0<2;++d0)stg[orow*64+d0*32+r32]=__float2bfloat16(o[d0][r]*rli[r]);}
    asm volatile("s_waitcnt lgkmcnt(0)":::"memory");
    #pragma unroll
    for(int i=0;i<4;++i){const int row=i*8+(lane>>3),ch=lane&7; const u32x4 v=*(const u32x4*)(stg+row*64+ch*8); ATTN_STORE16(Ow+(long)row*DM+ch*8,v);} }
  asm volatile("s_waitcnt lgkmcnt(0)\n\ts_barrier":::"memory");
  #undef DMA_K
  #undef DMA_V
  #undef CMASK
  #undef HOOK
  #undef CINIT
  #undef START
  #undef RESC
  #undef ROT
}
#undef SBAR
#undef WAIT_BAR
}

namespace attn_body {
#define SBAR() __builtin_amdgcn_sched_barrier(0)
__device__ __forceinline__ void mem_unit(int brow,int bglob,int h,int qb,bf16*QO,const bf16*__restrict__ MK,char*shm,const int wave_s){
  const int tid=tid_from_wave(wave_s),lane=tid&63,r32=lane&31,hi=lane>>5; const int wid=wave_s;
  const lds_cptr shm3=(lds_cptr)shm; const unsigned lds0=(unsigned)(uintptr_t)shm;
  typedef __attribute__((address_space(3))) u32x4 lds_u32x4;
  const bf16*kg=MK+(size_t)(bglob*256)*MKP+h*128; const bf16*vg=kg+512;
  {
    const bf16*kp=kg+(size_t)(tid&255)*MKP+(tid>>8)*8; const lds_cptr kl=shm3+((tid&255)>>6)*16384+(tid>>8)*1024+(tid&63)*16;
    const bf16*vp=vg+(size_t)(tid>>2)*MKP+(tid&3)*8; const lds_cptr vl=shm3+65536+((tid>>2)>>6)*16384+((tid>>2)&63)*64+(tid&3)*16;
    #pragma unroll 2
    for(int i=0;i<8;i+=4){ u32x4 t0=*(const u32x4*)(kp+(i+0)*16),t1=*(const u32x4*)(kp+(i+1)*16),t2=*(const u32x4*)(kp+(i+2)*16),t3=*(const u32x4*)(kp+(i+3)*16);
      *(lds_u32x4*)(kl+(i+0)*2048)=t0; *(lds_u32x4*)(kl+(i+1)*2048)=t1; *(lds_u32x4*)(kl+(i+2)*2048)=t2; *(lds_u32x4*)(kl+(i+3)*2048)=t3; }
    #pragma unroll 2
    for(int i=0;i<8;i+=2){ u32x4 t0=*(const u32x4*)(vp+(i>>1)*32),t1=*(const u32x4*)(vp+(size_t)128*MKP+(i>>1)*32);
      *(lds_u32x4*)(vl+(i>>1)*4096)=t0; *(lds_u32x4*)(vl+32768+(i>>1)*4096)=t1; } }
  bf16*Qw=QO+(size_t)(brow+qb*256+wid*32)*DM+h*128;
  bf16x8 qr[8];
  #pragma unroll
  for(int d0=0;d0<8;++d0)qr[d0]=*reinterpret_cast<const bf16x8*>(&Qw[(size_t)r32*DM+d0*16+hi*8]);
  asm volatile("s_waitcnt vmcnt(0) lgkmcnt(0)\n\ts_barrier":::"memory");
  lds_f32* wsf=(lds_f32*)(shm3+131072)+wid*64;
  float m=-INFINITY,l_reg=0.f; f32x16 o[4]; o[0]=f32x16{};o[1]=f32x16{};o[2]=f32x16{};o[3]=f32x16{};
  const int vbl=((lane>>4)&1)*32+(lane&3)*8+(4*hi+((lane&15)>>2))*64;
  #pragma unroll 1
  for(int kt=0;kt<4;++kt){
    f32x16 p0=f32x16{},p1=f32x16{};
    const lds_cptr kb=shm3+kt*16384+hi*1024+r32*16;
    #pragma unroll
    for(int d0=0;d0<8;++d0){
      const bf16x8 b0=*(const __attribute__((address_space(3))) bf16x8*)(kb+d0*2048);
      const bf16x8 b1=*(const __attribute__((address_space(3))) bf16x8*)(kb+d0*2048+512);
      p0=__builtin_amdgcn_mfma_f32_32x32x16_bf16(b0,qr[d0],p0,0,0,0); p1=__builtin_amdgcn_mfma_f32_32x32x16_bf16(b1,qr[d0],p1,0,0,0); }
    float rm=p0[0];
    #pragma unroll
    for(int r=0;r<16;++r){rm=__builtin_fmaxf(rm,p0[r]);rm=__builtin_fmaxf(rm,p1[r]);}
    rm=max_x32(rm);
    const float mn=__builtin_fmaxf(m,rm); const float alpha=__builtin_amdgcn_exp2f(m-mn); m=mn;
    float sacc=0.f;
    #pragma unroll
    for(int r=0;r<16;++r){p0[r]=__builtin_amdgcn_exp2f(p0[r]-mn);p1[r]=__builtin_amdgcn_exp2f(p1[r]-mn);sacc+=p0[r]+p1[r];}
    l_reg=l_reg*alpha+sacc;
    if(hi==0)wsf[r32]=alpha;
    asm volatile("s_waitcnt lgkmcnt(0)":::"memory");
    #pragma unroll
    for(int r=0;r<16;++r){ const float a=wsf[crow(r,hi)]; o[0][r]*=a;o[1][r]*=a;o[2][r]*=a;o[3][r]*=a; }
    u32x4 pw0,pw1,pw2,pw3;
    pw0=(u32x4){cvtpk_s(p0[0],p0[1]),cvtpk_s(p0[2],p0[3]),cvtpk_s(p0[4],p0[5]),cvtpk_s(p0[6],p0[7])};
    pw1=(u32x4){cvtpk_s(p0[8],p0[9]),cvtpk_s(p0[10],p0[11]),cvtpk_s(p0[12],p0[13]),cvtpk_s(p0[14],p0[15])};
    pw2=(u32x4){cvtpk_s(p1[0],p1[1]),cvtpk_s(p1[2],p1[3]),cvtpk_s(p1[4],p1[5]),cvtpk_s(p1[6],p1[7])};
    pw3=(u32x4){cvtpk_s(p1[8],p1[9]),cvtpk_s(p1[10],p1[11]),cvtpk_s(p1[12],p1[13]),cvtpk_s(p1[14],p1[15])};
    const int vb=(int)(lds0+65536+kt*16384)+vbl;
    SBAR(); pv(o,vb,__builtin_bit_cast(bf16x8,pw0),__builtin_bit_cast(bf16x8,pw1),__builtin_bit_cast(bf16x8,pw2),__builtin_bit_cast(bf16x8,pw3));
    pv(o+2,vb+8192,__builtin_bit_cast(bf16x8,pw0),__builtin_bit_cast(bf16x8,pw1),__builtin_bit_cast(bf16x8,pw2),__builtin_bit_cast(bf16x8,pw3));
    asm volatile("s_waitcnt lgkmcnt(0)":::"memory");
  }
  l_reg=sum_x32(l_reg);
  if(hi==0)wsf[32+r32]=l_reg; asm volatile("s_waitcnt lgkmcnt(0)":::"memory");
  asm volatile("s_waitcnt lgkmcnt(0)\n\ts_barrier":::"memory");
  { typedef __attribute__((address_space(3))) unsigned short lds_u16;
    lds_u16* stg=(lds_u16*)(shm3+wid*8192);
    #pragma unroll
    for(int r=0;r<16;++r){ const float rl=__builtin_amdgcn_rcpf(wsf[32+crow(r,hi)]); const int orow=crow(r,hi);
      #pragma unroll
      for(int db=0;db<4;++db){ const unsigned w=cvtpk_s(o[db][r]*rl,0.f); stg[orow*128+db*32+r32]=(unsigned short)w; } }
    asm volatile("s_waitcnt lgkmcnt(0)":::"memory");
    #pragma unroll
    for(int i=0;i<8;++i){ const int row=i*4+(lane>>4),ch=lane&15; const u32x4 v=*(const lds_u32x4*)(shm3+wid*8192+row*256+ch*16); *(u32x4*)(Qw+(size_t)row*DM+ch*8)=v; } }
  asm volatile("s_waitcnt lgkmcnt(0)\n\ts_barrier":::"memory");
}
#undef SBAR
}

constexpr int NWAVES = 8;
constexpr int TOK = 32768, DMOD = 1024, FF = 2816, SEQL = 4096, PP = 5184, MKP = 2112, DIN = 8200, NLAYER = 2;
constexpr int C_QA = 0, C_PU = 512, C_QC = 1024, C_MQ = 1536, C_KA = 2048, C_VA = 2560, C_KC = 3072, C_VC = 3584, C_H = 4096, C_Z = 2048;
constexpr float RMS_EPS = 1e-6f;
constexpr float LOG2E = 1.4426950408889634f;
constexpr float C2_64 = 0.125f * LOG2E, C2_128 = 0.08838834764831845f * LOG2E;
constexpr size_t MiB = 1u << 20;
constexpr size_t WS_FOXF = 1 * MiB, WS_CK2 = 2 * MiB, WS_KMEAN = 3 * MiB, WS_MEMN = 4 * MiB, WS_MEMKV = 8 * MiB, WS_POOLED = 17 * MiB, WS_W = 49 * MiB,
                 WS_PROJ = 173 * MiB, WS_HF = WS_PROJ + 176 * MiB, WS_END = 497 * MiB;
static_assert((size_t)2048 * MKP * 2 <= 9 * MiB && (size_t)TOK * PP * 2 <= 324 * MiB && (size_t)TOK * FF * 2 <= 176 * MiB && (size_t)TOK * 512 * 2 <= 32 * MiB && (size_t)256 * 65536 * 2 <= 32 * MiB, "workspace map");
constexpr size_t E_FFN_IN = (size_t)2 * FF * DMOD, E_FFN_OUT = (size_t)DMOD * FF, E_WIN = (size_t)8192 * DMOD, E_WBR = (size_t)4 * DMOD * 1024  , E_WOUT = (size_t)DMOD * DMOD, E_WPOOL = (size_t)512 * 512;
constexpr size_t O_FFN1_IN = 0, O_FFN1_OUT = O_FFN1_IN + E_FFN_IN, O_WIN = O_FFN1_OUT + E_FFN_OUT, O_WBR = O_WIN + E_WIN, O_WOUT = O_WBR + E_WBR, O_WPOOL = O_WOUT + E_WOUT,
                 O_FFN2_IN = O_WPOOL + E_WPOOL, O_FFN2_OUT = O_FFN2_IN + E_FFN_IN, E_LAYER = O_FFN2_OUT + E_FFN_OUT, O_WMEM = NLAYER * E_LAYER, E_WTOTAL = O_WMEM + (size_t)2048 * 1024;
static_assert(E_WTOTAL * 2 <= 124 * MiB, "weights fit");
constexpr int RING_BYTES = 131072, LDS_BYTES = 147456;

#define LAS __attribute__((address_space(3)))
typedef unsigned short bf16;
typedef unsigned v4u __attribute__((ext_vector_type(4)));
typedef float f32x4 __attribute__((ext_vector_type(4)));
#define LDS_WAIT() asm volatile("s_waitcnt lgkmcnt(0)" ::: "memory")
__device__ __forceinline__ unsigned pk2(float lo, float hi) { return pg8::cvt_pk_bf16(lo, hi); }
__device__ __forceinline__ float wave_sum(float v) {
    v += xor_lane<1>(v); v += xor_lane<2>(v); v += xor_lane<4>(v); v += xor_lane<8>(v); v += xor_lane<16>(v); v = sum_x32(v);
    return v;
}
__device__ __forceinline__ void ld8(const bf16* p, float (&v)[8]) { const v4u w = *(const v4u*)p;
    v[0] = pg8::bf_lo(w.x); v[1] = pg8::bf_hi(w.x); v[2] = pg8::bf_lo(w.y); v[3] = pg8::bf_hi(w.y); v[4] = pg8::bf_lo(w.z); v[5] = pg8::bf_hi(w.z); v[6] = pg8::bf_lo(w.w); v[7] = pg8::bf_hi(w.w); }
__device__ __forceinline__ void un8(const v4u& w, float (&v)[8]) {
    v[0] = pg8::bf_lo(w.x); v[1] = pg8::bf_hi(w.x); v[2] = pg8::bf_lo(w.y); v[3] = pg8::bf_hi(w.y); v[4] = pg8::bf_lo(w.z); v[5] = pg8::bf_hi(w.z); v[6] = pg8::bf_lo(w.w); v[7] = pg8::bf_hi(w.w); }
__device__ __forceinline__ void st8(bf16* p, const float (&v)[8]) { v4u w; w.x = pk2(v[0], v[1]); w.y = pk2(v[2], v[3]); w.z = pk2(v[4], v[5]); w.w = pk2(v[6], v[7]); *(v4u*)p = w; }

__device__ __forceinline__ void tr_item(const float* W, int ldw, int srccol0, int k0, bf16* WT, int ldk, int dstrow0, const float* kscale, LAS float* scr, int lane) {
#pragma unroll
    for (int i = 0; i < 32; ++i) { const int kk = 2 * i + (lane >> 5); float v = W[(size_t)(k0 + kk) * ldw + srccol0 + (lane & 31)]; if (kscale) v *= kscale[k0 + kk]; scr[kk * 33 + (lane & 31)] = v; }
    LDS_WAIT(); asm volatile("" ::: "memory");
    const int c = lane & 7;
#pragma unroll
    for (int j = 0; j < 4; ++j) { const int n = (lane >> 3) + 8 * j; const LAS float* s = scr + (8 * c) * 33 + n;
        v4u o; o.x = pk2(s[0 * 33], s[1 * 33]); o.y = pk2(s[2 * 33], s[3 * 33]); o.z = pk2(s[4 * 33], s[5 * 33]); o.w = pk2(s[6 * 33], s[7 * 33]);
        *(v4u*)(WT + (size_t)(dstrow0 + n) * ldk + k0 + 8 * c) = o; }
    LDS_WAIT(); asm volatile("" ::: "memory");
}

template <bool FOX> __device__ __forceinline__ void norm_rows(const float* x, const float* gain, bf16* H, int ldh, int nrows, const float* w_in_l, float* foxf, int gw, int NGW, int lane) {
    f32x4 gv[4];
#pragma unroll
    for (int j = 0; j < 4; ++j) gv[j] = gain ? *((const f32x4*)gain + lane + 64 * j) : (f32x4){1.f, 1.f, 1.f, 1.f};
    f32x4 wf[FOX ? 16 : 1][2];
    if (FOX) {
#pragma unroll
        for (int j = 0; j < 4; ++j)
#pragma unroll
            for (int c = 0; c < 4; ++c) { const float* p = w_in_l + (size_t)(256 * j + 4 * lane + c) * DIN + 3072; wf[j * 4 + c][0] = *(const f32x4*)p; wf[j * 4 + c][1] = *(const f32x4*)(p + 4); }
    }
    f32x4 nv[4];
    if (gw < nrows) { const f32x4* xr = (const f32x4*)(x + (size_t)gw * DMOD) + lane;
#pragma unroll
        for (int j = 0; j < 4; ++j) nv[j] = xr[64 * j]; }
    for (int m = gw; m < nrows; m += NGW) {
        f32x4 v[4]; float s2 = 0.f;
#pragma unroll
        for (int j = 0; j < 4; ++j) { v[j] = nv[j]; s2 += (v[j].x * v[j].x + v[j].y * v[j].y) + (v[j].z * v[j].z + v[j].w * v[j].w); }
        if (m + NGW < nrows) { const f32x4* xr = (const f32x4*)(x + (size_t)(m + NGW) * DMOD) + lane;
#pragma unroll
            for (int j = 0; j < 4; ++j) nv[j] = xr[64 * j]; }
        const float rstd = 1.0f / sqrtf(wave_sum(s2) * (1.f / DMOD) + RMS_EPS);
        unsigned long long* o8 = (unsigned long long*)(H + (size_t)m * ldh) + lane;
#pragma unroll
        for (int j = 0; j < 4; ++j) { v[j] = v[j] * rstd * gv[j]; o8[64 * j] = (unsigned long long)pk2(v[j].x, v[j].y) | ((unsigned long long)pk2(v[j].z, v[j].w) << 32); }
        if (FOX) {
            float acc[8];
#pragma unroll
            for (int h = 0; h < 8; ++h) acc[h] = 0.f;
#pragma unroll
            for (int j = 0; j < 4; ++j)
#pragma unroll
                for (int c = 0; c < 4; ++c) { const float hv = v[j][c];
#pragma unroll
                    for (int h = 0; h < 4; ++h) { acc[h] += hv * wf[j * 4 + c][0][h]; acc[4 + h] += hv * wf[j * 4 + c][1][h]; } }
#pragma unroll
            for (int h = 0; h < 8; ++h) acc[h] = wave_sum(acc[h]);
            if (lane < 8) { const float sv = lane == 0 ? acc[0] : lane == 1 ? acc[1] : lane == 2 ? acc[2] : lane == 3 ? acc[3] : lane == 4 ? acc[4] : lane == 5 ? acc[5] : lane == 6 ? acc[6] : acc[7];
                foxf[(size_t)((m >> 12) * 8 + lane) * SEQL + (m & (SEQL - 1))] = sv; }
        }
    }
}

template <int GL> __device__ __forceinline__ void gnorm8(float (&v)[8], const float (&g)[8], float scale) {
    float ss = 0.f;
#pragma unroll
    for (int i = 0; i < 8; ++i) ss += v[i] * v[i];
    ss += xor_lane<1>(ss); ss += xor_lane<2>(ss); ss += xor_lane<4>(ss); if (GL > 8) ss += xor_lane<8>(ss);
    const float r = scale / sqrtf(ss * (1.0f / (8 * GL)) + RMS_EPS);
#pragma unroll
    for (int i = 0; i < 8; ++i) v[i] = v[i] * r * g[i];
}
__device__ __forceinline__ void rot8(float (&v)[8], const float (&cc)[8], const float (&sn)[8], int li) {
    float oth[8];
#pragma unroll
    for (int i = 0; i < 8; ++i) oth[i] = xor_lane<1>(v[i]);
    if (li == 0) {
#pragma unroll
        for (int i = 0; i < 8; ++i) v[i] = v[i] * cc[i] - oth[i] * sn[i];
    } else if (li == 1) {
#pragma unroll
        for (int i = 0; i < 8; ++i) v[i] = v[i] * cc[i] + oth[i] * sn[i];
    }
}

#define XB_TMO      128
#define XB_XCNT(j)  (256  + 64 * (j))
#define XB_XSUB(j)  (1280 + 64 * (j))
#define XB_XGEN(j)  (2304 + 64 * (j))
#define XB_TOP      3328
#define XB_TOPGEN   3392
#define XCD_BAR_WORDS 3456
#define XB_SPIN_CAP (1u << 18)

__device__ __forceinline__ unsigned xb_ld(unsigned* p)              { return __hip_atomic_load(p, __ATOMIC_RELAXED, __HIP_MEMORY_SCOPE_AGENT); }
__device__ __forceinline__ unsigned xb_add(unsigned* p, unsigned v) { return __hip_atomic_fetch_add(p, v, __ATOMIC_RELAXED, __HIP_MEMORY_SCOPE_AGENT); }
__device__ __forceinline__ unsigned xb_xcc_id() { return (unsigned)__builtin_amdgcn_s_getreg((3 << 11) | 20) & 0xFu; }
#define XB_SPIN(cond, bar) do { unsigned _sp = 0; while (cond) { __builtin_amdgcn_s_sleep(1); \
    if ((++_sp & 255u) == 0u) { if (xb_ld(&(bar)[XB_TMO])) break; if (_sp > XB_SPIN_CAP) { atomicAdd(&(bar)[XB_TMO], 1u); break; } } } } while (0)

struct XcdBarrier {
    unsigned* bar; unsigned x;
    volatile LAS unsigned* st;
};

__device__ __forceinline__ XcdBarrier xcd_barrier_post(unsigned* bar, volatile LAS unsigned* st, int wave_s) {
    XcdBarrier b; b.bar = bar; b.x = xb_xcc_id(); b.st = st;
    if (tid_from_wave(wave_s) == 0) (void)xb_add(&bar[XB_XCNT(b.x)], 1u);
    return b;
}
__device__ __forceinline__ void xcd_barrier_complete(unsigned* bar, unsigned x, unsigned& nloc, unsigned& nx) {
    const unsigned G = gridDim.x * gridDim.y * gridDim.z;
    unsigned sum, cnt, mine, sp = 0u;
    for (;;) {
        sum = 0u; cnt = 0u; mine = 0u;
#pragma unroll
        for (unsigned j = 0; j < 16; ++j) { const unsigned c = xb_ld(&bar[XB_XCNT(j)]); sum += c; cnt += (c > 0u) ? 1u : 0u; mine = (j == x) ? c : mine; }
        if (sum == G) break;
        __builtin_amdgcn_s_sleep(1);
        if ((++sp & 255u) == 0u) { if (xb_ld(&bar[XB_TMO])) break; if (sp > XB_SPIN_CAP) { atomicAdd(&bar[XB_TMO], 1u); break; } }
    }
    nloc = mine > 0u ? mine : 1u; nx = cnt > 0u ? cnt : 1u;
}

__device__ __forceinline__ void xcd_barrier(const XcdBarrier& b, int wave_s) {
    asm volatile("s_waitcnt vmcnt(0)" ::: "memory");
    __syncthreads();
    if (tid_from_wave(wave_s) == 0) {
        unsigned* bar = b.bar;
        __builtin_amdgcn_s_waitcnt(0);
        unsigned nloc = b.st[0], nx = b.st[1];
        if (nloc == 0u) { xcd_barrier_complete(bar, b.x, nloc, nx); b.st[0] = nloc; b.st[1] = nx; }
        const unsigned old = xb_add(&bar[XB_XSUB(b.x)], 1u);
        const unsigned gen = old / nloc;
        if (old + 1u == (gen + 1u) * nloc) {
            __builtin_amdgcn_fence(__ATOMIC_RELEASE, "agent");
            asm volatile("s_waitcnt vmcnt(0)" ::: "memory");
            const unsigned og = xb_add(&bar[XB_TOP], 1u);
            const unsigned tg = og / nx;
            if (og + 1u == (tg + 1u) * nx) xb_add(&bar[XB_TOPGEN], 1u);
            else XB_SPIN(xb_ld(&bar[XB_TOPGEN]) == tg, bar);
            __builtin_amdgcn_fence(__ATOMIC_ACQUIRE, "agent");
            xb_add(&bar[XB_XGEN(b.x)], 1u);
            asm volatile("s_waitcnt vmcnt(0)" ::: "memory");
        } else {
            XB_SPIN(xb_ld(&bar[XB_XGEN(b.x)]) == gen, bar);
            __builtin_amdgcn_fence(__ATOMIC_ACQUIRE, "agent");
            asm volatile("s_waitcnt vmcnt(0)" ::: "memory");
        }
    }
    __syncthreads();
}

__device__ __forceinline__ float logsig(float x) { return fminf(x, 0.f) - 0.6931471805599453f * __builtin_amdgcn_logf(1.0f + __builtin_amdgcn_exp2f(-1.4426950408889634f * fabsf(x))); }
struct Args { const float* in[24]; float* out; unsigned char* ws; };

__global__ void __launch_bounds__(NWAVES * 64, 2) hybrid_fwd(Args args) {
    extern __shared__ __attribute__((aligned(16))) unsigned char lds[];
    cg::grid_group grid = cg::this_grid();
    LAS unsigned char* ldsl = (LAS unsigned char*)lds;
    const int G = gridDim.x, bx = blockIdx.x;
    const int vcu = (G % 8 == 0) ? (bx % 8) * (G / 8) + bx / 8 : bx;
    const int NGW = G * NWAVES;
    const int wave_s = __builtin_amdgcn_readfirstlane((int)threadIdx.x >> 6);
    if (tid_from_wave(wave_s) < 2) ((volatile LAS unsigned*)(ldsl + 133120))[tid_from_wave(wave_s)] = 0u;
    __syncthreads();
    XcdBarrier xbar = xcd_barrier_post((unsigned*)args.ws, (volatile LAS unsigned*)(ldsl + 133120), wave_s);
#define GSYNC() xcd_barrier(xbar, wave_s)
#define LANE_STATE() const int tid = tid_from_wave(wave_s), lane = tid & 63, wave = wave_s, gw = vcu * NWAVES + wave; (void)tid; (void)lane; (void)gw
    unsigned char* ws = args.ws;
    const float* x_in = args.in[0]; const float* mem = args.in[1]; const int* positions = (const int*)args.in[2];
    float* xout = args.out;
    float* FOXF = (float*)(ws + WS_FOXF); float* CK2 = (float*)(ws + WS_CK2); float* KMEAN = (float*)(ws + WS_KMEAN);
    bf16* MEMN = (bf16*)(ws + WS_MEMN); bf16* MEMKV = (bf16*)(ws + WS_MEMKV); bf16* POOLED = (bf16*)(ws + WS_POOLED);
    bf16* HF = (bf16*)(ws + WS_HF); bf16* WB = (bf16*)(ws + WS_W); bf16* PROJ = (bf16*)(ws + WS_PROJ); bf16* HID = PROJ; bf16* GS = POOLED;

#ifdef PROBE_PHASE
    unsigned long long probe_acc = 0, probe_t0 = 0;
#define PB(k) do { if ((k) == PROBE_PHASE) probe_t0 = __builtin_amdgcn_s_memrealtime(); } while (0)
#define PE(k) do { if ((k) == PROBE_PHASE) probe_acc += __builtin_amdgcn_s_memrealtime() - probe_t0; } while (0)
#else
#define PB(k) do {} while (0)
#define PE(k) do {} while (0)
#endif
    PB(0);
    {
        LANE_STATE();
        LAS float* scr = (LAS float*)(ldsl + wave * 16384);
        constexpr int I_FI = 16 * 176, I_FO = 44 * 32, I_WI = 16 * 256, I_BR = 4 * 8 * 32, I_WO = 16 * 32, I_MEM = 16 * 32;
        constexpr int I_LAYER = 2 * I_FI + 2 * I_FO + I_WI + I_BR + I_WO + I_MEM;
        for (int it = gw; it < NLAYER * I_LAYER; it += NGW) {
            const int l = it / I_LAYER; int r = it % I_LAYER; bf16* WL = WB + (size_t)l * E_LAYER;
            if (r < 2 * I_FI) { const int which = r / I_FI; r %= I_FI; const float* W = args.in[which ? 22 : 4] + (size_t)l * DMOD * 2 * FF;
                const int kb = r / 176, nb = r % 176, n0 = 32 * nb, isu = n0 / FF, j = n0 % FF;
                tr_item(W, 2 * FF, n0, 64 * kb, WL + (which ? O_FFN2_IN : O_FFN1_IN), DMOD, 256 * (j / 128) + 128 * isu + (j % 128), nullptr, scr, lane); continue; }
            r -= 2 * I_FI;
            if (r < 2 * I_FO) { const int which = r / I_FO; r %= I_FO; const float* W = args.in[which ? 23 : 5] + (size_t)l * FF * DMOD;
                const int kb = r / 32, nb = r % 32;
                tr_item(W, DMOD, 32 * nb, 64 * kb, WL + (which ? O_FFN2_OUT : O_FFN1_OUT), FF, 32 * nb, nullptr, scr, lane); continue; }
            r -= 2 * I_FO;
            if (r < I_WI) { const float* W = args.in[7] + (size_t)l * DMOD * DIN; const int kb = r / 256, nb = r % 256, n0 = 32 * nb;
                int src;
                if (n0 >= 4096) src = n0 + 8; else { const int sec = n0 >> 9, o = n0 & 511;
                    const int sb = sec == 0 ? 0 : sec == 1 ? 3080 : sec == 2 ? 1536 : sec == 3 ? 3592 : sec == 4 ? 512 : sec == 5 ? 1024 : sec == 6 ? 2048 : 2560; src = sb + o; }
                tr_item(W, DIN, src, 64 * kb, WL + O_WIN, DMOD, n0, nullptr, scr, lane); continue; }
            r -= I_WI;
            if (r < I_BR) { const int br = r / 256; r %= 256; const float* W = args.in[19] + ((size_t)l * 4 + br) * 512 * DMOD; const int kb = r / 32, nb = r % 32;
                tr_item(W, DMOD, 32 * nb, 64 * kb, WL + O_WBR + (size_t)br * DMOD * 1024, 1024, 32 * nb, nullptr, scr, lane); continue; }
            r -= I_BR;
            if (r < I_WO) { const float* W = args.in[20] + (size_t)l * DMOD * DMOD; const int kb = r / 32, nb = r % 32;
                tr_item(W, DMOD, 32 * nb, 64 * kb, WL + O_WOUT, DMOD, 32 * nb, nullptr, scr, lane); continue; }
            r -= I_WO;
            { const float* W = args.in[14] + (size_t)l * DMOD * 1024; const int kb = r / 32, nb = r % 32;
                tr_item(W, 1024, 32 * nb, 64 * kb, WB + O_WMEM, DMOD, l * 1024 + 32 * nb, args.in[13] + l * DMOD, scr, lane); }
        }
        for (int e = gw * 64 + lane; e < NLAYER * 512 * 64; e += NGW * 64) {
            const int l = e / (512 * 64), r = e % (512 * 64), n = r / 64, k8 = (r % 64) * 8, g = n >> 7;
            float v[8];
            if ((k8 >> 7) == g) { const float* mp = args.in[17] + (((size_t)l * 4 + g) * 128 + (k8 & 127)) * 128 + (n & 127); const float sc = args.in[18][l * 512 + n];
#pragma unroll
                for (int i = 0; i < 8; ++i) v[i] = mp[i * 128] * sc;
            } else {
#pragma unroll
                for (int i = 0; i < 8; ++i) v[i] = 0.f;
            }
            st8(WB + (size_t)l * E_LAYER + O_WPOOL + (size_t)n * 512 + k8, v);
        }
        norm_rows<false>(mem, nullptr, MEMN, DMOD, 2048, nullptr, nullptr, gw, NGW, lane);
        norm_rows<false>(x_in, args.in[3], HF, DMOD, TOK, nullptr, nullptr, gw, NGW, lane);
    }
    GSYNC();
    if (args.out == nullptr) grid.sync();
    PE(0);

    for (int st = 0; st < 3 * NLAYER; ++st) {
        const int l = st / 3, kind = st % 3;
        bf16* WL = WB + (size_t)l * E_LAYER;
        if (kind != 1) {
            const bool second = (kind == 2);
            const float* xsrc = (st == 0) ? x_in : xout;
            if (st != 0) { PB(1); LANE_STATE(); norm_rows<false>(xsrc, args.in[second ? 21 : 3] + l * DMOD, HF, DMOD, TOK, nullptr, nullptr, gw, NGW, lane); GSYNC(); PE(1); }
            PB(2);
            { pg8::Gemm g{HF, WL + (second ? O_FFN2_IN : O_FFN1_IN), TOK, 2 * FF, DMOD, DMOD, DMOD, 0, 0}; pg8::StaticOrder S; S.init(TOK, 2 * FF, G, bx);
              pg8::EpiSwiglu E{HID, FF};

#ifndef NO_G0
              pg8::gemm_phase<pg8::EpiSwiglu, pg8::StaticOrder, true, true>(ldsl, g, S, E, wave_s);
#endif
              }
            GSYNC(); PE(2); PB(3);
            { pg8::Gemm g{HID, WL + (second ? O_FFN2_OUT : O_FFN1_OUT), TOK, DMOD, FF, FF, FF, 0, 0}; pg8::StaticOrder S; S.init(TOK, DMOD, G, bx);
              pg8::EpiResid E{xsrc, xout, DMOD, 0.5f};

#ifndef NO_G1
              pg8::gemm_phase<pg8::EpiResid, pg8::StaticOrder, true, true>(ldsl, g, S, E, wave_s);
#endif
              }
            GSYNC(); PE(3);
        } else {
            const float* w_in_l = args.in[7] + (size_t)l * DMOD * DIN;
            PB(4);
#ifndef NO_FOXNORM
            { LANE_STATE(); norm_rows<true>(xout, args.in[6] + l * DMOD, PROJ + C_H, PP, TOK, w_in_l, FOXF, gw, NGW, lane); }
#endif
            if (l == 0) {
                pg8::Gemm g{MEMN, WB + O_WMEM, 2048, 2048, DMOD, DMOD, DMOD, 0, 0}; pg8::StaticOrder S; S.init(2048, 2048, G, bx);
                pg8::EpiBf16 E{MEMKV, MKP};

#ifndef NO_G2
              pg8::gemm_phase<pg8::EpiBf16, pg8::StaticOrder, true, true>(ldsl, g, S, E, wave_s);
#endif

            }
            GSYNC(); PE(4);
            {
                PB(5);
                { pg8::Gemm g{PROJ + C_H, WL + O_WIN, TOK, 4096, DMOD, PP, DMOD, 0, 0}; pg8::StaticOrder S; S.init(TOK, 4096, G, bx);
                  pg8::EpiBf16 E{PROJ, PP};

#ifndef NO_G3
              pg8::gemm_phase<pg8::EpiBf16, pg8::StaticOrder, true, true>(ldsl, g, S, E, wave_s);
#endif
              }
                GSYNC(); PE(5); PB(6);
#ifndef NO_PP1
                {
                    LANE_STATE();
                    if (gw < 64) {
                        const int bl = gw >> 3, h = gw & 7; const float bfv = args.in[8][l * 8 + h];
                        const f32x4* f4 = (const f32x4*)(FOXF + (size_t)(bl * 8 + h) * SEQL + lane * 64);
                        f32x4 lf[16]; float run = 0.f;
#pragma unroll
                        for (int i = 0; i < 16; ++i) lf[i] = f4[i];
#pragma unroll
                        for (int i = 0; i < 16; ++i) {
#pragma unroll
                            for (int e = 0; e < 4; ++e) { lf[i][e] = logsig(lf[i][e] + bfv); run += lf[i][e]; } }
                        float incl = run;
#pragma unroll
                        for (int o = 1; o < 64; o <<= 1) { const float t = __builtin_bit_cast(float, __builtin_amdgcn_ds_bpermute((lane - o) << 2, __builtin_bit_cast(int, incl))); if (lane >= o) incl += t; }
                        run = incl - run;
                        f32x4* cp = (f32x4*)(CK2 + (size_t)(bl * 8 + h) * SEQL + lane * 64);
#pragma unroll
                        for (int i = 0; i < 16; ++i) { f32x4 o4;
#pragma unroll
                            for (int e = 0; e < 4; ++e) { run += lf[i][e]; o4[e] = -run * LOG2E; }
                            cp[i] = o4; }
                    }
                    {
                        float gk[8];
#pragma unroll
                        for (int i = 0; i < 8; ++i) gk[i] = args.in[16][l * 128 + (lane & 15) * 8 + i];
                        for (int r = gw; r < 2048; r += NGW) { bf16* p = MEMKV + (size_t)r * MKP + l * 1024 + lane * 8; float v[8]; ld8(p, v); gnorm8<16>(v, gk, 1.0f); st8(p, v); }
                    }
                    float gqa[8], gka[8], gqc[8], gkc[8], gmq[8];
#pragma unroll
                    for (int i = 0; i < 8; ++i) { const int d = (lane & 7) * 8 + i; gqa[i] = args.in[9][l * 64 + d]; gka[i] = args.in[10][l * 64 + d]; gqc[i] = args.in[11][l * 64 + d]; gkc[i] = args.in[12][l * 64 + d];
                        gmq[i] = args.in[15][l * 128 + (lane & 15) * 8 + i]; }
                    const float invf = powf(500000.0f, -(float)(lane & 7) * 0.125f);
                    LAS float* scr = (LAS float*)ldsl;
                    for (int it = vcu; it < TOK / 64; it += G) {
                        const int m0 = it * 64;
                        float kacc[8];
#pragma unroll
                        for (int i = 0; i < 8; ++i) kacc[i] = 0.f;
                        for (int tt = 0; tt < 8; ++tt) {
                            const int m = m0 + wave * 8 + tt, s = m & (SEQL - 1);
                            bf16* row = PROJ + (size_t)m * PP;
                            const int w = 2 << (lane >> 4); const int cnt = (s + 1 < w) ? s + 1 : w;
                            const v4u rqa = *(const v4u*)(row + C_QA + lane * 8), rka = *(const v4u*)(row + C_KA + lane * 8), rqc = *(const v4u*)(row + C_QC + lane * 8),
                                      rkc = *(const v4u*)(row + C_KC + lane * 8), rmq = *(const v4u*)(row + C_MQ + lane * 8), rpu = *(const v4u*)(row + C_PU + lane * 8);
                            v4u rw[15];
#pragma unroll
                            for (int j = 1; j < 16; ++j) rw[j - 1] = (j < cnt) ? *(const v4u*)(row - (size_t)j * PP + C_PU + lane * 8) : (v4u){0u, 0u, 0u, 0u};
                            const float ang = (float)positions[m] * invf;
                            const float cs = cosf(ang), sn = sinf(ang);
                            float cc[8], ss[8];
#pragma unroll
                            for (int i = 0; i < 8; ++i) { cc[i] = __builtin_bit_cast(float, __builtin_amdgcn_readlane(__builtin_bit_cast(int, cs), i)); ss[i] = __builtin_bit_cast(float, __builtin_amdgcn_readlane(__builtin_bit_cast(int, sn), i)); }
                            float v[8];
                            un8(rqa, v); gnorm8<8>(v, gqa, 1.0f); rot8(v, cc, ss, lane & 7);
#pragma unroll
                            for (int i = 0; i < 8; ++i) v[i] *= C2_64;
                            st8(row + C_QA + lane * 8, v);
                            un8(rka, v); gnorm8<8>(v, gka, 1.0f); rot8(v, cc, ss, lane & 7); st8(row + C_KA + lane * 8, v);
#pragma unroll
                            for (int i = 0; i < 8; ++i) kacc[i] += v[i];
                            un8(rqc, v); gnorm8<8>(v, gqc, C2_64); st8(row + C_QC + lane * 8, v);
                            un8(rkc, v); gnorm8<8>(v, gkc, 1.0f); st8(row + C_KC + lane * 8, v);
                            un8(rmq, v); gnorm8<16>(v, gmq, C2_128); st8(row + C_MQ + lane * 8, v);
                            {
                                float u0[8], sm[8]; un8(rpu, u0);
#pragma unroll
                                for (int i = 0; i < 8; ++i) sm[i] = u0[i];
#pragma unroll
                                for (int j = 0; j < 15; ++j) { float t[8]; un8(rw[j], t);
#pragma unroll
                                    for (int i = 0; i < 8; ++i) sm[i] += t[i]; }
                                const float inv = 1.0f / (float)cnt;
#pragma unroll
                                for (int i = 0; i < 8; ++i) sm[i] = sm[i] * inv - u0[i];
                                st8(POOLED + (size_t)m * 512 + lane * 8, sm);
                            }
                        }
#pragma unroll
                        for (int i = 0; i < 8; ++i) scr[wave * 512 + lane * 8 + i] = kacc[i];
                        __syncthreads();
                        { float t = 0.f;
#pragma unroll
                          for (int w8 = 0; w8 < 8; ++w8) t += scr[w8 * 512 + tid];
                          const int bl = m0 >> 12, s0 = m0 & (SEQL - 1);
                          KMEAN[(size_t)((bl * 16 + (s0 >> 8)) * 4 + ((s0 >> 6) & 3)) * 512 + tid] = t * (1.0f / 256.0f); }
                        __syncthreads();
                    }
                }
#endif
                GSYNC(); PE(6); PB(7);
                {
                    float skipb;
                    { float mq = 0.f, mk = 0.f; for (int i = 0; i < 64; ++i) { mq = fmaxf(mq, fabsf(args.in[11][l * 64 + i])); mk = fmaxf(mk, fabsf(args.in[12][l * 64 + i])); }
                      skipb = 2.0f * (C2_64 * 64.0f * 1.01f * mq * mk) + 48.0f; *(volatile LAS float*)(ldsl + 133136) = skipb; __syncthreads(); }
                    for (int ui = vcu; ui < 512; ui += G)
                        for (int uj = 0; uj < 2; ++uj) {
                            const int pp = ui, bh = pp >> 3, s8 = pp & 7, bl = bh >> 3, h = bh & 7;
                            const int qb = (uj & 1) ? s8 : 15 - s8;
#ifndef NO_ATTN0
                            attn_body::attn_unit<0, 8>(bl, h, qb, (const attn_body::bf16*)(PROJ + C_QA), (const attn_body::bf16*)(PROJ + C_KA), (const attn_body::bf16*)(PROJ + C_VA), (attn_body::bf16*)(PROJ + C_QA), KMEAN, (char*)lds, wave_s, 0.f);
#endif
                        }
                    for (int u = vcu; u < 512; u += G) { const int bl = u >> 6, h = (u >> 4) & 3, qb = u & 15;
#ifndef NO_MEM
                        attn_body::mem_unit(bl * SEQL, bl, h, qb, (attn_body::bf16*)(PROJ + C_MQ), (const attn_body::bf16*)(MEMKV + l * 1024), (char*)lds, wave_s);
#endif
                    }
                    { pg8::Gemm g{POOLED, WL + O_WPOOL, TOK, 512, 512, 512, 512, 0, 0}; pg8::StaticOrder S; S.init(TOK, 512, G, bx);
                      pg8::EpiBf16 E{PROJ + C_PU, PP};

#ifndef NO_G4
              pg8::gemm_phase<pg8::EpiBf16, pg8::StaticOrder, true, true>(ldsl, g, S, E, wave_s);
#endif
              }
                    {
                        for (int guard = 0; guard < 1200; ++guard) {
                            { int z_; asm volatile("s_mov_b32 %0, 0" : "=s"(z_));
                              if (tid_from_wave(wave_s) == 0) *(volatile LAS unsigned*)(ldsl + 133144 + z_) = atomicAdd((unsigned*)args.ws + 3584 + 64 * l + z_, 1u); }
                            __syncthreads();
                            const int fu = __builtin_amdgcn_readfirstlane((int)*(volatile LAS unsigned*)(ldsl + 133144));
                            __syncthreads();
                            if (fu >= 1024) break;
                            const int qb = 15 - (fu >> 6), bh = fu & 63, bl = bh >> 3, h = bh & 7;
#ifndef NO_ATTN1
                            attn_body::attn_unit<1, 24>(bl, h, qb, (const attn_body::bf16*)(PROJ + C_QC), (const attn_body::bf16*)(PROJ + C_KC), (const attn_body::bf16*)(PROJ + C_VC), (attn_body::bf16*)(PROJ + C_QC), CK2, (char*)lds, wave_s, 0.f);
#endif
                        }
                    }
                }
                GSYNC(); PE(7); PB(8);
                { pg8::Gemm g{PROJ, WL + O_WBR, TOK, DMOD, 512, PP, DMOD, 512, (long)DMOD * DMOD, PROJ + C_H, WL + O_WIN + (size_t)4096 * DMOD, DMOD, 0, (long)DMOD * DMOD}; pg8::StaticOrder S; S.init(TOK, DMOD, G, bx, 8);
                  pg8::EpiGate E{PROJ + C_Z, PP, GS + (size_t)bx * 65536};

#ifndef NO_G5
              pg8::gemm_phase<pg8::EpiGate, pg8::StaticOrder, false, true>(ldsl, g, S, E, wave_s);
#endif
              }
                GSYNC(); PE(8); PB(9);
                { pg8::Gemm g{PROJ + C_Z, WL + O_WOUT, TOK, DMOD, DMOD, PP, DMOD, 0, 0}; pg8::StaticOrder S; S.init(TOK, DMOD, G, bx);
                  float* xo = xout;
                  pg8::EpiResid E{xo, xo, DMOD, 1.0f};

#ifndef NO_G6
              pg8::gemm_phase<pg8::EpiResid, pg8::StaticOrder, true, true>(ldsl, g, S, E, wave_s);
#endif
              }
                GSYNC(); PE(9);
            }
        }
    }
#ifdef PROBE_SYNC
    for (int i = 0; i < 20; ++i) GSYNC();
#endif
#ifdef PROBE_PHASE
    { const unsigned long long tend = __builtin_amdgcn_s_memrealtime() + probe_acc; while (__builtin_amdgcn_s_memrealtime() < tend) __builtin_amdgcn_s_sleep(8); }
#endif
}

extern "C" void kernel_launch(void* const* d_in, const int* in_sizes, int n_in, void* d_out, int out_size, void* d_ws, size_t ws_size, hipStream_t stream) {
    static int grid = 0;
    if (grid == 0) {
        if (n_in != 24 || out_size != TOK * DMOD || ws_size < WS_END) { fprintf(stderr, "kernel_launch: unexpected shapes (n_in %d out %d ws %zu)\n", n_in, out_size, ws_size); grid = -1; return; }
        int dev = 0, cus = 0, per_cu = 0;
        hipGetDevice(&dev); hipDeviceGetAttribute(&cus, hipDeviceAttributeMultiprocessorCount, dev);
        hipFuncSetAttribute((const void*)hybrid_fwd, hipFuncAttributeMaxDynamicSharedMemorySize, LDS_BYTES);
        hipOccupancyMaxActiveBlocksPerMultiprocessor(&per_cu, (const void*)hybrid_fwd, NWAVES * 64, LDS_BYTES);
        (void)hipGetLastError();
        if (per_cu < 1) per_cu = 1;
        grid = cus;
    }
    if (grid < 0) return;
    if (hipMemsetAsync(d_ws, 0, 16384, stream) != hipSuccess) { fprintf(stderr, "kernel_launch: memset of the barrier words failed\n"); return; }
    Args a{};
    for (int i = 0; i < 24; ++i) a.in[i] = (const float*)d_in[i];
    a.out = (float*)d_out; a.ws = (unsigned char*)d_ws;
    void* kargs[] = {&a};
    hipError_t e = hipLaunchCooperativeKernel((const void*)hybrid_fwd, dim3(grid), dim3(NWAVES * 64), kargs, LDS_BYTES, stream);
    if (e != hipSuccess) fprintf(stderr, "cooperative launch failed: %s (grid %d)\n", hipGetErrorString(e), grid);
}
```

```cpp
#include <hip/hip_runtime.h>
#include <hip/hip_cooperative_groups.h>
#include <hip/hip_bf16.h>
#include <cstdio>
#include <cstdint>
#include <cmath>
namespace cg = cooperative_groups;

__device__ __forceinline__ int tid_from_wave(int wave_s) { int l; asm volatile("v_mbcnt_lo_u32_b32 %0, -1, 0\n\tv_mbcnt_hi_u32_b32 %0, -1, %0" : "=v"(l)); return wave_s * 64 + l; }

template <int M> __device__ __forceinline__ float xor_lane(float v) {
    if constexpr (M < 32) { return __builtin_bit_cast(float, __builtin_amdgcn_ds_swizzle(__builtin_bit_cast(int, v), (M << 10) | 0x1f)); }
    else { const unsigned u = __builtin_bit_cast(unsigned, v); auto rr = __builtin_amdgcn_permlane32_swap(u, u, false, false); const unsigned a = rr[0], b = rr[1]; return __builtin_bit_cast(float, a == u ? b : a); }
}
__device__ __forceinline__ float sum_x32(float v) { const unsigned u = __builtin_bit_cast(unsigned, v); auto rr = __builtin_amdgcn_permlane32_swap(u, u, false, false); return __builtin_bit_cast(float, (unsigned)rr[0]) + __builtin_bit_cast(float, (unsigned)rr[1]); }
__device__ __forceinline__ float max_x32(float v) { const unsigned u = __builtin_bit_cast(unsigned, v); auto rr = __builtin_amdgcn_permlane32_swap(u, u, false, false); return __builtin_fmaxf(__builtin_bit_cast(float, (unsigned)rr[0]), __builtin_bit_cast(float, (unsigned)rr[1])); }

namespace pg8 {
#define PG8_LAS __attribute__((address_space(3)))
typedef unsigned short bf16_t;
typedef short bf16x8 __attribute__((ext_vector_type(8)));
typedef float f32x4 __attribute__((ext_vector_type(4)));
typedef unsigned u32x4 __attribute__((ext_vector_type(4)));
constexpr int BM = 256, BK = 64, HALF = 128, HTB = HALF * BK * 2  , STAGE_BYTES = 8 * HTB, NXCD = 8, WGM = 8;

__host__ __device__ __forceinline__ int lds_byte(int r, int c) { const int st = (r >> 4) * 2 + (c >> 5), rr = r & 15, cc = c & 31, ob = rr * 64 + cc * 2; return st * 1024 + (ob ^ (((ob >> 9) & 1) << 5)); }
__host__ __device__ __forceinline__ void stage_rc(int b, int& R, int& C) { const int st = b / 1024, sb = b % 1024, swz = sb ^ (((sb >> 9) & 1) << 5); R = (st >> 1) * 16 + swz / 64; C = (st & 1) * 32 + (swz % 64) / 2; }
__host__ __device__ __forceinline__ int perm32(int rho) { const int n = rho >> 4, i = rho & 15; return 8 * (i >> 2) + 4 * n + (i & 3); }

struct Unit { int pm, pn, z; };
struct Gemm { const bf16_t* A; const bf16_t* Bt; int M, N, K, lda, ldb; long azoff, bzoff;
    const bf16_t* A2 = nullptr; const bf16_t* Bt2 = nullptr; int K2 = 0; long a2z = 0, b2z = 0; };
__device__ __forceinline__ void unit_ptrs(const Gemm& g, const Unit& u, size_t tstepA, size_t tstepB, const char*& pa, const char*& pb, int& ntu) {
    if (g.K2 != 0) { const int zb = u.z >> 1;
        if (u.z & 1) { pa = (const char*)g.A2 + (size_t)u.pm * tstepA + (size_t)zb * g.a2z * 2; pb = (const char*)g.Bt2 + (size_t)u.pn * tstepB + (size_t)zb * g.b2z * 2; ntu = g.K2 / BK; }
        else { pa = (const char*)g.A + (size_t)u.pm * tstepA + (size_t)zb * g.azoff * 2; pb = (const char*)g.Bt + (size_t)u.pn * tstepB + (size_t)zb * g.bzoff * 2; ntu = g.K / BK; }
    } else { pa = (const char*)g.A + (size_t)u.pm * tstepA + (size_t)u.z * g.azoff * 2; pb = (const char*)g.Bt + (size_t)u.pn * tstepB + (size_t)u.z * g.bzoff * 2; ntu = g.K / BK; }
}

struct StaticOrder {
    int nM, nN, nwg, G, c, NZ;
    __host__ __device__ void init(int M, int N, int G_, int c_, int NZ_ = 1) { nM = M / BM; nN = N / BM; nwg = nM * nN; G = G_; c = c_; NZ = NZ_; }
    __host__ __device__ bool next(int i, Unit& u) const {
        const int zi = i % NZ, ii = i / NZ;
        const long L = (long)ii * G + c; if (L >= nwg) return false;
        int wgid = (int)L; { const int q = nwg / NXCD, r = nwg % NXCD, xcd = wgid % NXCD, off = wgid / NXCD; wgid = (xcd < r ? xcd * (q + 1) : r * (q + 1) + (xcd - r) * q) + off; }
        const int nig = WGM * nN, gid = wgid / nig, fm = gid * WGM, gsz = (nM - fm) < WGM ? (nM - fm) : WGM;
        u.pm = fm + ((wgid % nig) % gsz); u.pn = (wgid % nig) / gsz; u.z = zi; return true;
    }
    __device__ __forceinline__ void a_ready(const Unit&) const {}
    __device__ __forceinline__ void done(const Unit&) const {}
};

__device__ __forceinline__ unsigned cvt_pk_bf16(float lo, float hi) { unsigned r; asm volatile("v_cvt_pk_bf16_f32 %0, %1, %2" : "=v"(r) : "v"(lo), "v"(hi)); return r; }
__device__ __forceinline__ float bf_lo(unsigned w) { return __uint_as_float(w << 16); }
__device__ __forceinline__ float bf_hi(unsigned w) { return __uint_as_float(w & 0xffff0000u); }
__device__ __forceinline__ float sigm(float x) { return __builtin_amdgcn_rcpf(1.0f + __builtin_amdgcn_exp2f(-1.4426950408889634f * x)); }

struct EpiBf16 {
    static constexpr bool PERM = true, AFTER_DRAIN = false;
    bf16_t* O; int ldc;
    __device__ __forceinline__ void operator()(const f32x4 (&acc)[2][2][4][2], const Unit& u, int wr, int wc, int fr, int fq) const {
        const int row0 = u.pm * BM + wr * 64 + fr, col0 = u.pn * BM + wc * 32 + 8 * fq;
#pragma unroll
        for (int ai = 0; ai < 2; ++ai)
#pragma unroll
            for (int m = 0; m < 4; ++m) { bf16_t* rowp = O + (size_t)(row0 + ai * HALF + m * 16) * ldc + col0;
#pragma unroll
                for (int bj = 0; bj < 2; ++bj) { const f32x4 v0 = acc[ai][bj][m][0], v1 = acc[ai][bj][m][1];
                    u32x4 w; w.x = cvt_pk_bf16(v0[0], v0[1]); w.y = cvt_pk_bf16(v0[2], v0[3]); w.z = cvt_pk_bf16(v1[0], v1[1]); w.w = cvt_pk_bf16(v1[2], v1[3]);
                    *(u32x4*)(rowp + bj * HALF) = w; } }
    }
};
struct EpiSwiglu {
    static constexpr bool PERM = true, AFTER_DRAIN = false;
    bf16_t* O; int ldc;
    __device__ __forceinline__ void operator()(const f32x4 (&acc)[2][2][4][2], const Unit& u, int wr, int wc, int fr, int fq) const {
        const int row0 = u.pm * BM + wr * 64 + fr, col0 = u.pn * HALF + wc * 32 + 8 * fq;
#pragma unroll
        for (int ai = 0; ai < 2; ++ai)
#pragma unroll
            for (int m = 0; m < 4; ++m) { bf16_t* rowp = O + (size_t)(row0 + ai * HALF + m * 16) * ldc + col0;
                float r[8];
#pragma unroll
                for (int n = 0; n < 2; ++n)
#pragma unroll
                    for (int e = 0; e < 4; ++e) { const float g = acc[ai][0][m][n][e], uu = acc[ai][1][m][n][e]; r[n * 4 + e] = g * sigm(g) * uu; }
                u32x4 w; w.x = cvt_pk_bf16(r[0], r[1]); w.y = cvt_pk_bf16(r[2], r[3]); w.z = cvt_pk_bf16(r[4], r[5]); w.w = cvt_pk_bf16(r[6], r[7]);
                *(u32x4*)rowp = w; }
    }
};
struct EpiResid {
    static constexpr bool PERM = false, AFTER_DRAIN = false;
    const float* base; float* out; int ldc; float scale;
    __device__ __forceinline__ void operator()(const f32x4 (&acc)[2][2][4][2], const Unit& u, int wr, int wc, int fr, int fq) const {
        const int row0 = u.pm * BM + wr * 64 + fr, col0 = u.pn * BM + wc * 32 + 4 * fq;
#pragma unroll
        for (int ai = 0; ai < 2; ++ai) {
            f32x4 bs[4][2][2];
#pragma unroll
            for (int m = 0; m < 4; ++m) { const size_t off = (size_t)(row0 + ai * HALF + m * 16) * ldc + col0;
#pragma unroll
                for (int bj = 0; bj < 2; ++bj)
#pragma unroll
                    for (int n = 0; n < 2; ++n) bs[m][bj][n] = *(const f32x4*)(base + off + bj * HALF + n * 16); }
#pragma unroll
            for (int m = 0; m < 4; ++m) { const size_t off = (size_t)(row0 + ai * HALF + m * 16) * ldc + col0;
#pragma unroll
                for (int bj = 0; bj < 2; ++bj)
#pragma unroll
                    for (int n = 0; n < 2; ++n) *(f32x4*)(out + off + bj * HALF + n * 16) = bs[m][bj][n] + acc[ai][bj][m][n] * scale; }
            asm volatile("" ::: "memory");
        }
    }
};
__device__ __forceinline__ u32x4 ld16_l2(const bf16_t* p) { const unsigned long long* q = (const unsigned long long*)p;
    const unsigned long long a = __hip_atomic_load(q, __ATOMIC_RELAXED, __HIP_MEMORY_SCOPE_AGENT), b = __hip_atomic_load(q + 1, __ATOMIC_RELAXED, __HIP_MEMORY_SCOPE_AGENT);
    return (u32x4){(unsigned)a, (unsigned)(a >> 32), (unsigned)b, (unsigned)(b >> 32)}; }
struct EpiGate {
    static constexpr bool PERM = true, AFTER_DRAIN = false;
    bf16_t* Z; int ldz; bf16_t* GS;
    __device__ __forceinline__ void operator()(const f32x4 (&acc)[2][2][4][2], const Unit& u, int wr, int wc, int fr, int fq) const {
        int fr_ = fr, fq_ = fq; asm volatile("" : "+v"(fr_), "+v"(fq_));
        const int rl0 = wr * 64 + fr_, cl0 = wc * 32 + 8 * fq_, row0 = u.pm * BM + rl0, col0 = u.pn * BM + cl0, zb = u.z >> 1;
        if (!(u.z & 1)) {
#pragma unroll
            for (int ai = 0; ai < 2; ++ai)
#pragma unroll
                for (int m = 0; m < 4; ++m)
#pragma unroll
                    for (int bj = 0; bj < 2; ++bj) { const f32x4 v0 = acc[ai][bj][m][0], v1 = acc[ai][bj][m][1];
                        u32x4 w; w.x = cvt_pk_bf16(v0[0], v0[1]); w.y = cvt_pk_bf16(v0[2], v0[3]); w.z = cvt_pk_bf16(v1[0], v1[1]); w.w = cvt_pk_bf16(v1[2], v1[3]);
                        *(u32x4*)(GS + (size_t)(rl0 + ai * HALF + m * 16) * 256 + cl0 + bj * HALF) = w; }
            return;
        }
#pragma unroll
        for (int ai = 0; ai < 2; ++ai) {
            u32x4 gv[4][2], zv[4][2];
#pragma unroll
            for (int m = 0; m < 4; ++m)
#pragma unroll
                for (int bj = 0; bj < 2; ++bj) gv[m][bj] = ld16_l2(GS + (size_t)(rl0 + ai * HALF + m * 16) * 256 + cl0 + bj * HALF);
            if (zb > 0) {
#pragma unroll
                for (int m = 0; m < 4; ++m)
#pragma unroll
                    for (int bj = 0; bj < 2; ++bj) zv[m][bj] = ld16_l2(Z + (size_t)(row0 + ai * HALF + m * 16) * ldz + col0 + bj * HALF);
            }
#pragma unroll
            for (int m = 0; m < 4; ++m)
#pragma unroll
                for (int bj = 0; bj < 2; ++bj) {
                    const u32x4 g4 = gv[m][bj]; const f32x4 v0 = acc[ai][bj][m][0], v1 = acc[ai][bj][m][1];
                    float o[8];
                    o[0] = bf_lo(g4.x) * sigm(v0[0]); o[1] = bf_hi(g4.x) * sigm(v0[1]); o[2] = bf_lo(g4.y) * sigm(v0[2]); o[3] = bf_hi(g4.y) * sigm(v0[3]);
                    o[4] = bf_lo(g4.z) * sigm(v1[0]); o[5] = bf_hi(g4.z) * sigm(v1[1]); o[6] = bf_lo(g4.w) * sigm(v1[2]); o[7] = bf_hi(g4.w) * sigm(v1[3]);
                    if (zb > 0) { const u32x4 z4 = zv[m][bj];
                        o[0] += bf_lo(z4.x); o[1] += bf_hi(z4.x); o[2] += bf_lo(z4.y); o[3] += bf_hi(z4.y); o[4] += bf_lo(z4.z); o[5] += bf_hi(z4.z); o[6] += bf_lo(z4.w); o[7] += bf_hi(z4.w); }
                    u32x4 w; w.x = cvt_pk_bf16(o[0], o[1]); w.y = cvt_pk_bf16(o[2], o[3]); w.z = cvt_pk_bf16(o[4], o[5]); w.w = cvt_pk_bf16(o[6], o[7]);
                    *(u32x4*)(Z + (size_t)(row0 + ai * HALF + m * 16) * ldz + col0 + bj * HALF) = w; }
            asm volatile("" ::: "memory");
        }
    }
};

template <class Epi, class Sched, bool ALIGN_EPI = false, bool SP2 = false>
__device__ __forceinline__ void gemm_phase(PG8_LAS unsigned char* lds, const Gemm g, const Sched& S, const Epi& E, const int wave_s) {
    int tid_ = tid_from_wave(wave_s);
    const int tid = tid_, wid = __builtin_amdgcn_readfirstlane(tid >> 6), lane = tid & 63, wr = wid >> 2, wc = wid & 3, fr = lane & 15, fq = lane >> 4;
    const int lda = g.lda, ldb = g.ldb;
    unsigned voffA[2], voffB[2];
#pragma unroll
    for (int i = 0; i < 2; ++i) { int R, C; stage_rc(tid * 16 + i * 8192, R, C); const int Rb = Epi::PERM ? ((R & ~31) + perm32(R & 31)) : R;
        voffA[i] = (unsigned)(R * lda + C) * 2u; voffB[i] = (unsigned)(Rb * ldb + C) * 2u; }
    const size_t kstep = (size_t)(BK * 2);
    const size_t hstepA = (size_t)HALF * lda * 2, hstepB = (size_t)HALF * ldb * 2;
    const size_t tstepA = 2 * hstepA, tstepB = 2 * hstepB;
    const unsigned ldsw = (unsigned)wid * 1024u;
    const int aoff = lds_byte(wr * 64 + fr, fq * 8), boff = lds_byte(wc * 32 + fr, fq * 8);
#define PG8_SA(b, h) (((b) * 2 + (h)) * HTB)
#define PG8_SB(b, h) ((4 + (b) * 2 + (h)) * HTB)
#define PG8_STAGE(bufoff, gbase, voff) do { _Pragma("unroll") for (int _i = 0; _i < 2; ++_i) \
        __builtin_amdgcn_global_load_lds((const unsigned*)((const char*)(gbase) + (voff)[_i]), (PG8_LAS unsigned*)(lds + (bufoff) + ldsw + _i * 8192), 16, 0, 0); } while (0)
#define PG8_LDA(dst, b, h) do { _Pragma("unroll") for (int m = 0; m < 4; ++m) _Pragma("unroll") for (int k = 0; k < 2; ++k) dst[m][k] = *(const PG8_LAS bf16x8*)(lds + PG8_SA(b, h) + aoff + m * 2048 + k * 1024); } while (0)
#define PG8_LDB(dst, b, h) do { _Pragma("unroll") for (int n = 0; n < 2; ++n) _Pragma("unroll") for (int k = 0; k < 2; ++k) dst[n][k] = *(const PG8_LAS bf16x8*)(lds + PG8_SB(b, h) + boff + n * 2048 + k * 1024); } while (0)
#define PG8_MMA(ai, bj, At, Bt) do { __builtin_amdgcn_s_setprio(1); _Pragma("unroll") for (int m = 0; m < 4; ++m) _Pragma("unroll") for (int n = 0; n < 2; ++n) _Pragma("unroll") for (int k = 0; k < 2; ++k) \
        acc[ai][bj][m][n] = __builtin_amdgcn_mfma_f32_16x16x32_bf16(Bt[n][k], At[m][k], acc[ai][bj][m][n], 0, 0, 0); __builtin_amdgcn_s_setprio(0); } while (0)
#define PG8_WAIT_V(n) asm volatile("s_waitcnt vmcnt(" #n ")" ::: "memory")
#define PG8_WAIT_L(n) asm volatile("s_waitcnt lgkmcnt(" #n ")" ::: "memory")
#define PG8_BAR __builtin_amdgcn_s_barrier()
#define PG8_SCHED __builtin_amdgcn_sched_barrier(0)
    Unit cur, nxt; int ui = 0;
    if (!S.next(0, cur)) return;
    f32x4 acc[2][2][4][2];
#pragma unroll
    for (int a = 0; a < 2; ++a)
#pragma unroll
        for (int b = 0; b < 2; ++b)
#pragma unroll
            for (int m = 0; m < 4; ++m)
#pragma unroll
                for (int n = 0; n < 2; ++n) acc[a][b][m][n] = (f32x4){0.f, 0.f, 0.f, 0.f};
    bf16x8 At[4][2], B0[2][2], B1[2][2];
    const char* cA; const char* cB; int nt; unit_ptrs(g, cur, tstepA, tstepB, cA, cB, nt);
    S.a_ready(cur);
    if constexpr (SP2) {
        PG8_STAGE(PG8_SB(0, 0), cB, voffB); PG8_STAGE(PG8_SB(0, 1), cB + hstepB, voffB); PG8_STAGE(PG8_SA(0, 0), cA, voffA); PG8_STAGE(PG8_SA(0, 1), cA + hstepA, voffA);
        if (wr == 1) PG8_BAR;
        PG8_WAIT_V(2); PG8_BAR;
        PG8_STAGE(PG8_SB(1, 0), cB + kstep, voffB); PG8_STAGE(PG8_SA(1, 0), cA + kstep, voffA); PG8_STAGE(PG8_SB(1, 1), cB + hstepB + kstep, voffB);
        PG8_WAIT_V(6); PG8_BAR;
    } else {
        PG8_STAGE(PG8_SB(0, 0), cB, voffB); PG8_STAGE(PG8_SA(0, 0), cA, voffA); PG8_STAGE(PG8_SB(0, 1), cB + hstepB, voffB); PG8_STAGE(PG8_SA(0, 1), cA + hstepA, voffA);
        if (wr == 1) PG8_BAR;
        PG8_WAIT_V(4); PG8_BAR;
        PG8_STAGE(PG8_SB(1, 0), cB + kstep, voffB); PG8_STAGE(PG8_SA(1, 0), cA + kstep, voffA); PG8_STAGE(PG8_SB(1, 1), cB + hstepB + kstep, voffB);
        PG8_WAIT_V(6); PG8_BAR;
    }
    for (;;) {
        const bool has_next = S.next(ui + 1, nxt);
        const char* nA = cA; const char* nB = cB; int ntn = nt; if (has_next) unit_ptrs(g, nxt, tstepA, tstepB, nA, nB, ntn);
        for (int t = 0; t < nt; t += 2) {
            const bool last = (t == nt - 2);
            const char* a1 = cA + (size_t)(t + 1) * kstep;
            const char* a2 = last ? nA : cA + (size_t)(t + 2) * kstep; const char* b2 = last ? nB : cB + (size_t)(t + 2) * kstep;
            const char* a3 = a2 + kstep; const char* b3 = b2 + kstep;
            if (last && has_next) S.a_ready(nxt);
            if constexpr (SP2) {
            PG8_LDB(B0, 0, 0); PG8_LDB(B1, 0, 1); PG8_SCHED; PG8_LDA(At, 0, 0); PG8_STAGE(PG8_SA(1, 1), a1 + hstepA, voffA);
            PG8_WAIT_V(8); PG8_WAIT_L(0); PG8_BAR; PG8_MMA(0, 0, At, B0); PG8_MMA(0, 1, At, B1); PG8_BAR; PG8_SCHED;
            PG8_LDA(At, 0, 1); PG8_STAGE(PG8_SB(0, 0), b2, voffB); PG8_STAGE(PG8_SB(0, 1), b2 + hstepB, voffB); PG8_STAGE(PG8_SA(0, 0), a2, voffA);
            PG8_WAIT_V(8); PG8_WAIT_L(0); PG8_BAR; PG8_MMA(1, 0, At, B0); PG8_MMA(1, 1, At, B1); PG8_BAR; PG8_SCHED;
            PG8_LDB(B0, 1, 0); PG8_LDB(B1, 1, 1); PG8_SCHED; PG8_LDA(At, 1, 0); PG8_STAGE(PG8_SA(0, 1), a2 + hstepA, voffA);
            PG8_WAIT_V(8); PG8_WAIT_L(0); PG8_BAR; PG8_MMA(0, 0, At, B0); PG8_MMA(0, 1, At, B1); PG8_BAR; PG8_SCHED;
            PG8_LDA(At, 1, 1); PG8_STAGE(PG8_SB(1, 0), b3, voffB); PG8_STAGE(PG8_SB(1, 1), b3 + hstepB, voffB); PG8_STAGE(PG8_SA(1, 0), a3, voffA);
            PG8_WAIT_V(8); PG8_WAIT_L(0); PG8_BAR; PG8_MMA(1, 0, At, B0); PG8_MMA(1, 1, At, B1); PG8_BAR; PG8_SCHED;
            } else {
            PG8_LDB(B0, 0, 0); PG8_SCHED; PG8_LDA(At, 0, 0); PG8_STAGE(PG8_SA(1, 1), a1 + hstepA, voffA);
            PG8_WAIT_L(8); PG8_BAR; PG8_WAIT_L(0); PG8_MMA(0, 0, At, B0); PG8_BAR; PG8_SCHED;
            PG8_LDB(B1, 0, 1); PG8_STAGE(PG8_SB(0, 0), b2, voffB);
            PG8_BAR; PG8_WAIT_L(0); PG8_MMA(0, 1, At, B1); PG8_BAR;
            PG8_LDA(At, 0, 1); PG8_STAGE(PG8_SA(0, 0), a2, voffA);
            PG8_BAR; PG8_WAIT_L(0); PG8_MMA(1, 0, At, B0); PG8_BAR; PG8_SCHED;
            PG8_STAGE(PG8_SB(0, 1), b2 + hstepB, voffB);
            PG8_WAIT_V(6); PG8_BAR; PG8_MMA(1, 1, At, B1); PG8_BAR;
            PG8_LDB(B0, 1, 0); PG8_SCHED; PG8_LDA(At, 1, 0); PG8_STAGE(PG8_SA(0, 1), a2 + hstepA, voffA);
            PG8_WAIT_L(8); PG8_BAR; PG8_WAIT_L(0); PG8_MMA(0, 0, At, B0); PG8_BAR; PG8_SCHED;
            PG8_LDB(B1, 1, 1); PG8_STAGE(PG8_SB(1, 0), b3, voffB);
            PG8_BAR; PG8_WAIT_L(0); PG8_MMA(0, 1, At, B1); PG8_BAR;
            PG8_LDA(At, 1, 1); PG8_STAGE(PG8_SA(1, 0), a3, voffA);
            PG8_BAR; PG8_WAIT_L(0); PG8_MMA(1, 0, At, B0); PG8_BAR; PG8_SCHED;
            PG8_STAGE(PG8_SB(1, 1), b3 + hstepB, voffB);
            PG8_WAIT_V(6); PG8_BAR; PG8_MMA(1, 1, At, B1); PG8_BAR;
            }
        }
        if constexpr (ALIGN_EPI) { if (wr == 0) PG8_BAR; }
        if constexpr (!Epi::AFTER_DRAIN) { E(acc, cur, wr, wc, fr, fq); S.done(cur); }
        if (!has_next) break;
#pragma unroll
        for (int a = 0; a < 2; ++a)
#pragma unroll
            for (int b = 0; b < 2; ++b)
#pragma unroll
                for (int m = 0; m < 4; ++m)
#pragma unroll
                    for (int n = 0; n < 2; ++n) acc[a][b][m][n] = (f32x4){0.f, 0.f, 0.f, 0.f};
        cur = nxt; cA = nA; cB = nB; nt = ntn; ++ui;
        if constexpr (ALIGN_EPI) { if (wr == 1) PG8_BAR; }
    }
    PG8_WAIT_V(0);
    if constexpr (!ALIGN_EPI) { if (wr == 0) PG8_BAR; }
    PG8_BAR;
    if constexpr (Epi::AFTER_DRAIN) { E.fused(acc, cur, wr, wc, fr, fq, lds, wid, lane); S.done(cur); }
#undef PG8_SA
#undef PG8_SB
#undef PG8_STAGE
#undef PG8_LDA
#undef PG8_LDB
#undef PG8_MMA
#undef PG8_WAIT_V
#undef PG8_WAIT_L
#undef PG8_BAR
#undef PG8_SCHED
}
}

namespace attn_body {
using bf16=__hip_bfloat16;
using bf16x8=__attribute__((ext_vector_type(8)))short;
using s16x4=__attribute__((ext_vector_type(4)))short;
using f32x16=__attribute__((ext_vector_type(16)))float;
using u32x4=__attribute__((ext_vector_type(4)))unsigned;
constexpr int SEQ=4096,D=64,DM=5184,MKP=2112;
constexpr int NW=8,QBLK=32,QB=QBLK*NW,KVBLK=64,NQB=SEQ/QB;
constexpr int ATTN_PITCH=DM, ATTN_UNIT_ROWS=QB;
__device__ __forceinline__ int crow(int r,int hi){return (r&3)+8*(r>>2)+4*hi;}
#define SBAR() __builtin_amdgcn_sched_barrier(0)
__device__ __forceinline__ void cmask(f32x16&p0,f32x16&p1,int jb,int qrel,int hi){
  const float NEG=-INFINITY; int kb=64*jb+4*hi;
  #pragma unroll
  for(int r=0;r<16;++r){int kv=kb+(r&3)+8*(r>>2); if(kv>qrel)p0[r]=NEG; if(kv+32>qrel)p1[r]=NEG;}
}

constexpr int NSLOT=3, SLOTB=8192;
constexpr int LDS_K=0, LDS_V=NSLOT*SLOTB, LDS_WS=2*NSLOT*SLOTB, LDS_OST=LDS_WS+NW*64*4, LDS_BYTES=LDS_OST+NW*4096, LDS_AUX=86016;
constexpr float C2=0.125f*1.4426950408889634f;
__device__ __forceinline__ void glds16(const void*gsrc,unsigned lds_dst){unsigned keep;
  asm volatile("s_mov_b32 %0, m0\n\ts_mov_b32 m0, %2\n\ts_nop 0\n\tglobal_load_lds_dwordx4 %1, off\n\ts_mov_b32 m0, %0":"=&s"(keep):"v"(gsrc),"s"(lds_dst):"memory");}
__device__ __forceinline__ float max3f(float a,float b,float c){float r;asm("v_max3_f32 %0, %1, %2, %3":"=v"(r):"v"(a),"v"(b),"v"(c));return r;}
__device__ __forceinline__ float max2f(float a,float b){float r;asm("v_max_f32_e32 %0, %1, %2":"=v"(r):"v"(a),"v"(b));return r;}
__device__ __forceinline__ float fadd_s(float a,float b){float r;asm("v_add_f32_e32 %0, %1, %2":"=v"(r):"v"(a),"v"(b));return r;}
__device__ __forceinline__ float fsub_s(float a,float b){float r;asm("v_sub_f32_e32 %0, %1, %2":"=v"(r):"v"(a),"v"(b));return r;}
typedef float f32x4_t __attribute__((ext_vector_type(4))); typedef float f32x2_t __attribute__((ext_vector_type(2))); typedef __bf16 bf16x2_t __attribute__((ext_vector_type(2)));
__device__ __forceinline__ unsigned cvtpk_s(float lo,float hi){f32x2_t v={lo,hi};bf16x2_t b=__builtin_convertvector(v,bf16x2_t);return __builtin_bit_cast(unsigned,b);}
#define WAIT_BAR(N) asm volatile("s_waitcnt vmcnt(" #N ") lgkmcnt(0)\n\ts_barrier":::"memory")

__device__ __forceinline__ void qkt(f32x16&p0,f32x16&p1,const char*Kslot,const bf16x8*qr,const f32x16&negm,int r32,int hi){
  const char*kb=Kslot+hi*1024+r32*16;
  #pragma unroll
  for(int d0=0;d0<4;++d0){
    const bf16x8 b0=*reinterpret_cast<const bf16x8*>(kb+d0*2048);
    const bf16x8 b1=*reinterpret_cast<const bf16x8*>(kb+d0*2048+512);
    if(d0==0){p0=__builtin_amdgcn_mfma_f32_32x32x16_bf16(b0,qr[0],negm,0,0,0);p1=__builtin_amdgcn_mfma_f32_32x32x16_bf16(b1,qr[0],negm,0,0,0);}
    else{p0=__builtin_amdgcn_mfma_f32_32x32x16_bf16(b0,qr[d0],p0,0,0,0);p1=__builtin_amdgcn_mfma_f32_32x32x16_bf16(b1,qr[d0],p1,0,0,0);}}
}
typedef __attribute__((address_space(3))) const char* lds_cptr;
typedef short v4i16_t __attribute__((ext_vector_type(4)));
__device__ __forceinline__ void kload8(bf16x8*kf,lds_cptr kp){
  kf[0]=*(const __attribute__((address_space(3))) bf16x8*)(kp);      kf[1]=*(const __attribute__((address_space(3))) bf16x8*)(kp+512);
  kf[2]=*(const __attribute__((address_space(3))) bf16x8*)(kp+2048); kf[3]=*(const __attribute__((address_space(3))) bf16x8*)(kp+2560);
  kf[4]=*(const __attribute__((address_space(3))) bf16x8*)(kp+4096); kf[5]=*(const __attribute__((address_space(3))) bf16x8*)(kp+4608);
  kf[6]=*(const __attribute__((address_space(3))) bf16x8*)(kp+6144); kf[7]=*(const __attribute__((address_space(3))) bf16x8*)(kp+6656);
}
__device__ __forceinline__ void kload2(bf16x8*kf,lds_cptr kp,int j){ kf[2*j]=*(const __attribute__((address_space(3))) bf16x8*)(kp+j*2048); kf[2*j+1]=*(const __attribute__((address_space(3))) bf16x8*)(kp+j*2048+512); }
__device__ __forceinline__ s16x4 vtr(lds_cptr p){ return __builtin_bit_cast(s16x4,__builtin_amdgcn_ds_read_tr16_b64_v4i16((__attribute__((address_space(3))) v4i16_t*)p)); }
__device__ __forceinline__ float rowmax(const f32x16&p0,const f32x16&p1){
  float a=max3f(p0[0],p0[1],p1[0]),b=max3f(p0[2],p0[3],p1[1]);a=max3f(a,p1[2],p1[3]);
  #pragma unroll
  for(int r=4;r<16;r+=4){a=max3f(a,p0[r],p0[r+1]);b=max3f(b,p0[r+2],p0[r+3]);a=max3f(a,p1[r],p1[r+1]);b=max3f(b,p1[r+2],p1[r+3]);}
  const float m=max2f(a,b);
  auto rr=__builtin_amdgcn_permlane32_swap(__float_as_uint(m),__float_as_uint(m),false,false);
  return max2f(__uint_as_float(rr[0]),__uint_as_float(rr[1]));
}
__device__ __forceinline__ void pv(f32x16*o,int vb,bf16x8 pa0,bf16x8 pa1,bf16x8 pa2,bf16x8 pa3){
  #pragma unroll
  for(int d0=0;d0<2;++d0){s16x4 lo[4],hi[4];
    #pragma unroll
    for(int ks=0;ks<4;++ks){
      asm volatile("ds_read_b64_tr_b16 %0,%1 offset:%c2":"=&v"(lo[ks]):"v"(vb),"i"(d0*4096+ks*1024):"memory");
      asm volatile("ds_read_b64_tr_b16 %0,%1 offset:%c2":"=&v"(hi[ks]):"v"(vb),"i"(d0*4096+ks*1024+512):"memory");}
    asm volatile("s_waitcnt lgkmcnt(0)":::"memory");SBAR();
    #define PK(k) (bf16x8){lo[k][0],lo[k][1],lo[k][2],lo[k][3],hi[k][0],hi[k][1],hi[k][2],hi[k][3]}
    o[d0]=__builtin_amdgcn_mfma_f32_32x32x16_bf16(pa0,PK(0),o[d0],0,0,0);
    o[d0]=__builtin_amdgcn_mfma_f32_32x32x16_bf16(pa1,PK(1),o[d0],0,0,0);
    o[d0]=__builtin_amdgcn_mfma_f32_32x32x16_bf16(pa2,PK(2),o[d0],0,0,0);
    o[d0]=__builtin_amdgcn_mfma_f32_32x32x16_bf16(pa3,PK(3),o[d0],0,0,0);
    #undef PK
  }
}

#ifndef ATTN_STORE16
#define ATTN_STORE16(p,v) (*(u32x4*)(p)=(v))
#endif
typedef __attribute__((address_space(3))) float lds_f32; typedef __attribute__((address_space(3))) f32x4_t lds_f32x4;
template<int MODE,int THRL> __device__ __forceinline__ void attn_unit(int b,int h,int qb,const bf16*Q,const bf16*__restrict__ K,const bf16*__restrict__ V,bf16*O,const float*__restrict__ aux,char*shm,const int wave_s,const float skipb_unused){
  const int tid=tid_from_wave(wave_s),lane=tid&63,r32=lane&31,hi=lane>>5; const int wid=wave_s;
  const long rowbase=(long)b*SEQ; const int q0=qb*QB;
  const bf16*Qw=Q+(rowbase+q0+wid*QBLK)*DM+h*D;
  int t0=0;
  if(MODE==1){ if(qb>0){ const float skipb=*(const volatile __attribute__((address_space(3))) float*)((lds_cptr)shm+133136); const float*p=aux+(size_t)(b*8+h)*SEQ; const float cq=p[q0]; const bool sk=(lane<4*qb)&&(cq-p[(lane<4*qb?lane:0)*64+63]>=skipb);
      const unsigned long long mk=__ballot(sk); t0=(int)__builtin_ctzll(~mk); t0=__builtin_amdgcn_readfirstlane(t0)&~1; } }
  const bf16*Kh=K+(rowbase+(long)t0*64)*DM+h*D,*Vh=V+(rowbase+(long)t0*64)*DM+h*D;
  const unsigned lds0=(unsigned)(uintptr_t)shm;
  float*wsf=(float*)(shm+LDS_WS)+wid*64;
  const bf16*ksrc=Kh+(long)lane*DM+wid*8;
  const bf16*vsrc=Vh+(long)(16*(wid&3)+(lane>>2))*DM+(wid>>2)*32+(lane&3)*8;
  const unsigned kdst=lds0+LDS_K+wid*1024, vdst=lds0+LDS_V+wid*1024;
  #define DMA_K(t,slot) glds16(ksrc+(long)(t)*KVBLK*DM,(unsigned)__builtin_amdgcn_readfirstlane(kdst+(slot)))
  #define DMA_V(t,slot) glds16(vsrc+(long)(t)*KVBLK*DM,(unsigned)__builtin_amdgcn_readfirstlane(vdst+(slot)))
  const char*Kbase=shm+LDS_K; bf16x8 kf[8];
  const lds_cptr shm3=(lds_cptr)shm; const lds_cptr kp0=shm3+LDS_K+hi*1024+r32*16; const lds_cptr vp0=shm3+LDS_V+((lane>>4)&1)*32+(lane&3)*8+(4*hi+((lane&15)>>2))*64;
  const int NT=(q0+QB)/KVBLK-t0;
  lds_f32* auxl=(lds_f32*)(shm3+LDS_AUX);
  if(MODE==0){ for(int e=tid;e<qb*64;e+=512){ const int j=e>>6,dd=e&63; const float*p=aux+(size_t)((b*16+j)*4)*512+h*64+dd; auxl[e]=(p[0]+p[512])+(p[1024]+p[1536]); } }
  else { const float*p=aux+(size_t)(b*8+h)*SEQ+t0*64; for(int e=tid*4;e<NT*64;e+=2048){ *(lds_f32x4*)(auxl+e)=*(const f32x4_t*)(p+e); } }
  asm volatile("s_waitcnt vmcnt(0) lgkmcnt(0)\n\ts_barrier":::"memory");
  DMA_K(0,0);DMA_V(0,0);DMA_K(1,SLOTB);
  bf16x8 qr[4];
  #pragma unroll
  for(int d0=0;d0<4;++d0)qr[d0]=*reinterpret_cast<const bf16x8*>(&Qw[(long)r32*DM+d0*16+hi*8]);
  float mhat=0.f,l_reg=0.f;f32x16 o[2];o[0]=f32x16{};o[1]=f32x16{};f32x16 negm=f32x16{};if(MODE==0)asm volatile("":"+v"(negm));
  #define CINIT (MODE==0?negm:f32x16{})
  const int qrel=wid*QBLK+r32;
  #define CMASK(P0,P1,t) do{int jb_=(t)-(NT-4); if(jb_>=0)cmask(P0,P1,jb_,qrel,hi);}while(0)
  bool resc=false;
  #define START(P0,P1) do{ const float rm=rowmax(P0,P1); resc=false; \
    { const float dl=__builtin_fmaxf(rm,-30.f); mhat=fadd_s(mhat,dl); \
      _Pragma("unroll") for(int r=0;r<16;++r){P0[r]=fsub_s(P0[r],dl);P1[r]=fsub_s(P1[r],dl);} \
      if(MODE==0){ _Pragma("unroll") for(int r=0;r<16;++r)negm[r]=-mhat; asm volatile("":"+v"(negm)); } } \
    _Pragma("unroll") for(int r=0;r<16;++r)P0[r]=__builtin_amdgcn_exp2f(P0[r]); }while(0)
  #define RESC() do{ if(resc){ asm volatile("s_waitcnt lgkmcnt(0)":::"memory"); \
      _Pragma("unroll") for(int d_=0;d_<2;++d_) _Pragma("unroll") for(int r=0;r<16;++r)o[d_][r]*=wsf[crow(r,hi)]; } }while(0)
  f32x16 pA0,pA1,pB0,pB1;
  int sl_prev=0,sl_cur=0,sl_next=SLOTB;
  #define ROT() do{sl_prev=sl_cur;sl_cur=sl_next;sl_next=(sl_next==(NSLOT-1)*SLOTB)?0:sl_next+SLOTB;}while(0)
  DMA_K(2,2*SLOTB);
  WAIT_BAR(3);
  unsigned sel=0u;
  if(MODE==0){ float v1=-3.0e38f,v2=-3.0e38f,v3=-3.0e38f; int i1=-1,i2=-1,i3=-1;
    for(int j=0;j<qb;++j){ const lds_f32* km=auxl+j*64+hi*8; float g=0.f;
      _Pragma("unroll") for(int d0=0;d0<4;++d0){ const f32x4_t a=*(const lds_f32x4*)(km+d0*16), c=*(const lds_f32x4*)(km+d0*16+4);
        g+=__uint_as_float((unsigned)(unsigned short)qr[d0][0]<<16)*a[0]; g+=__uint_as_float((unsigned)(unsigned short)qr[d0][1]<<16)*a[1]; g+=__uint_as_float((unsigned)(unsigned short)qr[d0][2]<<16)*a[2]; g+=__uint_as_float((unsigned)(unsigned short)qr[d0][3]<<16)*a[3];
        g+=__uint_as_float((unsigned)(unsigned short)qr[d0][4]<<16)*c[0]; g+=__uint_as_float((unsigned)(unsigned short)qr[d0][5]<<16)*c[1]; g+=__uint_as_float((unsigned)(unsigned short)qr[d0][6]<<16)*c[2]; g+=__uint_as_float((unsigned)(unsigned short)qr[d0][7]<<16)*c[3]; }
      g=sum_x32(g);
      if(g>v1){v3=v2;i3=i2;v2=v1;i2=i1;v1=g;i1=j;} else if(g>v2){v3=v2;i3=i2;v2=g;i2=j;} else if(g>v3){v3=g;i3=j;} }
    sel=(i1>=0?(1u<<i1):0u)|(i2>=0?(1u<<i2):0u)|(i3>=0?(1u<<i3):0u); }
  #define HOOK(P0,P1,t) do{ if(MODE==0){ const int j_=(t)>>2; if(j_<qb){ if(!((sel>>j_)&1u)){ _Pragma("unroll") for(int r=0;r<16;++r){P0[r]=-INFINITY;P1[r]=-INFINITY;} } } } \
    else { const lds_f32* bp_=auxl+64*(t)+4*hi; const float nm_=-mhat; _Pragma("unroll") for(int g_=0;g_<4;++g_){ const f32x4_t b0_=*(const lds_f32x4*)(bp_+8*g_)+nm_; const f32x4_t b1_=*(const lds_f32x4*)(bp_+32+8*g_)+nm_; \
        P0[4*g_]+=b0_[0];P0[4*g_+1]+=b0_[1];P0[4*g_+2]+=b0_[2];P0[4*g_+3]+=b0_[3]; P1[4*g_]+=b1_[0];P1[4*g_+1]+=b1_[1];P1[4*g_+2]+=b1_[2];P1[4*g_+3]+=b1_[3]; } } }while(0)
  qkt(pA0,pA1,Kbase,qr,CINIT,r32,hi);asm volatile("s_nop 15\n\ts_nop 7":"+v"(pA0),"+v"(pA1));HOOK(pA0,pA1,0);CMASK(pA0,pA1,0);
  START(pA0,pA1);
  _Pragma("unroll") for(int r=0;r<16;++r)pA1[r]=__builtin_amdgcn_exp2f(pA1[r]);
  WAIT_BAR(0);
  DMA_K(3,0);DMA_V(1,SLOTB);
  ROT();
  kload8(kf,kp0+sl_cur);
  WAIT_BAR(2);
  s16x4 vlo[8],vhi[8]; u32x4 pw0,pw1,pw2,pw3;
  #define PKW(P,B) cvtpk_s(P[B],P[B+1])
  #define PAF(k) __builtin_bit_cast(bf16x8,pw##k)
  #define VFR(i) (bf16x8){vlo[i][0],vlo[i][1],vlo[i][2],vlo[i][3],vhi[i][0],vhi[i][1],vhi[i][2],vhi[i][3]}
  #define PIN(x) asm volatile("":"+v"(x))
  #define MX3(a,b,c) __builtin_fmaxf(__builtin_fmaxf((a),(b)),(c))
  #define GAPA(MF,A0,A1,A2,A3,W0,W1,PW) do{ MF; sacc+=A0; sacc+=A1; sacc+=A2; sacc+=A3; PIN(sacc); W0; W1; PIN(PW); SBAR(); }while(0)
  #define EX(v) __builtin_amdgcn_exp2f(v)
  #define GAPB(MF,X,B) do{ MF; X[B]=EX(X[B]); X[B+1]=EX(X[B+1]); X[B+2]=EX(X[B+2]); X[B+3]=EX(X[B+3]); PIN(X); SBAR(); }while(0)
  #define VRD(i) do{ vlo[i]=vtr(vp_+(((i)>>2)*4096+((i)&3)*1024)); vhi[i]=vtr(vp_+(((i)>>2)*4096+((i)&3)*1024+512)); }while(0)
  #define KRD(G,j) do{ if(G){ kload2(kf,kp0+sl_next,j); SBAR(); } }while(0)
  #define STEP(C0,C1,P0,P1,t,GK,GV,GL) do{ SBAR(); \
    const lds_cptr vp_=vp0+sl_prev; \
    VRD(0); SBAR(); float sacc=(P0[0]+P0[1]); \
    GAPA(C0=__builtin_amdgcn_mfma_f32_32x32x16_bf16(kf[0],qr[0],CINIT,0,0,0), P0[2],P0[3],P0[4],P0[5],     pw0[0]=PKW(P0,0), pw0[1]=PKW(P0,2), pw0); \
    VRD(4); SBAR(); GAPA(C1=__builtin_amdgcn_mfma_f32_32x32x16_bf16(kf[1],qr[0],CINIT,0,0,0), P0[6],P0[7],P0[8],P0[9],     pw0[2]=PKW(P0,4), pw0[3]=PKW(P0,6), pw0); \
    VRD(1); SBAR(); GAPA(C0=__builtin_amdgcn_mfma_f32_32x32x16_bf16(kf[2],qr[1],C0,0,0,0),   P0[10],P0[11],P0[12],P0[13], pw1[0]=PKW(P0,8), pw1[1]=PKW(P0,10), pw1); \
    VRD(5); SBAR(); GAPA(C1=__builtin_amdgcn_mfma_f32_32x32x16_bf16(kf[3],qr[1],C1,0,0,0),   P0[14],P0[15],P1[0],P1[1],   pw1[2]=PKW(P0,12),pw1[3]=PKW(P0,14), pw1); \
    VRD(2); SBAR(); GAPA(C0=__builtin_amdgcn_mfma_f32_32x32x16_bf16(kf[4],qr[2],C0,0,0,0),   P1[2],P1[3],P1[4],P1[5],     pw2[0]=PKW(P1,0), pw2[1]=PKW(P1,2), pw2); \
    VRD(6); SBAR(); GAPA(C1=__builtin_amdgcn_mfma_f32_32x32x16_bf16(kf[5],qr[2],C1,0,0,0),   P1[6],P1[7],P1[8],P1[9],     pw2[2]=PKW(P1,4), pw2[3]=PKW(P1,6), pw2); \
    VRD(3); SBAR(); GAPA(C0=__builtin_amdgcn_mfma_f32_32x32x16_bf16(kf[6],qr[3],C0,0,0,0),   P1[10],P1[11],P1[12],P1[13], pw3[0]=PKW(P1,8), pw3[1]=PKW(P1,10), pw3); \
    VRD(7); SBAR(); GAPA(C1=__builtin_amdgcn_mfma_f32_32x32x16_bf16(kf[7],qr[3],C1,0,0,0),   P1[14],P1[15],0.f,0.f,       pw3[2]=PKW(P1,12),pw3[3]=PKW(P1,14), pw3); \
    l_reg+=sacc; \
    if(GK){DMA_K((t)+3,sl_cur);} if(GV){DMA_V((t)+1,sl_next);} \
    HOOK(C0,C1,t); CMASK(C0,C1,t); \
    { float a=MX3(C0[0],C0[1],C1[0]),b=MX3(C0[2],C0[3],C1[1]); a=MX3(a,C1[2],C1[3]); \
      _Pragma("unroll") for(int r=4;r<16;r+=4){a=MX3(a,C0[r],C0[r+1]);b=MX3(b,C0[r+2],C0[r+3]);a=MX3(a,C1[r],C1[r+1]);b=MX3(b,C1[r+2],C1[r+3]);} \
      float rm=__builtin_fmaxf(a,b); { auto rr=__builtin_amdgcn_permlane32_swap(__float_as_uint(rm),__float_as_uint(rm),false,false); rm=__builtin_fmaxf(__uint_as_float(rr[0]),__uint_as_float(rr[1])); } \
      resc=false; \
      if(__builtin_expect(__any(rm>(float)THRL),0)){ const float dl=__builtin_fmaxf(rm,0.f); mhat+=dl; \
        _Pragma("unroll") for(int r=0;r<16;++r){C0[r]-=dl;C1[r]-=dl;} \
        if(MODE==0){ _Pragma("unroll") for(int r=0;r<16;++r)negm[r]=-mhat; asm volatile("":"+v"(negm)); } \
        const float f=__builtin_amdgcn_exp2f(-dl); l_reg*=f; if(hi==0)wsf[r32]=f; resc=true; } } \
    SBAR(); \
    GAPB(o[0]=__builtin_amdgcn_mfma_f32_32x32x16_bf16(PAF(0),VFR(0),o[0],0,0,0), C0,0); \
    GAPB(o[1]=__builtin_amdgcn_mfma_f32_32x32x16_bf16(PAF(0),VFR(4),o[1],0,0,0), C0,4); \
    KRD(GL,0); GAPB(o[0]=__builtin_amdgcn_mfma_f32_32x32x16_bf16(PAF(1),VFR(1),o[0],0,0,0), C0,8); \
    KRD(GL,1); GAPB(o[1]=__builtin_amdgcn_mfma_f32_32x32x16_bf16(PAF(1),VFR(5),o[1],0,0,0), C0,12); \
    KRD(GL,2); GAPB(o[0]=__builtin_amdgcn_mfma_f32_32x32x16_bf16(PAF(2),VFR(2),o[0],0,0,0), C1,0); \
    KRD(GL,3); GAPB(o[1]=__builtin_amdgcn_mfma_f32_32x32x16_bf16(PAF(2),VFR(6),o[1],0,0,0), C1,4); \
    GAPB(o[0]=__builtin_amdgcn_mfma_f32_32x32x16_bf16(PAF(3),VFR(3),o[0],0,0,0), C1,8); \
    GAPB(o[1]=__builtin_amdgcn_mfma_f32_32x32x16_bf16(PAF(3),VFR(7),o[1],0,0,0), C1,12); \
    }while(0)
  int t=1;
  #undef CMASK
  #define CMASK(P0,P1,t) do{}while(0)
  for(;t+5<NT;t+=2){
    STEP(pB0,pB1,pA0,pA1,t,true,true,true);     WAIT_BAR(2); RESC(); ROT();
    STEP(pA0,pA1,pB0,pB1,t+1,true,true,true);   WAIT_BAR(2); RESC(); ROT();
  }
  #undef CMASK
  #define CMASK(P0,P1,t) do{int jb_=(t)-(NT-4); if(jb_>=0)cmask(P0,P1,jb_,qrel,hi);}while(0)
  #define ENDW(tt) do{ if((tt)+3<NT){WAIT_BAR(2);} else if((tt)+2<NT){WAIT_BAR(1);} else {WAIT_BAR(0);} }while(0)
  for(;t+1<NT;t+=2){
    STEP(pB0,pB1,pA0,pA1,t,(t+3<NT),(t+1<NT),(t+1<NT));       ENDW(t);   RESC(); ROT();
    STEP(pA0,pA1,pB0,pB1,t+1,(t+4<NT),(t+2<NT),(t+2<NT));     ENDW(t+1); RESC(); ROT();
  }
  STEP(pB0,pB1,pA0,pA1,NT-1,false,false,false); RESC();
  { float sacc=pB0[0]+pB0[1]; _Pragma("unroll") for(int r=2;r<16;++r)sacc+=pB0[r]; _Pragma("unroll") for(int r=0;r<16;++r)sacc+=pB1[r]; l_reg+=sacc;
    pw0=(u32x4){PKW(pB0,0),PKW(pB0,2),PKW(pB0,4),PKW(pB0,6)};pw1=(u32x4){PKW(pB0,8),PKW(pB0,10),PKW(pB0,12),PKW(pB0,14)};pw2=(u32x4){PKW(pB1,0),PKW(pB1,2),PKW(pB1,4),PKW(pB1,6)};pw3=(u32x4){PKW(pB1,8),PKW(pB1,10),PKW(pB1,12),PKW(pB1,14)};
    SBAR(); const int vb0=(int)(lds0+LDS_V)+((lane>>4)&1)*32+(lane&3)*8+(4*hi+((lane&15)>>2))*64; pv(o,vb0+sl_cur,PAF(0),PAF(1),PAF(2),PAF(3)); }
  #undef PKW
  #undef PAF
  #undef VFR
  #undef PIN
  #undef MX3
  #undef GAPA
  #undef GAPB
  #undef EX
  #undef VRD
  #undef KRD
  #undef STEP
  #undef ENDW
  {auto rr=__builtin_amdgcn_permlane32_swap(__float_as_uint(l_reg),__float_as_uint(l_reg),false,false);l_reg=__uint_as_float(rr[0])+__uint_as_float(rr[1]);}
  if(hi==0)wsf[32+r32]=l_reg;asm volatile("s_waitcnt lgkmcnt(0)":::"memory");
  float rli[16];
  #pragma unroll
  for(int r=0;r<16;++r)rli[r]=__builtin_amdgcn_rcpf(wsf[32+crow(r,hi)]);
  bf16*Ow=O+(rowbase+q0+wid*QBLK)*DM+h*D;
  { bf16*stg=(bf16*)(shm+LDS_OST)+wid*2048;
    #pragma unroll
    for(int r=0;r<16;++r){const int orow=crow(r,hi);
      #pragma unroll
      for(int d0=0;d0<2;++d0)stg[orow*64+d0*32+r32]=__float2bfloat16(o[d0][r]*rli[r]);}
    asm volatile("s_waitcnt lgkmcnt(0)":::"memory");
    #pragma unroll
    for(int i=0;i<4;++i){const int row=i*8+(lane>>3),ch=lane&7; const u32x4 v=*(const u32x4*)(stg+row*64+ch*8); ATTN_STORE16(Ow+(long)row*DM+ch*8,v);} }
  asm volatile("s_waitcnt lgkmcnt(0)\n\ts_barrier":::"memory");
  #undef DMA_K
  #undef DMA_V
  #undef CMASK
  #undef HOOK
  #undef CINIT
  #undef START
  #undef RESC
  #undef ROT
}
#undef SBAR
#undef WAIT_BAR
}

namespace attn_body {
#define SBAR() __builtin_amdgcn_sched_barrier(0)
__device__ __forceinline__ void mem_unit(int brow,int bglob,int h,int qb,bf16*QO,const bf16*__restrict__ MK,char*shm,const int wave_s){
  const int tid=tid_from_wave(wave_s),lane=tid&63,r32=lane&31,hi=lane>>5; const int wid=wave_s;
  const lds_cptr shm3=(lds_cptr)shm; const unsigned lds0=(unsigned)(uintptr_t)shm;
  typedef __attribute__((address_space(3))) u32x4 lds_u32x4;
  const bf16*kg=MK+(size_t)(bglob*256)*MKP+h*128; const bf16*vg=kg+512;
  {
    const bf16*kp=kg+(size_t)(tid&255)*MKP+(tid>>8)*8; const lds_cptr kl=shm3+((tid&255)>>6)*16384+(tid>>8)*1024+(tid&63)*16;
    const bf16*vp=vg+(size_t)(tid>>2)*MKP+(tid&3)*8; const lds_cptr vl=shm3+65536+((tid>>2)>>6)*16384+((tid>>2)&63)*64+(tid&3)*16;
    #pragma unroll 2
    for(int i=0;i<8;i+=4){ u32x4 t0=*(const u32x4*)(kp+(i+0)*16),t1=*(const u32x4*)(kp+(i+1)*16),t2=*(const u32x4*)(kp+(i+2)*16),t3=*(const u32x4*)(kp+(i+3)*16);
      *(lds_u32x4*)(kl+(i+0)*2048)=t0; *(lds_u32x4*)(kl+(i+1)*2048)=t1; *(lds_u32x4*)(kl+(i+2)*2048)=t2; *(lds_u32x4*)(kl+(i+3)*2048)=t3; }
    #pragma unroll 2
    for(int i=0;i<8;i+=2){ u32x4 t0=*(const u32x4*)(vp+(i>>1)*32),t1=*(const u32x4*)(vp+(size_t)128*MKP+(i>>1)*32);
      *(lds_u32x4*)(vl+(i>>1)*4096)=t0; *(lds_u32x4*)(vl+32768+(i>>1)*4096)=t1; } }
  bf16*Qw=QO+(size_t)(brow+qb*256+wid*32)*DM+h*128;
  bf16x8 qr[8];
  #pragma unroll
  for(int d0=0;d0<8;++d0)qr[d0]=*reinterpret_cast<const bf16x8*>(&Qw[(size_t)r32*DM+d0*16+hi*8]);
  asm volatile("s_waitcnt vmcnt(0) lgkmcnt(0)\n\ts_barrier":::"memory");
  lds_f32* wsf=(lds_f32*)(shm3+131072)+wid*64;
  float m=-INFINITY,l_reg=0.f; f32x16 o[4]; o[0]=f32x16{};o[1]=f32x16{};o[2]=f32x16{};o[3]=f32x16{};
  const int vbl=((lane>>4)&1)*32+(lane&3)*8+(4*hi+((lane&15)>>2))*64;
  #pragma unroll 1
  for(int kt=0;kt<4;++kt){
    f32x16 p0=f32x16{},p1=f32x16{};
    const lds_cptr kb=shm3+kt*16384+hi*1024+r32*16;
    #pragma unroll
    for(int d0=0;d0<8;++d0){
      const bf16x8 b0=*(const __attribute__((address_space(3))) bf16x8*)(kb+d0*2048);
      const bf16x8 b1=*(const __attribute__((address_space(3))) bf16x8*)(kb+d0*2048+512);
      p0=__builtin_amdgcn_mfma_f32_32x32x16_bf16(b0,qr[d0],p0,0,0,0); p1=__builtin_amdgcn_mfma_f32_32x32x16_bf16(b1,qr[d0],p1,0,0,0); }
    float rm=p0[0];
    #pragma unroll
    for(int r=0;r<16;++r){rm=__builtin_fmaxf(rm,p0[r]);rm=__builtin_fmaxf(rm,p1[r]);}
    rm=max_x32(rm);
    const float mn=__builtin_fmaxf(m,rm); const float alpha=__builtin_amdgcn_exp2f(m-mn); m=mn;
    float sacc=0.f;
    #pragma unroll
    for(int r=0;r<16;++r){p0[r]=__builtin_amdgcn_exp2f(p0[r]-mn);p1[r]=__builtin_amdgcn_exp2f(p1[r]-mn);sacc+=p0[r]+p1[r];}
    l_reg=l_reg*alpha+sacc;
    if(hi==0)wsf[r32]=alpha;
    asm volatile("s_waitcnt lgkmcnt(0)":::"memory");
    #pragma unroll
    for(int r=0;r<16;++r){ const float a=wsf[crow(r,hi)]; o[0][r]*=a;o[1][r]*=a;o[2][r]*=a;o[3][r]*=a; }
    u32x4 pw0,pw1,pw2,pw3;
    pw0=(u32x4){cvtpk_s(p0[0],p0[1]),cvtpk_s(p0[2],p0[3]),cvtpk_s(p0[4],p0[5]),cvtpk_s(p0[6],p0[7])};
    pw1=(u32x4){cvtpk_s(p0[8],p0[9]),cvtpk_s(p0[10],p0[11]),cvtpk_s(p0[12],p0[13]),cvtpk_s(p0[14],p0[15])};
    pw2=(u32x4){cvtpk_s(p1[0],p1[1]),cvtpk_s(p1[2],p1[3]),cvtpk_s(p1[4],p1[5]),cvtpk_s(p1[6],p1[7])};
    pw3=(u32x4){cvtpk_s(p1[8],p1[9]),cvtpk_s(p1[10],p1[11]),cvtpk_s(p1[12],p1[13]),cvtpk_s(p1[14],p1[15])};
    const int vb=(int)(lds0+65536+kt*16384)+vbl;
    SBAR(); pv(o,vb,__builtin_bit_cast(bf16x8,pw0),__builtin_bit_cast(bf16x8,pw1),__builtin_bit_cast(bf16x8,pw2),__builtin_bit_cast(bf16x8,pw3));
    pv(o+2,vb+8192,__builtin_bit_cast(bf16x8,pw0),__builtin_bit_cast(bf16x8,pw1),__builtin_bit_cast(bf16x8,pw2),__builtin_bit_cast(bf16x8,pw3));
    asm volatile("s_waitcnt lgkmcnt(0)":::"memory");
  }
  l_reg=sum_x32(l_reg);
  if(hi==0)wsf[32+r32]=l_reg; asm volatile("s_waitcnt lgkmcnt(0)":::"memory");
  asm volatile("s_waitcnt lgkmcnt(0)\n\ts_barrier":::"memory");
  { typedef __attribute__((address_space(3))) unsigned short lds_u16;
    lds_u16* stg=(lds_u16*)(shm3+wid*8192);
    #pragma unroll
    for(int r=0;r<16;++r){ const float rl=__builtin_amdgcn_rcpf(wsf[32+crow(r,hi)]); const int orow=crow(r,hi);
      #pragma unroll
      for(int db=0;db<4;++db){ const unsigned w=cvtpk_s(o[db][r]*rl,0.f); stg[orow*128+db*32+r32]=(unsigned short)w; } }
    asm volatile("s_waitcnt lgkmcnt(0)":::"memory");
    #pragma unroll
    for(int i=0;i<8;++i){ const int row=i*4+(lane>>4),ch=lane&15; const u32x4 v=*(const lds_u32x4*)(shm3+wid*8192+row*256+ch*16); *(u32x4*)(Qw+(size_t)row*DM+ch*8)=v; } }
  asm volatile("s_waitcnt lgkmcnt(0)\n\ts_barrier":::"memory");
}
#undef SBAR
}

constexpr int NWAVES = 8;
constexpr int TOK = 32768, DMOD = 1024, FF = 2816, SEQL = 4096, PP = 5184, MKP = 2112, DIN = 8200, NLAYER = 2;
constexpr int C_QA = 0, C_PU = 512, C_QC = 1024, C_MQ = 1536, C_KA = 2048, C_VA = 2560, C_KC = 3072, C_VC = 3584, C_H = 4096, C_Z = 2048;
constexpr float RMS_EPS = 1e-6f;
constexpr float LOG2E = 1.4426950408889634f;
constexpr float C2_64 = 0.125f * LOG2E, C2_128 = 0.08838834764831845f * LOG2E;
constexpr size_t MiB = 1u << 20;
constexpr size_t WS_FOXF = 1 * MiB, WS_CK2 = 2 * MiB, WS_KMEAN = 3 * MiB, WS_MEMN = 4 * MiB, WS_MEMKV = 8 * MiB, WS_POOLED = 17 * MiB, WS_W = 49 * MiB,
                 WS_PROJ = 173 * MiB, WS_HF = WS_PROJ + 176 * MiB, WS_END = 497 * MiB;
static_assert((size_t)2048 * MKP * 2 <= 9 * MiB && (size_t)TOK * PP * 2 <= 324 * MiB && (size_t)TOK * FF * 2 <= 176 * MiB && (size_t)TOK * 512 * 2 <= 32 * MiB && (size_t)256 * 65536 * 2 <= 32 * MiB, "workspace map");
constexpr size_t E_FFN_IN = (size_t)2 * FF * DMOD, E_FFN_OUT = (size_t)DMOD * FF, E_WIN = (size_t)8192 * DMOD, E_WBR = (size_t)4 * DMOD * 1024  , E_WOUT = (size_t)DMOD * DMOD, E_WPOOL = (size_t)512 * 512;
constexpr size_t O_FFN1_IN = 0, O_FFN1_OUT = O_FFN1_IN + E_FFN_IN, O_WIN = O_FFN1_OUT + E_FFN_OUT, O_WBR = O_WIN + E_WIN, O_WOUT = O_WBR + E_WBR, O_WPOOL = O_WOUT + E_WOUT,
                 O_FFN2_IN = O_WPOOL + E_WPOOL, O_FFN2_OUT = O_FFN2_IN + E_FFN_IN, E_LAYER = O_FFN2_OUT + E_FFN_OUT, O_WMEM = NLAYER * E_LAYER, E_WTOTAL = O_WMEM + (size_t)2048 * 1024;
static_assert(E_WTOTAL * 2 <= 124 * MiB, "weights fit");
constexpr int RING_BYTES = 131072, LDS_BYTES = 147456;

#define LAS __attribute__((address_space(3)))
typedef unsigned short bf16;
typedef unsigned v4u __attribute__((ext_vector_type(4)));
typedef float f32x4 __attribute__((ext_vector_type(4)));
#define LDS_WAIT() asm volatile("s_waitcnt lgkmcnt(0)" ::: "memory")
__device__ __forceinline__ unsigned pk2(float lo, float hi) { return pg8::cvt_pk_bf16(lo, hi); }
__device__ __forceinline__ float wave_sum(float v) {
    v += xor_lane<1>(v); v += xor_lane<2>(v); v += xor_lane<4>(v); v += xor_lane<8>(v); v += xor_lane<16>(v); v = sum_x32(v);
    return v;
}
__device__ __forceinline__ void ld8(const bf16* p, float (&v)[8]) { const v4u w = *(const v4u*)p;
    v[0] = pg8::bf_lo(w.x); v[1] = pg8::bf_hi(w.x); v[2] = pg8::bf_lo(w.y); v[3] = pg8::bf_hi(w.y); v[4] = pg8::bf_lo(w.z); v[5] = pg8::bf_hi(w.z); v[6] = pg8::bf_lo(w.w); v[7] = pg8::bf_hi(w.w); }
__device__ __forceinline__ void un8(const v4u& w, float (&v)[8]) {
    v[0] = pg8::bf_lo(w.x); v[1] = pg8::bf_hi(w.x); v[2] = pg8::bf_lo(w.y); v[3] = pg8::bf_hi(w.y); v[4] = pg8::bf_lo(w.z); v[5] = pg8::bf_hi(w.z); v[6] = pg8::bf_lo(w.w); v[7] = pg8::bf_hi(w.w); }
__device__ __forceinline__ void st8(bf16* p, const float (&v)[8]) { v4u w; w.x = pk2(v[0], v[1]); w.y = pk2(v[2], v[3]); w.z = pk2(v[4], v[5]); w.w = pk2(v[6], v[7]); *(v4u*)p = w; }

__device__ __forceinline__ void tr_item(const float* W, int ldw, int srccol0, int k0, bf16* WT, int ldk, int dstrow0, const float* kscale, LAS float* scr, int lane) {
#pragma unroll
    for (int i = 0; i < 32; ++i) { const int kk = 2 * i + (lane >> 5); float v = W[(size_t)(k0 + kk) * ldw + srccol0 + (lane & 31)]; if (kscale) v *= kscale[k0 + kk]; scr[kk * 33 + (lane & 31)] = v; }
    LDS_WAIT(); asm volatile("" ::: "memory");
    const int c = lane & 7;
#pragma unroll
    for (int j = 0; j < 4; ++j) { const int n = (lane >> 3) + 8 * j; const LAS float* s = scr + (8 * c) * 33 + n;
        v4u o; o.x = pk2(s[0 * 33], s[1 * 33]); o.y = pk2(s[2 * 33], s[3 * 33]); o.z = pk2(s[4 * 33], s[5 * 33]); o.w = pk2(s[6 * 33], s[7 * 33]);
        *(v4u*)(WT + (size_t)(dstrow0 + n) * ldk + k0 + 8 * c) = o; }
    LDS_WAIT(); asm volatile("" ::: "memory");
}

template <bool FOX> __device__ __forceinline__ void norm_rows(const float* x, const float* gain, bf16* H, int ldh, int nrows, const float* w_in_l, float* foxf, int gw, int NGW, int lane) {
    f32x4 gv[4];
#pragma unroll
    for (int j = 0; j < 4; ++j) gv[j] = gain ? *((const f32x4*)gain + lane + 64 * j) : (f32x4){1.f, 1.f, 1.f, 1.f};
    f32x4 wf[FOX ? 16 : 1][2];
    if (FOX) {
#pragma unroll
        for (int j = 0; j < 4; ++j)
#pragma unroll
            for (int c = 0; c < 4; ++c) { const float* p = w_in_l + (size_t)(256 * j + 4 * lane + c) * DIN + 3072; wf[j * 4 + c][0] = *(const f32x4*)p; wf[j * 4 + c][1] = *(const f32x4*)(p + 4); }
    }
    f32x4 nv[4];
    if (gw < nrows) { const f32x4* xr = (const f32x4*)(x + (size_t)gw * DMOD) + lane;
#pragma unroll
        for (int j = 0; j < 4; ++j) nv[j] = xr[64 * j]; }
    for (int m = gw; m < nrows; m += NGW) {
        f32x4 v[4]; float s2 = 0.f;
#pragma unroll
        for (int j = 0; j < 4; ++j) { v[j] = nv[j]; s2 += (v[j].x * v[j].x + v[j].y * v[j].y) + (v[j].z * v[j].z + v[j].w * v[j].w); }
        if (m + NGW < nrows) { const f32x4* xr = (const f32x4*)(x + (size_t)(m + NGW) * DMOD) + lane;
#pragma unroll
            for (int j = 0; j < 4; ++j) nv[j] = xr[64 * j]; }
        const float rstd = 1.0f / sqrtf(wave_sum(s2) * (1.f / DMOD) + RMS_EPS);
        unsigned long long* o8 = (unsigned long long*)(H + (size_t)m * ldh) + lane;
#pragma unroll
        for (int j = 0; j < 4; ++j) { v[j] = v[j] * rstd * gv[j]; o8[64 * j] = (unsigned long long)pk2(v[j].x, v[j].y) | ((unsigned long long)pk2(v[j].z, v[j].w) << 32); }
        if (FOX) {
            float acc[8];
#pragma unroll
            for (int h = 0; h < 8; ++h) acc[h] = 0.f;
#pragma unroll
            for (int j = 0; j < 4; ++j)
#pragma unroll
                for (int c = 0; c < 4; ++c) { const float hv = v[j][c];
#pragma unroll
                    for (int h = 0; h < 4; ++h) { acc[h] += hv * wf[j * 4 + c][0][h]; acc[4 + h] += hv * wf[j * 4 + c][1][h]; } }
#pragma unroll
            for (int h = 0; h < 8; ++h) acc[h] = wave_sum(acc[h]);
            if (lane < 8) { const float sv = lane == 0 ? acc[0] : lane == 1 ? acc[1] : lane == 2 ? acc[2] : lane == 3 ? acc[3] : lane == 4 ? acc[4] : lane == 5 ? acc[5] : lane == 6 ? acc[6] : acc[7];
                foxf[(size_t)((m >> 12) * 8 + lane) * SEQL + (m & (SEQL - 1))] = sv; }
        }
    }
}

template <int GL> __device__ __forceinline__ void gnorm8(float (&v)[8], const float (&g)[8], float scale) {
    float ss = 0.f;
#pragma unroll
    for (int i = 0; i < 8; ++i) ss += v[i] * v[i];
    ss += xor_lane<1>(ss); ss += xor_lane<2>(ss); ss += xor_lane<4>(ss); if (GL > 8) ss += xor_lane<8>(ss);
    const float r = scale / sqrtf(ss * (1.0f / (8 * GL)) + RMS_EPS);
#pragma unroll
    for (int i = 0; i < 8; ++i) v[i] = v[i] * r * g[i];
}
__device__ __forceinline__ void rot8(float (&v)[8], const float (&cc)[8], const float (&sn)[8], int li) {
    float oth[8];
#pragma unroll
    for (int i = 0; i < 8; ++i) oth[i] = xor_lane<1>(v[i]);
    if (li == 0) {
#pragma unroll
        for (int i = 0; i < 8; ++i) v[i] = v[i] * cc[i] - oth[i] * sn[i];
    } else if (li == 1) {
#pragma unroll
        for (int i = 0; i < 8; ++i) v[i] = v[i] * cc[i] + oth[i] * sn[i];
    }
}

#define XB_TMO      128
#define XB_XCNT(j)  (256  + 64 * (j))
#define XB_XSUB(j)  (1280 + 64 * (j))
#define XB_XGEN(j)  (2304 + 64 * (j))
#define XB_TOP      3328
#define XB_TOPGEN   3392
#define XCD_BAR_WORDS 3456
#define XB_SPIN_CAP (1u << 18)

__device__ __forceinline__ unsigned xb_ld(unsigned* p)              { return __hip_atomic_load(p, __ATOMIC_RELAXED, __HIP_MEMORY_SCOPE_AGENT); }
__device__ __forceinline__ unsigned xb_add(unsigned* p, unsigned v) { return __hip_atomic_fetch_add(p, v, __ATOMIC_RELAXED, __HIP_MEMORY_SCOPE_AGENT); }
__device__ __forceinline__ unsigned xb_xcc_id() { return (unsigned)__builtin_amdgcn_s_getreg((3 << 11) | 20) & 0xFu; }
#define XB_SPIN(cond, bar) do { unsigned _sp = 0; while (cond) { __builtin_amdgcn_s_sleep(1); \
    if ((++_sp & 255u) == 0u) { if (xb_ld(&(bar)[XB_TMO])) break; if (_sp > XB_SPIN_CAP) { atomicAdd(&(bar)[XB_TMO], 1u); break; } } } } while (0)

struct XcdBarrier {
    unsigned* bar; unsigned x;
    volatile LAS unsigned* st;
};

__device__ __forceinline__ XcdBarrier xcd_barrier_post(unsigned* bar, volatile LAS unsigned* st, int wave_s) {
    XcdBarrier b; b.bar = bar; b.x = xb_xcc_id(); b.st = st;
    if (tid_from_wave(wave_s) == 0) (void)xb_add(&bar[XB_XCNT(b.x)], 1u);
    return b;
}
__device__ __forceinline__ void xcd_barrier_complete(unsigned* bar, unsigned x, unsigned& nloc, unsigned& nx) {
    const unsigned G = gridDim.x * gridDim.y * gridDim.z;
    unsigned sum, cnt, mine, sp = 0u;
    for (;;) {
        sum = 0u; cnt = 0u; mine = 0u;
#pragma unroll
        for (unsigned j = 0; j < 16; ++j) { const unsigned c = xb_ld(&bar[XB_XCNT(j)]); sum += c; cnt += (c > 0u) ? 1u : 0u; mine = (j == x) ? c : mine; }
        if (sum == G) break;
        __builtin_amdgcn_s_sleep(1);
        if ((++sp & 255u) == 0u) { if (xb_ld(&bar[XB_TMO])) break; if (sp > XB_SPIN_CAP) { atomicAdd(&bar[XB_TMO], 1u); break; } }
    }
    nloc = mine > 0u ? mine : 1u; nx = cnt > 0u ? cnt : 1u;
}

__device__ __forceinline__ void xcd_barrier(const XcdBarrier& b, int wave_s) {
    asm volatile("s_waitcnt vmcnt(0)" ::: "memory");
    __syncthreads();
    if (tid_from_wave(wave_s) == 0) {
        unsigned* bar = b.bar;
        __builtin_amdgcn_s_waitcnt(0);
        unsigned nloc = b.st[0], nx = b.st[1];
        if (nloc == 0u) { xcd_barrier_complete(bar, b.x, nloc, nx); b.st[0] = nloc; b.st[1] = nx; }
        const unsigned old = xb_add(&bar[XB_XSUB(b.x)], 1u);
        const unsigned gen = old / nloc;
        if (old + 1u == (gen + 1u) * nloc) {
            __builtin_amdgcn_fence(__ATOMIC_RELEASE, "agent");
            asm volatile("s_waitcnt vmcnt(0)" ::: "memory");
            const unsigned og = xb_add(&bar[XB_TOP], 1u);
            const unsigned tg = og / nx;
            if (og + 1u == (tg + 1u) * nx) xb_add(&bar[XB_TOPGEN], 1u);
            else XB_SPIN(xb_ld(&bar[XB_TOPGEN]) == tg, bar);
            __builtin_amdgcn_fence(__ATOMIC_ACQUIRE, "agent");
            xb_add(&bar[XB_XGEN(b.x)], 1u);
            asm volatile("s_waitcnt vmcnt(0)" ::: "memory");
        } else {
            XB_SPIN(xb_ld(&bar[XB_XGEN(b.x)]) == gen, bar);
            __builtin_amdgcn_fence(__ATOMIC_ACQUIRE, "agent");
            asm volatile("s_waitcnt vmcnt(0)" ::: "memory");
        }
    }
    __syncthreads();
}

__device__ __forceinline__ float logsig(float x) { return fminf(x, 0.f) - 0.6931471805599453f * __builtin_amdgcn_logf(1.0f + __builtin_amdgcn_exp2f(-1.4426950408889634f * fabsf(x))); }
struct Args { const float* in[24]; float* out; unsigned char* ws; };

__global__ void __launch_bounds__(NWAVES * 64, 2) hybrid_fwd(Args args) {
    extern __shared__ __attribute__((aligned(16))) unsigned char lds[];
    cg::grid_group grid = cg::this_grid();
    LAS unsigned char* ldsl = (LAS unsigned char*)lds;
    const int G = gridDim.x, bx = blockIdx.x;
    const int vcu = (G % 8 == 0) ? (bx % 8) * (G / 8) + bx / 8 : bx;
    const int NGW = G * NWAVES;
    const int wave_s = __builtin_amdgcn_readfirstlane((int)threadIdx.x >> 6);
    if (tid_from_wave(wave_s) < 2) ((volatile LAS unsigned*)(ldsl + 133120))[tid_from_wave(wave_s)] = 0u;
    __syncthreads();
    XcdBarrier xbar = xcd_barrier_post((unsigned*)args.ws, (volatile LAS unsigned*)(ldsl + 133120), wave_s);
#define GSYNC() xcd_barrier(xbar, wave_s)
#define LANE_STATE() const int tid = tid_from_wave(wave_s), lane = tid & 63, wave = wave_s, gw = vcu * NWAVES + wave; (void)tid; (void)lane; (void)gw
    unsigned char* ws = args.ws;
    const float* x_in = args.in[0]; const float* mem = args.in[1]; const int* positions = (const int*)args.in[2];
    float* xout = args.out;
    float* FOXF = (float*)(ws + WS_FOXF); float* CK2 = (float*)(ws + WS_CK2); float* KMEAN = (float*)(ws + WS_KMEAN);
    bf16* MEMN = (bf16*)(ws + WS_MEMN); bf16* MEMKV = (bf16*)(ws + WS_MEMKV); bf16* POOLED = (bf16*)(ws + WS_POOLED);
    bf16* HF = (bf16*)(ws + WS_HF); bf16* WB = (bf16*)(ws + WS_W); bf16* PROJ = (bf16*)(ws + WS_PROJ); bf16* HID = PROJ; bf16* GS = POOLED;

#ifdef PROBE_PHASE
    unsigned long long probe_acc = 0, probe_t0 = 0;
#define PB(k) do { if ((k) == PROBE_PHASE) probe_t0 = __builtin_amdgcn_s_memrealtime(); } while (0)
#define PE(k) do { if ((k) == PROBE_PHASE) probe_acc += __builtin_amdgcn_s_memrealtime() - probe_t0; } while (0)
#else
#define PB(k) do {} while (0)
#define PE(k) do {} while (0)
#endif
    PB(0);
    {
        LANE_STATE();
        LAS float* scr = (LAS float*)(ldsl + wave * 16384);
        constexpr int I_FI = 16 * 176, I_FO = 44 * 32, I_WI = 16 * 256, I_BR = 4 * 8 * 32, I_WO = 16 * 32, I_MEM = 16 * 32;
        constexpr int I_LAYER = 2 * I_FI + 2 * I_FO + I_WI + I_BR + I_WO + I_MEM;
        for (int it = gw; it < NLAYER * I_LAYER; it += NGW) {
            const int l = it / I_LAYER; int r = it % I_LAYER; bf16* WL = WB + (size_t)l * E_LAYER;
            if (r < 2 * I_FI) { const int which = r / I_FI; r %= I_FI; const float* W = args.in[which ? 22 : 4] + (size_t)l * DMOD * 2 * FF;
                const int kb = r / 176, nb = r % 176, n0 = 32 * nb, isu = n0 / FF, j = n0 % FF;
                tr_item(W, 2 * FF, n0, 64 * kb, WL + (which ? O_FFN2_IN : O_FFN1_IN), DMOD, 256 * (j / 128) + 128 * isu + (j % 128), nullptr, scr, lane); continue; }
            r -= 2 * I_FI;
            if (r < 2 * I_FO) { const int which = r / I_FO; r %= I_FO; const float* W = args.in[which ? 23 : 5] + (size_t)l * FF * DMOD;
                const int kb = r / 32, nb = r % 32;
                tr_item(W, DMOD, 32 * nb, 64 * kb, WL + (which ? O_FFN2_OUT : O_FFN1_OUT), FF, 32 * nb, nullptr, scr, lane); continue; }
            r -= 2 * I_FO;
            if (r < I_WI) { const float* W = args.in[7] + (size_t)l * DMOD * DIN; const int kb = r / 256, nb = r % 256, n0 = 32 * nb;
                int src;
                if (n0 >= 4096) src = n0 + 8; else { const int sec = n0 >> 9, o = n0 & 511;
                    const int sb = sec == 0 ? 0 : sec == 1 ? 3080 : sec == 2 ? 1536 : sec == 3 ? 3592 : sec == 4 ? 512 : sec == 5 ? 1024 : sec == 6 ? 2048 : 2560; src = sb + o; }
                tr_item(W, DIN, src, 64 * kb, WL + O_WIN, DMOD, n0, nullptr, scr, lane); continue; }
            r -= I_WI;
            if (r < I_BR) { const int br = r / 256; r %= 256; const float* W = args.in[19] + ((size_t)l * 4 + br) * 512 * DMOD; const int kb = r / 32, nb = r % 32;
                tr_item(W, DMOD, 32 * nb, 64 * kb, WL + O_WBR + (size_t)br * DMOD * 1024, 1024, 32 * nb, nullptr, scr, lane); continue; }
            r -= I_BR;
            if (r < I_WO) { const float* W = args.in[20] + (size_t)l * DMOD * DMOD; const int kb = r / 32, nb = r % 32;
                tr_item(W, DMOD, 32 * nb, 64 * kb, WL + O_WOUT, DMOD, 32 * nb, nullptr, scr, lane); continue; }
            r -= I_WO;
            { const float* W = args.in[14] + (size_t)l * DMOD * 1024; const int kb = r / 32, nb = r % 32;
                tr_item(W, 1024, 32 * nb, 64 * kb, WB + O_WMEM, DMOD, l * 1024 + 32 * nb, args.in[13] + l * DMOD, scr, lane); }
        }
        for (int e = gw * 64 + lane; e < NLAYER * 512 * 64; e += NGW * 64) {
            const int l = e / (512 * 64), r = e % (512 * 64), n = r / 64, k8 = (r % 64) * 8, g = n >> 7;
            float v[8];
            if ((k8 >> 7) == g) { const float* mp = args.in[17] + (((size_t)l * 4 + g) * 128 + (k8 & 127)) * 128 + (n & 127); const float sc = args.in[18][l * 512 + n];
#pragma unroll
                for (int i = 0; i < 8; ++i) v[i] = mp[i * 128] * sc;
            } else {
#pragma unroll
                for (int i = 0; i < 8; ++i) v[i] = 0.f;
            }
            st8(WB + (size_t)l * E_LAYER + O_WPOOL + (size_t)n * 512 + k8, v);
        }
        norm_rows<false>(mem, nullptr, MEMN, DMOD, 2048, nullptr, nullptr, gw, NGW, lane);
        norm_rows<false>(x_in, args.in[3], HF, DMOD, TOK, nullptr, nullptr, gw, NGW, lane);
    }
    GSYNC();
    if (args.out == nullptr) grid.sync();
    PE(0);

    for (int st = 0; st < 3 * NLAYER; ++st) {
        const int l = st / 3, kind = st % 3;
        bf16* WL = WB + (size_t)l * E_LAYER;
        if (kind != 1) {
            const bool second = (kind == 2);
            const float* xsrc = (st == 0) ? x_in : xout;
            if (st != 0) { PB(1); LANE_STATE(); norm_rows<false>(xsrc, args.in[second ? 21 : 3] + l * DMOD, HF, DMOD, TOK, nullptr, nullptr, gw, NGW, lane); GSYNC(); PE(1); }
            PB(2);
            { pg8::Gemm g{HF, WL + (second ? O_FFN2_IN : O_FFN1_IN), TOK, 2 * FF, DMOD, DMOD, DMOD, 0, 0}; pg8::StaticOrder S; S.init(TOK, 2 * FF, G, bx);
              pg8::EpiSwiglu E{HID, FF};

#ifndef NO_G0
              pg8::gemm_phase<pg8::EpiSwiglu, pg8::StaticOrder, true, true>(ldsl, g, S, E, wave_s);
#endif
              }
            GSYNC(); PE(2); PB(3);
            { pg8::Gemm g{HID, WL + (second ? O_FFN2_OUT : O_FFN1_OUT), TOK, DMOD, FF, FF, FF, 0, 0}; pg8::StaticOrder S; S.init(TOK, DMOD, G, bx);
              pg8::EpiResid E{xsrc, xout, DMOD, 0.5f};

#ifndef NO_G1
              pg8::gemm_phase<pg8::EpiResid, pg8::StaticOrder, true, true>(ldsl, g, S, E, wave_s);
#endif
              }
            GSYNC(); PE(3);
        } else {
            const float* w_in_l = args.in[7] + (size_t)l * DMOD * DIN;
            PB(4);
#ifndef NO_FOXNORM
            { LANE_STATE(); norm_rows<true>(xout, args.in[6] + l * DMOD, PROJ + C_H, PP, TOK, w_in_l, FOXF, gw, NGW, lane); }
#endif
            if (l == 0) {
                pg8::Gemm g{MEMN, WB + O_WMEM, 2048, 2048, DMOD, DMOD, DMOD, 0, 0}; pg8::StaticOrder S; S.init(2048, 2048, G, bx);
                pg8::EpiBf16 E{MEMKV, MKP};

#ifndef NO_G2
              pg8::gemm_phase<pg8::EpiBf16, pg8::StaticOrder, true, true>(ldsl, g, S, E, wave_s);
#endif

            }
            GSYNC(); PE(4);
            {
                PB(5);
                { pg8::Gemm g{PROJ + C_H, WL + O_WIN, TOK, 4096, DMOD, PP, DMOD, 0, 0}; pg8::StaticOrder S; S.init(TOK, 4096, G, bx);
                  pg8::EpiBf16 E{PROJ, PP};

#ifndef NO_G3
              pg8::gemm_phase<pg8::EpiBf16, pg8::StaticOrder, true, true>(ldsl, g, S, E, wave_s);
#endif
              }
                GSYNC(); PE(5); PB(6);
#ifndef NO_PP1
                {
                    LANE_STATE();
                    if (gw < 64) {
                        const int bl = gw >> 3, h = gw & 7; const float bfv = args.in[8][l * 8 + h];
                        const f32x4* f4 = (const f32x4*)(FOXF + (size_t)(bl * 8 + h) * SEQL + lane * 64);
                        f32x4 lf[16]; float run = 0.f;
#pragma unroll
                        for (int i = 0; i < 16; ++i) lf[i] = f4[i];
#pragma unroll
                        for (int i = 0; i < 16; ++i) {
#pragma unroll
                            for (int e = 0; e < 4; ++e) { lf[i][e] = logsig(lf[i][e] + bfv); run += lf[i][e]; } }
                        float incl = run;
#pragma unroll
                        for (int o = 1; o < 64; o <<= 1) { const float t = __builtin_bit_cast(float, __builtin_amdgcn_ds_bpermute((lane - o) << 2, __builtin_bit_cast(int, incl))); if (lane >= o) incl += t; }
                        run = incl - run;
                        f32x4* cp = (f32x4*)(CK2 + (size_t)(bl * 8 + h) * SEQL + lane * 64);
#pragma unroll
                        for (int i = 0; i < 16; ++i) { f32x4 o4;
#pragma unroll
                            for (int e = 0; e < 4; ++e) { run += lf[i][e]; o4[e] = -run * LOG2E; }
                            cp[i] = o4; }
                    }
                    {
                        float gk[8];
#pragma unroll
                        for (int i = 0; i < 8; ++i) gk[i] = args.in[16][l * 128 + (lane & 15) * 8 + i];
                        for (int r = gw; r < 2048; r += NGW) { bf16* p = MEMKV + (size_t)r * MKP + l * 1024 + lane * 8; float v[8]; ld8(p, v); gnorm8<16>(v, gk, 1.0f); st8(p, v); }
                    }
                    float gqa[8], gka[8], gqc[8], gkc[8], gmq[8];
#pragma unroll
                    for (int i = 0; i < 8; ++i) { const int d = (lane & 7) * 8 + i; gqa[i] = args.in[9][l * 64 + d]; gka[i] = args.in[10][l * 64 + d]; gqc[i] = args.in[11][l * 64 + d]; gkc[i] = args.in[12][l * 64 + d];
                        gmq[i] = args.in[15][l * 128 + (lane & 15) * 8 + i]; }
                    const float invf = powf(500000.0f, -(float)(lane & 7) * 0.125f);
                    LAS float* scr = (LAS float*)ldsl;
                    for (int it = vcu; it < TOK / 64; it += G) {
                        const int m0 = it * 64;
                        float kacc[8];
#pragma unroll
                        for (int i = 0; i < 8; ++i) kacc[i] = 0.f;
                        for (int tt = 0; tt < 8; ++tt) {
                            const int m = m0 + wave * 8 + tt, s = m & (SEQL - 1);
                            bf16* row = PROJ + (size_t)m * PP;
                            const int w = 2 << (lane >> 4); const int cnt = (s + 1 < w) ? s + 1 : w;
                            const v4u rqa = *(const v4u*)(row + C_QA + lane * 8), rka = *(const v4u*)(row + C_KA + lane * 8), rqc = *(const v4u*)(row + C_QC + lane * 8),
                                      rkc = *(const v4u*)(row + C_KC + lane * 8), rmq = *(const v4u*)(row + C_MQ + lane * 8), rpu = *(const v4u*)(row + C_PU + lane * 8);
                            v4u rw[15];
#pragma unroll
                            for (int j = 1; j < 16; ++j) rw[j - 1] = (j < cnt) ? *(const v4u*)(row - (size_t)j * PP + C_PU + lane * 8) : (v4u){0u, 0u, 0u, 0u};
                            const float ang = (float)positions[m] * invf;
                            const float cs = cosf(ang), sn = sinf(ang);
                            float cc[8], ss[8];
#pragma unroll
                            for (int i = 0; i < 8; ++i) { cc[i] = __builtin_bit_cast(float, __builtin_amdgcn_readlane(__builtin_bit_cast(int, cs), i)); ss[i] = __builtin_bit_cast(float, __builtin_amdgcn_readlane(__builtin_bit_cast(int, sn), i)); }
                            float v[8];
                            un8(rqa, v); gnorm8<8>(v, gqa, 1.0f); rot8(v, cc, ss, lane & 7);
#pragma unroll
                            for (int i = 0; i < 8; ++i) v[i] *= C2_64;
                            st8(row + C_QA + lane * 8, v);
                            un8(rka, v); gnorm8<8>(v, gka, 1.0f); rot8(v, cc, ss, lane & 7); st8(row + C_KA + lane * 8, v);
#pragma unroll
                            for (int i = 0; i < 8; ++i) kacc[i] += v[i];
                            un8(rqc, v); gnorm8<8>(v, gqc, C2_64); st8(row + C_QC + lane * 8, v);
                            un8(rkc, v); gnorm8<8>(v, gkc, 1.0f); st8(row + C_KC + lane * 8, v);
                            un8(rmq, v); gnorm8<16>(v, gmq, C2_128); st8(row + C_MQ + lane * 8, v);
                            {
                                float u0[8], sm[8]; un8(rpu, u0);
#pragma unroll
                                for (int i = 0; i < 8; ++i) sm[i] = u0[i];
#pragma unroll
                                for (int j = 0; j < 15; ++j) { float t[8]; un8(rw[j], t);
#pragma unroll
                                    for (int i = 0; i < 8; ++i) sm[i] += t[i]; }
                                const float inv = 1.0f / (float)cnt;
#pragma unroll
                                for (int i = 0; i < 8; ++i) sm[i] = sm[i] * inv - u0[i];
                                st8(POOLED + (size_t)m * 512 + lane * 8, sm);
                            }
                        }
#pragma unroll
                        for (int i = 0; i < 8; ++i) scr[wave * 512 + lane * 8 + i] = kacc[i];
                        __syncthreads();
                        { float t = 0.f;
#pragma unroll
                          for (int w8 = 0; w8 < 8; ++w8) t += scr[w8 * 512 + tid];
                          const int bl = m0 >> 12, s0 = m0 & (SEQL - 1);
                          KMEAN[(size_t)((bl * 16 + (s0 >> 8)) * 4 + ((s0 >> 6) & 3)) * 512 + tid] = t * (1.0f / 256.0f); }
                        __syncthreads();
                    }
                }
#endif
                GSYNC(); PE(6); PB(7);
                {
                    float skipb;
                    { float mq = 0.f, mk = 0.f; for (int i = 0; i < 64; ++i) { mq = fmaxf(mq, fabsf(args.in[11][l * 64 + i])); mk = fmaxf(mk, fabsf(args.in[12][l * 64 + i])); }
                      skipb = 2.0f * (C2_64 * 64.0f * 1.01f * mq * mk) + 48.0f; *(volatile LAS float*)(ldsl + 133136) = skipb; __syncthreads(); }
                    for (int ui = vcu; ui < 512; ui += G)
                        for (int uj = 0; uj < 2; ++uj) {
                            const int pp = ui, bh = pp >> 3, s8 = pp & 7, bl = bh >> 3, h = bh & 7;
                            const int qb = (uj & 1) ? s8 : 15 - s8;
#ifndef NO_ATTN0
                            attn_body::attn_unit<0, 8>(bl, h, qb, (const attn_body::bf16*)(PROJ + C_QA), (const attn_body::bf16*)(PROJ + C_KA), (const attn_body::bf16*)(PROJ + C_VA), (attn_body::bf16*)(PROJ + C_QA), KMEAN, (char*)lds, wave_s, 0.f);
#endif
                        }
                    for (int u = vcu; u < 512; u += G) { const int bl = u >> 6, h = (u >> 4) & 3, qb = u & 15;
#ifndef NO_MEM
                        attn_body::mem_unit(bl * SEQL, bl, h, qb, (attn_body::bf16*)(PROJ + C_MQ), (const attn_body::bf16*)(MEMKV + l * 1024), (char*)lds, wave_s);
#endif
                    }
                    { pg8::Gemm g{POOLED, WL + O_WPOOL, TOK, 512, 512, 512, 512, 0, 0}; pg8::StaticOrder S; S.init(TOK, 512, G, bx);
                      pg8::EpiBf16 E{PROJ + C_PU, PP};

#ifndef NO_G4
              pg8::gemm_phase<pg8::EpiBf16, pg8::StaticOrder, true, true>(ldsl, g, S, E, wave_s);
#endif
              }
                    {
                        for (int guard = 0; guard < 1200; ++guard) {
                            { int z_; asm volatile("s_mov_b32 %0, 0" : "=s"(z_));
                              if (tid_from_wave(wave_s) == 0) *(volatile LAS unsigned*)(ldsl + 133144 + z_) = atomicAdd((unsigned*)args.ws + 3584 + 64 * l + z_, 1u); }
                            __syncthreads();
                            const int fu = __builtin_amdgcn_readfirstlane((int)*(volatile LAS unsigned*)(ldsl + 133144));
                            __syncthreads();
                            if (fu >= 1024) break;
                            const int qb = 15 - (fu >> 6), bh = fu & 63, bl = bh >> 3, h = bh & 7;
#ifndef NO_ATTN1
                            attn_body::attn_unit<1, 24>(bl, h, qb, (const attn_body::bf16*)(PROJ + C_QC), (const attn_body::bf16*)(PROJ + C_KC), (const attn_body::bf16*)(PROJ + C_VC), (attn_body::bf16*)(PROJ + C_QC), CK2, (char*)lds, wave_s, 0.f);
#endif
                        }
                    }
                }
                GSYNC(); PE(7); PB(8);
                { pg8::Gemm g{PROJ, WL + O_WBR, TOK, DMOD, 512, PP, DMOD, 512, (long)DMOD * DMOD, PROJ + C_H, WL + O_WIN + (size_t)4096 * DMOD, DMOD, 0, (long)DMOD * DMOD}; pg8::StaticOrder S; S.init(TOK, DMOD, G, bx, 8);
                  pg8::EpiGate E{PROJ + C_Z, PP, GS + (size_t)bx * 65536};

#ifndef NO_G5
              pg8::gemm_phase<pg8::EpiGate, pg8::StaticOrder, true, true>(ldsl, g, S, E, wave_s);
#endif
              }
                GSYNC(); PE(8); PB(9);
                { pg8::Gemm g{PROJ + C_Z, WL + O_WOUT, TOK, DMOD, DMOD, PP, DMOD, 0, 0}; pg8::StaticOrder S; S.init(TOK, DMOD, G, bx);
                  float* xo = xout;
                  pg8::EpiResid E{xo, xo, DMOD, 1.0f};

#ifndef NO_G6
              pg8::gemm_phase<pg8::EpiResid, pg8::StaticOrder, true, true>(ldsl, g, S, E, wave_s);
#endif
              }
                GSYNC(); PE(9);
            }
        }
    }
#ifdef PROBE_SYNC
    for (int i = 0; i < 20; ++i) GSYNC();
#endif
#ifdef PROBE_PHASE
    { const unsigned long long tend = __builtin_amdgcn_s_memrealtime() + probe_acc; while (__builtin_amdgcn_s_memrealtime() < tend) __builtin_amdgcn_s_sleep(8); }
#endif
}

extern "C" void kernel_launch(void* const* d_in, const int* in_sizes, int n_in, void* d_out, int out_size, void* d_ws, size_t ws_size, hipStream_t stream) {
    static int grid = 0;
    if (grid == 0) {
        if (n_in != 24 || out_size != TOK * DMOD || ws_size < WS_END) { fprintf(stderr, "kernel_launch: unexpected shapes (n_in %d out %d ws %zu)\n", n_in, out_size, ws_size); grid = -1; return; }
        int dev = 0, cus = 0, per_cu = 0;
        hipGetDevice(&dev); hipDeviceGetAttribute(&cus, hipDeviceAttributeMultiprocessorCount, dev);
        hipFuncSetAttribute((const void*)hybrid_fwd, hipFuncAttributeMaxDynamicSharedMemorySize, LDS_BYTES);
        hipOccupancyMaxActiveBlocksPerMultiprocessor(&per_cu, (const void*)hybrid_fwd, NWAVES * 64, LDS_BYTES);
        (void)hipGetLastError();
        if (per_cu < 1) per_cu = 1;
        grid = cus;
    }
    if (grid < 0) return;
    if (hipMemsetAsync(d_ws, 0, 16384, stream) != hipSuccess) { fprintf(stderr, "kernel_launch: memset of the barrier words failed\n"); return; }
    Args a{};
    for (int i = 0; i < 24; ++i) a.in[i] = (const float*)d_in[i];
    a.out = (float*)d_out; a.ws = (unsigned char*)d_ws;
    void* kargs[] = {&a};
    hipError_t e = hipLaunchCooperativeKernel((const void*)hybrid_fwd, dim3(grid), dim3(NWAVES * 64), kargs, LDS_BYTES, stream);
    if (e != hipSuccess) fprintf(stderr, "cooperative launch failed: %s (grid %d)\n", hipGetErrorString(e), grid);
}
```

```cpp
#include <hip/hip_runtime.h>
#include <hip/hip_cooperative_groups.h>
#include <hip/hip_bf16.h>
#include <cstdio>
#include <cstdint>
#include <cmath>
namespace cg = cooperative_groups;

__device__ __forceinline__ int tid_from_wave(int wave_s) { int l; asm volatile("v_mbcnt_lo_u32_b32 %0, -1, 0\n\tv_mbcnt_hi_u32_b32 %0, -1, %0" : "=v"(l)); return wave_s * 64 + l; }

template <int M> __device__ __forceinline__ float xor_lane(float v) {
    if constexpr (M < 32) { return __builtin_bit_cast(float, __builtin_amdgcn_ds_swizzle(__builtin_bit_cast(int, v), (M << 10) | 0x1f)); }
    else { const unsigned u = __builtin_bit_cast(unsigned, v); auto rr = __builtin_amdgcn_permlane32_swap(u, u, false, false); const unsigned a = rr[0], b = rr[1]; return __builtin_bit_cast(float, a == u ? b : a); }
}
__device__ __forceinline__ float sum_x32(float v) { const unsigned u = __builtin_bit_cast(unsigned, v); auto rr = __builtin_amdgcn_permlane32_swap(u, u, false, false); return __builtin_bit_cast(float, (unsigned)rr[0]) + __builtin_bit_cast(float, (unsigned)rr[1]); }
__device__ __forceinline__ float max_x32(float v) { const unsigned u = __builtin_bit_cast(unsigned, v); auto rr = __builtin_amdgcn_permlane32_swap(u, u, false, false); return __builtin_fmaxf(__builtin_bit_cast(float, (unsigned)rr[0]), __builtin_bit_cast(float, (unsigned)rr[1])); }

namespace pg8 {
#define PG8_LAS __attribute__((address_space(3)))
typedef unsigned short bf16_t;
typedef short bf16x8 __attribute__((ext_vector_type(8)));
typedef float f32x4 __attribute__((ext_vector_type(4)));
typedef unsigned u32x4 __attribute__((ext_vector_type(4)));
constexpr int BM = 256, BK = 64, HALF = 128, HTB = HALF * BK * 2  , STAGE_BYTES = 8 * HTB, NXCD = 8, WGM = 8;

__host__ __device__ __forceinline__ int lds_byte(int r, int c) { const int st = (r >> 4) * 2 + (c >> 5), rr = r & 15, cc = c & 31, ob = rr * 64 + cc * 2; return st * 1024 + (ob ^ (((ob >> 9) & 1) << 5)); }
__host__ __device__ __forceinline__ void stage_rc(int b, int& R, int& C) { const int st = b / 1024, sb = b % 1024, swz = sb ^ (((sb >> 9) & 1) << 5); R = (st >> 1) * 16 + swz / 64; C = (st & 1) * 32 + (swz % 64) / 2; }
__host__ __device__ __forceinline__ int perm32(int rho) { const int n = rho >> 4, i = rho & 15; return 8 * (i >> 2) + 4 * n + (i & 3); }

struct Unit { int pm, pn, z; };
struct Gemm { const bf16_t* A; const bf16_t* Bt; int M, N, K, lda, ldb; long azoff, bzoff;
    const bf16_t* A2 = nullptr; const bf16_t* Bt2 = nullptr; int K2 = 0; long a2z = 0, b2z = 0; };
__device__ __forceinline__ void unit_ptrs(const Gemm& g, const Unit& u, size_t tstepA, size_t tstepB, const char*& pa, const char*& pb, int& ntu) {
    if (g.K2 != 0) { const int zb = u.z >> 1;
        if (u.z & 1) { pa = (const char*)g.A2 + (size_t)u.pm * tstepA + (size_t)zb * g.a2z * 2; pb = (const char*)g.Bt2 + (size_t)u.pn * tstepB + (size_t)zb * g.b2z * 2; ntu = g.K2 / BK; }
        else { pa = (const char*)g.A + (size_t)u.pm * tstepA + (size_t)zb * g.azoff * 2; pb = (const char*)g.Bt + (size_t)u.pn * tstepB + (size_t)zb * g.bzoff * 2; ntu = g.K / BK; }
    } else { pa = (const char*)g.A + (size_t)u.pm * tstepA + (size_t)u.z * g.azoff * 2; pb = (const char*)g.Bt + (size_t)u.pn * tstepB + (size_t)u.z * g.bzoff * 2; ntu = g.K / BK; }
}

struct StaticOrder {
    int nM, nN, nwg, G, c, NZ;
    __host__ __device__ void init(int M, int N, int G_, int c_, int NZ_ = 1) { nM = M / BM; nN = N / BM; nwg = nM * nN; G = G_; c = c_; NZ = NZ_; }
    __host__ __device__ bool next(int i, Unit& u) const {
        const int zi = i % NZ, ii = i / NZ;
        const long L = (long)ii * G + c; if (L >= nwg) return false;
        int wgid = (int)L; { const int q = nwg / NXCD, r = nwg % NXCD, xcd = wgid % NXCD, off = wgid / NXCD; wgid = (xcd < r ? xcd * (q + 1) : r * (q + 1) + (xcd - r) * q) + off; }
        const int nig = WGM * nN, gid = wgid / nig, fm = gid * WGM, gsz = (nM - fm) < WGM ? (nM - fm) : WGM;
        u.pm = fm + ((wgid % nig) % gsz); u.pn = (wgid % nig) / gsz; u.z = zi; return true;
    }
    __device__ __forceinline__ void a_ready(const Unit&) const {}
    __device__ __forceinline__ void done(const Unit&) const {}
};

__device__ __forceinline__ unsigned cvt_pk_bf16(float lo, float hi) { unsigned r; asm volatile("v_cvt_pk_bf16_f32 %0, %1, %2" : "=v"(r) : "v"(lo), "v"(hi)); return r; }
__device__ __forceinline__ float bf_lo(unsigned w) { return __uint_as_float(w << 16); }
__device__ __forceinline__ float bf_hi(unsigned w) { return __uint_as_float(w & 0xffff0000u); }
__device__ __forceinline__ float sigm(float x) { return __builtin_amdgcn_rcpf(1.0f + __builtin_amdgcn_exp2f(-1.4426950408889634f * x)); }

struct EpiBf16 {
    static constexpr bool PERM = true, AFTER_DRAIN = false;
    bf16_t* O; int ldc;
    __device__ __forceinline__ void operator()(const f32x4 (&acc)[2][2][4][2], const Unit& u, int wr, int wc, int fr, int fq) const {
        const int row0 = u.pm * BM + wr * 64 + fr, col0 = u.pn * BM + wc * 32 + 8 * fq;
#pragma unroll
        for (int ai = 0; ai < 2; ++ai)
#pragma unroll
            for (int m = 0; m < 4; ++m) { bf16_t* rowp = O + (size_t)(row0 + ai * HALF + m * 16) * ldc + col0;
#pragma unroll
                for (int bj = 0; bj < 2; ++bj) { const f32x4 v0 = acc[ai][bj][m][0], v1 = acc[ai][bj][m][1];
                    u32x4 w; w.x = cvt_pk_bf16(v0[0], v0[1]); w.y = cvt_pk_bf16(v0[2], v0[3]); w.z = cvt_pk_bf16(v1[0], v1[1]); w.w = cvt_pk_bf16(v1[2], v1[3]);
                    *(u32x4*)(rowp + bj * HALF) = w; } }
    }
};
struct EpiSwiglu {
    static constexpr bool PERM = true, AFTER_DRAIN = false;
    bf16_t* O; int ldc;
    __device__ __forceinline__ void operator()(const f32x4 (&acc)[2][2][4][2], const Unit& u, int wr, int wc, int fr, int fq) const {
        const int row0 = u.pm * BM + wr * 64 + fr, col0 = u.pn * HALF + wc * 32 + 8 * fq;
#pragma unroll
        for (int ai = 0; ai < 2; ++ai)
#pragma unroll
            for (int m = 0; m < 4; ++m) { bf16_t* rowp = O + (size_t)(row0 + ai * HALF + m * 16) * ldc + col0;
                float r[8];
#pragma unroll
                for (int n = 0; n < 2; ++n)
#pragma unroll
                    for (int e = 0; e < 4; ++e) { const float g = acc[ai][0][m][n][e], uu = acc[ai][1][m][n][e]; r[n * 4 + e] = g * sigm(g) * uu; }
                u32x4 w; w.x = cvt_pk_bf16(r[0], r[1]); w.y = cvt_pk_bf16(r[2], r[3]); w.z = cvt_pk_bf16(r[4], r[5]); w.w = cvt_pk_bf16(r[6], r[7]);
                *(u32x4*)rowp = w; }
    }
};
struct EpiResid {
    static constexpr bool PERM = false, AFTER_DRAIN = false;
    const float* base; float* out; int ldc; float scale;
    __device__ __forceinline__ void operator()(const f32x4 (&acc)[2][2][4][2], const Unit& u, int wr, int wc, int fr, int fq) const {
        const int row0 = u.pm * BM + wr * 64 + fr, col0 = u.pn * BM + wc * 32 + 4 * fq;
#pragma unroll
        for (int ai = 0; ai < 2; ++ai) {
            f32x4 bs[4][2][2];
#pragma unroll
            for (int m = 0; m < 4; ++m) { const size_t off = (size_t)(row0 + ai * HALF + m * 16) * ldc + col0;
#pragma unroll
                for (int bj = 0; bj < 2; ++bj)
#pragma unroll
                    for (int n = 0; n < 2; ++n) bs[m][bj][n] = *(const f32x4*)(base + off + bj * HALF + n * 16); }
#pragma unroll
            for (int m = 0; m < 4; ++m) { const size_t off = (size_t)(row0 + ai * HALF + m * 16) * ldc + col0;
#pragma unroll
                for (int bj = 0; bj < 2; ++bj)
#pragma unroll
                    for (int n = 0; n < 2; ++n) *(f32x4*)(out + off + bj * HALF + n * 16) = bs[m][bj][n] + acc[ai][bj][m][n] * scale; }
            asm volatile("" ::: "memory");
        }
    }
};
__device__ __forceinline__ u32x4 ld16_l2(const bf16_t* p) { const unsigned long long* q = (const unsigned long long*)p;
    const unsigned long long a = __hip_atomic_load(q, __ATOMIC_RELAXED, __HIP_MEMORY_SCOPE_AGENT), b = __hip_atomic_load(q + 1, __ATOMIC_RELAXED, __HIP_MEMORY_SCOPE_AGENT);
    return (u32x4){(unsigned)a, (unsigned)(a >> 32), (unsigned)b, (unsigned)(b >> 32)}; }
struct EpiGate {
    static constexpr bool PERM = true, AFTER_DRAIN = false;
    bf16_t* Z; int ldz; bf16_t* GS;
    __device__ __forceinline__ void operator()(const f32x4 (&acc)[2][2][4][2], const Unit& u, int wr, int wc, int fr, int fq) const {
        int fr_ = fr, fq_ = fq; asm volatile("" : "+v"(fr_), "+v"(fq_));
        const int rl0 = wr * 64 + fr_, cl0 = wc * 32 + 8 * fq_, row0 = u.pm * BM + rl0, col0 = u.pn * BM + cl0, zb = u.z >> 1;
        if (!(u.z & 1)) {
#pragma unroll
            for (int ai = 0; ai < 2; ++ai)
#pragma unroll
                for (int m = 0; m < 4; ++m)
#pragma unroll
                    for (int bj = 0; bj < 2; ++bj) { const f32x4 v0 = acc[ai][bj][m][0], v1 = acc[ai][bj][m][1];
                        u32x4 w; w.x = cvt_pk_bf16(v0[0], v0[1]); w.y = cvt_pk_bf16(v0[2], v0[3]); w.z = cvt_pk_bf16(v1[0], v1[1]); w.w = cvt_pk_bf16(v1[2], v1[3]);
                        *(u32x4*)(GS + (size_t)(rl0 + ai * HALF + m * 16) * 256 + cl0 + bj * HALF) = w; }
            return;
        }
#pragma unroll
        for (int ai = 0; ai < 2; ++ai) {
            u32x4 gv[4][2], zv[4][2];
#pragma unroll
            for (int m = 0; m < 4; ++m)
#pragma unroll
                for (int bj = 0; bj < 2; ++bj) gv[m][bj] = ld16_l2(GS + (size_t)(rl0 + ai * HALF + m * 16) * 256 + cl0 + bj * HALF);
            if (zb > 0) {
#pragma unroll
                for (int m = 0; m < 4; ++m)
#pragma unroll
                    for (int bj = 0; bj < 2; ++bj) zv[m][bj] = ld16_l2(Z + (size_t)(row0 + ai * HALF + m * 16) * ldz + col0 + bj * HALF);
            }
            {
                f32x4 (&accw)[2][2][4][2] = const_cast<f32x4 (&)[2][2][4][2]>(acc);
#pragma unroll
                for (int m = 0; m < 4; ++m)
#pragma unroll
                    for (int bj = 0; bj < 2; ++bj)
#pragma unroll
                        for (int n = 0; n < 2; ++n) { f32x4 t = accw[ai][bj][m][n]; t[0] = sigm(t[0]); t[1] = sigm(t[1]); t[2] = sigm(t[2]); t[3] = sigm(t[3]); accw[ai][bj][m][n] = t; }
                __builtin_amdgcn_sched_barrier(0);
            }
#pragma unroll
            for (int m = 0; m < 4; ++m)
#pragma unroll
                for (int bj = 0; bj < 2; ++bj) {
                    const u32x4 g4 = gv[m][bj]; const f32x4 v0 = acc[ai][bj][m][0], v1 = acc[ai][bj][m][1];
                    float o[8];
                    o[0] = bf_lo(g4.x) * v0[0]; o[1] = bf_hi(g4.x) * v0[1]; o[2] = bf_lo(g4.y) * v0[2]; o[3] = bf_hi(g4.y) * v0[3];
                    o[4] = bf_lo(g4.z) * v1[0]; o[5] = bf_hi(g4.z) * v1[1]; o[6] = bf_lo(g4.w) * v1[2]; o[7] = bf_hi(g4.w) * v1[3];
                    if (zb > 0) { const u32x4 z4 = zv[m][bj];
                        o[0] += bf_lo(z4.x); o[1] += bf_hi(z4.x); o[2] += bf_lo(z4.y); o[3] += bf_hi(z4.y); o[4] += bf_lo(z4.z); o[5] += bf_hi(z4.z); o[6] += bf_lo(z4.w); o[7] += bf_hi(z4.w); }
                    u32x4 w; w.x = cvt_pk_bf16(o[0], o[1]); w.y = cvt_pk_bf16(o[2], o[3]); w.z = cvt_pk_bf16(o[4], o[5]); w.w = cvt_pk_bf16(o[6], o[7]);
                    *(u32x4*)(Z + (size_t)(row0 + ai * HALF + m * 16) * ldz + col0 + bj * HALF) = w; }
            asm volatile("" ::: "memory");
        }
    }
};

template <class Epi, class Sched, bool ALIGN_EPI = false, bool SP2 = false>
__device__ __forceinline__ void gemm_phase(PG8_LAS unsigned char* lds, const Gemm g, const Sched& S, const Epi& E, const int wave_s) {
    int tid_ = tid_from_wave(wave_s);
    const int tid = tid_, wid = __builtin_amdgcn_readfirstlane(tid >> 6), lane = tid & 63, wr = wid >> 2, wc = wid & 3, fr = lane & 15, fq = lane >> 4;
    const int lda = g.lda, ldb = g.ldb;
    unsigned voffA[2], voffB[2];
#pragma unroll
    for (int i = 0; i < 2; ++i) { int R, C; stage_rc(tid * 16 + i * 8192, R, C); const int Rb = Epi::PERM ? ((R & ~31) + perm32(R & 31)) : R;
        voffA[i] = (unsigned)(R * lda + C) * 2u; voffB[i] = (unsigned)(Rb * ldb + C) * 2u; }
    const size_t kstep = (size_t)(BK * 2);
    const size_t hstepA = (size_t)HALF * lda * 2, hstepB = (size_t)HALF * ldb * 2;
    const size_t tstepA = 2 * hstepA, tstepB = 2 * hstepB;
    const unsigned ldsw = (unsigned)wid * 1024u;
    const int aoff = lds_byte(wr * 64 + fr, fq * 8), boff = lds_byte(wc * 32 + fr, fq * 8);
#define PG8_SA(b, h) (((b) * 2 + (h)) * HTB)
#define PG8_SB(b, h) ((4 + (b) * 2 + (h)) * HTB)
#define PG8_STAGE(bufoff, gbase, voff) do { _Pragma("unroll") for (int _i = 0; _i < 2; ++_i) \
        __builtin_amdgcn_global_load_lds((const unsigned*)((const char*)(gbase) + (voff)[_i]), (PG8_LAS unsigned*)(lds + (bufoff) + ldsw + _i * 8192), 16, 0, 0); } while (0)
#define PG8_LDA(dst, b, h) do { _Pragma("unroll") for (int m = 0; m < 4; ++m) _Pragma("unroll") for (int k = 0; k < 2; ++k) dst[m][k] = *(const PG8_LAS bf16x8*)(lds + PG8_SA(b, h) + aoff + m * 2048 + k * 1024); } while (0)
#define PG8_LDB(dst, b, h) do { _Pragma("unroll") for (int n = 0; n < 2; ++n) _Pragma("unroll") for (int k = 0; k < 2; ++k) dst[n][k] = *(const PG8_LAS bf16x8*)(lds + PG8_SB(b, h) + boff + n * 2048 + k * 1024); } while (0)
#define PG8_MMA(ai, bj, At, Bt) do { __builtin_amdgcn_s_setprio(1); _Pragma("unroll") for (int m = 0; m < 4; ++m) _Pragma("unroll") for (int n = 0; n < 2; ++n) _Pragma("unroll") for (int k = 0; k < 2; ++k) \
        acc[ai][bj][m][n] = __builtin_amdgcn_mfma_f32_16x16x32_bf16(Bt[n][k], At[m][k], acc[ai][bj][m][n], 0, 0, 0); __builtin_amdgcn_s_setprio(0); } while (0)
#define PG8_WAIT_V(n) asm volatile("s_waitcnt vmcnt(" #n ")" ::: "memory")
#define PG8_WAIT_L(n) asm volatile("s_waitcnt lgkmcnt(" #n ")" ::: "memory")
#define PG8_BAR __builtin_amdgcn_s_barrier()
#define PG8_SCHED __builtin_amdgcn_sched_barrier(0)
    Unit cur, nxt; int ui = 0;
    if (!S.next(0, cur)) return;
    f32x4 acc[2][2][4][2];
#pragma unroll
    for (int a = 0; a < 2; ++a)
#pragma unroll
        for (int b = 0; b < 2; ++b)
#pragma unroll
            for (int m = 0; m < 4; ++m)
#pragma unroll
                for (int n = 0; n < 2; ++n) acc[a][b][m][n] = (f32x4){0.f, 0.f, 0.f, 0.f};
    bf16x8 At[4][2], B0[2][2], B1[2][2];
    const char* cA; const char* cB; int nt; unit_ptrs(g, cur, tstepA, tstepB, cA, cB, nt);
    S.a_ready(cur);
    if constexpr (SP2) {
        PG8_STAGE(PG8_SB(0, 0), cB, voffB); PG8_STAGE(PG8_SB(0, 1), cB + hstepB, voffB); PG8_STAGE(PG8_SA(0, 0), cA, voffA); PG8_STAGE(PG8_SA(0, 1), cA + hstepA, voffA);
        if (wr == 1) PG8_BAR;
        PG8_WAIT_V(2); PG8_BAR;
        PG8_STAGE(PG8_SB(1, 0), cB + kstep, voffB); PG8_STAGE(PG8_SA(1, 0), cA + kstep, voffA); PG8_STAGE(PG8_SB(1, 1), cB + hstepB + kstep, voffB);
        PG8_WAIT_V(6); PG8_BAR;
    } else {
        PG8_STAGE(PG8_SB(0, 0), cB, voffB); PG8_STAGE(PG8_SA(0, 0), cA, voffA); PG8_STAGE(PG8_SB(0, 1), cB + hstepB, voffB); PG8_STAGE(PG8_SA(0, 1), cA + hstepA, voffA);
        if (wr == 1) PG8_BAR;
        PG8_WAIT_V(4); PG8_BAR;
        PG8_STAGE(PG8_SB(1, 0), cB + kstep, voffB); PG8_STAGE(PG8_SA(1, 0), cA + kstep, voffA); PG8_STAGE(PG8_SB(1, 1), cB + hstepB + kstep, voffB);
        PG8_WAIT_V(6); PG8_BAR;
    }
    for (;;) {
        const bool has_next = S.next(ui + 1, nxt);
        const char* nA = cA; const char* nB = cB; int ntn = nt; if (has_next) unit_ptrs(g, nxt, tstepA, tstepB, nA, nB, ntn);
        for (int t = 0; t < nt; t += 2) {
            const bool last = (t == nt - 2);
            const char* a1 = cA + (size_t)(t + 1) * kstep;
            const char* a2 = last ? nA : cA + (size_t)(t + 2) * kstep; const char* b2 = last ? nB : cB + (size_t)(t + 2) * kstep;
            const char* a3 = a2 + kstep; const char* b3 = b2 + kstep;
            if (last && has_next) S.a_ready(nxt);
            if constexpr (SP2) {
            PG8_LDB(B0, 0, 0); PG8_LDB(B1, 0, 1); PG8_SCHED; PG8_LDA(At, 0, 0); PG8_STAGE(PG8_SA(1, 1), a1 + hstepA, voffA);
            PG8_WAIT_V(8); PG8_WAIT_L(0); PG8_BAR; PG8_MMA(0, 0, At, B0); PG8_MMA(0, 1, At, B1); PG8_BAR; PG8_SCHED;
            PG8_LDA(At, 0, 1); PG8_STAGE(PG8_SB(0, 0), b2, voffB); PG8_STAGE(PG8_SB(0, 1), b2 + hstepB, voffB); PG8_STAGE(PG8_SA(0, 0), a2, voffA);
            PG8_WAIT_V(8); PG8_WAIT_L(0); PG8_BAR; PG8_MMA(1, 0, At, B0); PG8_MMA(1, 1, At, B1); PG8_BAR; PG8_SCHED;
            PG8_LDB(B0, 1, 0); PG8_LDB(B1, 1, 1); PG8_SCHED; PG8_LDA(At, 1, 0); PG8_STAGE(PG8_SA(0, 1), a2 + hstepA, voffA);
            PG8_WAIT_V(8); PG8_WAIT_L(0); PG8_BAR; PG8_MMA(0, 0, At, B0); PG8_MMA(0, 1, At, B1); PG8_BAR; PG8_SCHED;
            PG8_LDA(At, 1, 1); PG8_STAGE(PG8_SB(1, 0), b3, voffB); PG8_STAGE(PG8_SB(1, 1), b3 + hstepB, voffB); PG8_STAGE(PG8_SA(1, 0), a3, voffA);
            PG8_WAIT_V(8); PG8_WAIT_L(0); PG8_BAR; PG8_MMA(1, 0, At, B0); PG8_MMA(1, 1, At, B1); PG8_BAR; PG8_SCHED;
            } else {
            PG8_LDB(B0, 0, 0); PG8_SCHED; PG8_LDA(At, 0, 0); PG8_STAGE(PG8_SA(1, 1), a1 + hstepA, voffA);
            PG8_WAIT_L(8); PG8_BAR; PG8_WAIT_L(0); PG8_MMA(0, 0, At, B0); PG8_BAR; PG8_SCHED;
            PG8_LDB(B1, 0, 1); PG8_STAGE(PG8_SB(0, 0), b2, voffB);
            PG8_BAR; PG8_WAIT_L(0); PG8_MMA(0, 1, At, B1); PG8_BAR;
            PG8_LDA(At, 0, 1); PG8_STAGE(PG8_SA(0, 0), a2, voffA);
            PG8_BAR; PG8_WAIT_L(0); PG8_MMA(1, 0, At, B0); PG8_BAR; PG8_SCHED;
            PG8_STAGE(PG8_SB(0, 1), b2 + hstepB, voffB);
            PG8_WAIT_V(6); PG8_BAR; PG8_MMA(1, 1, At, B1); PG8_BAR;
            PG8_LDB(B0, 1, 0); PG8_SCHED; PG8_LDA(At, 1, 0); PG8_STAGE(PG8_SA(0, 1), a2 + hstepA, voffA);
            PG8_WAIT_L(8); PG8_BAR; PG8_WAIT_L(0); PG8_MMA(0, 0, At, B0); PG8_BAR; PG8_SCHED;
            PG8_LDB(B1, 1, 1); PG8_STAGE(PG8_SB(1, 0), b3, voffB);
            PG8_BAR; PG8_WAIT_L(0); PG8_MMA(0, 1, At, B1); PG8_BAR;
            PG8_LDA(At, 1, 1); PG8_STAGE(PG8_SA(1, 0), a3, voffA);
            PG8_BAR; PG8_WAIT_L(0); PG8_MMA(1, 0, At, B0); PG8_BAR; PG8_SCHED;
            PG8_STAGE(PG8_SB(1, 1), b3 + hstepB, voffB);
            PG8_WAIT_V(6); PG8_BAR; PG8_MMA(1, 1, At, B1); PG8_BAR;
            }
        }
        if constexpr (ALIGN_EPI) { if (wr == 0) PG8_BAR; }
        if constexpr (!Epi::AFTER_DRAIN) { E(acc, cur, wr, wc, fr, fq); S.done(cur); }
        if (!has_next) break;
#pragma unroll
        for (int a = 0; a < 2; ++a)
#pragma unroll
            for (int b = 0; b < 2; ++b)
#pragma unroll
                for (int m = 0; m < 4; ++m)
#pragma unroll
                    for (int n = 0; n < 2; ++n) acc[a][b][m][n] = (f32x4){0.f, 0.f, 0.f, 0.f};
        cur = nxt; cA = nA; cB = nB; nt = ntn; ++ui;
        if constexpr (ALIGN_EPI) { if (wr == 1) PG8_BAR; }
    }
    PG8_WAIT_V(0);
    if constexpr (!ALIGN_EPI) { if (wr == 0) PG8_BAR; }
    PG8_BAR;
    if constexpr (Epi::AFTER_DRAIN) { E.fused(acc, cur, wr, wc, fr, fq, lds, wid, lane); S.done(cur); }
#undef PG8_SA
#undef PG8_SB
#undef PG8_STAGE
#undef PG8_LDA
#undef PG8_LDB
#undef PG8_MMA
#undef PG8_WAIT_V
#undef PG8_WAIT_L
#undef PG8_BAR
#undef PG8_SCHED
}
}

namespace attn_body {
using bf16=__hip_bfloat16;
using bf16x8=__attribute__((ext_vector_type(8)))short;
using s16x4=__attribute__((ext_vector_type(4)))short;
using f32x16=__attribute__((ext_vector_type(16)))float;
using u32x4=__attribute__((ext_vector_type(4)))unsigned;
constexpr int SEQ=4096,D=64,DM=5184,MKP=2112;
constexpr int NW=8,QBLK=32,QB=QBLK*NW,KVBLK=64,NQB=SEQ/QB;
constexpr int ATTN_PITCH=DM, ATTN_UNIT_ROWS=QB;
__device__ __forceinline__ int crow(int r,int hi){return (r&3)+8*(r>>2)+4*hi;}
#define SBAR() __builtin_amdgcn_sched_barrier(0)
__device__ __forceinline__ void cmask(f32x16&p0,f32x16&p1,int jb,int qrel,int hi){
  const float NEG=-INFINITY; int kb=64*jb+4*hi;
  #pragma unroll
  for(int r=0;r<16;++r){int kv=kb+(r&3)+8*(r>>2); if(kv>qrel)p0[r]=NEG; if(kv+32>qrel)p1[r]=NEG;}
}

constexpr int NSLOT=3, SLOTB=8192;
constexpr int LDS_K=0, LDS_V=NSLOT*SLOTB, LDS_WS=2*NSLOT*SLOTB, LDS_OST=LDS_WS+NW*64*4, LDS_BYTES=LDS_OST+NW*4096, LDS_AUX=86016;
constexpr float C2=0.125f*1.4426950408889634f;
__device__ __forceinline__ void glds16(const void*gsrc,unsigned lds_dst){unsigned keep;
  asm volatile("s_mov_b32 %0, m0\n\ts_mov_b32 m0, %2\n\ts_nop 0\n\tglobal_load_lds_dwordx4 %1, off\n\ts_mov_b32 m0, %0":"=&s"(keep):"v"(gsrc),"s"(lds_dst):"memory");}
__device__ __forceinline__ float max3f(float a,float b,float c){float r;asm("v_max3_f32 %0, %1, %2, %3":"=v"(r):"v"(a),"v"(b),"v"(c));return r;}
__device__ __forceinline__ float max2f(float a,float b){float r;asm("v_max_f32_e32 %0, %1, %2":"=v"(r):"v"(a),"v"(b));return r;}
__device__ __forceinline__ float fadd_s(float a,float b){float r;asm("v_add_f32_e32 %0, %1, %2":"=v"(r):"v"(a),"v"(b));return r;}
__device__ __forceinline__ float fsub_s(float a,float b){float r;asm("v_sub_f32_e32 %0, %1, %2":"=v"(r):"v"(a),"v"(b));return r;}
typedef float f32x4_t __attribute__((ext_vector_type(4))); typedef float f32x2_t __attribute__((ext_vector_type(2))); typedef __bf16 bf16x2_t __attribute__((ext_vector_type(2)));
__device__ __forceinline__ unsigned cvtpk_s(float lo,float hi){f32x2_t v={lo,hi};bf16x2_t b=__builtin_convertvector(v,bf16x2_t);return __builtin_bit_cast(unsigned,b);}
#define WAIT_BAR(N) asm volatile("s_waitcnt vmcnt(" #N ") lgkmcnt(0)\n\ts_barrier":::"memory")

__device__ __forceinline__ void qkt(f32x16&p0,f32x16&p1,const char*Kslot,const bf16x8*qr,const f32x16&negm,int r32,int hi){
  const char*kb=Kslot+hi*1024+r32*16;
  #pragma unroll
  for(int d0=0;d0<4;++d0){
    const bf16x8 b0=*reinterpret_cast<const bf16x8*>(kb+d0*2048);
    const bf16x8 b1=*reinterpret_cast<const bf16x8*>(kb+d0*2048+512);
    if(d0==0){p0=__builtin_amdgcn_mfma_f32_32x32x16_bf16(b0,qr[0],negm,0,0,0);p1=__builtin_amdgcn_mfma_f32_32x32x16_bf16(b1,qr[0],negm,0,0,0);}
    else{p0=__builtin_amdgcn_mfma_f32_32x32x16_bf16(b0,qr[d0],p0,0,0,0);p1=__builtin_amdgcn_mfma_f32_32x32x16_bf16(b1,qr[d0],p1,0,0,0);}}
}
typedef __attribute__((address_space(3))) const char* lds_cptr;
typedef short v4i16_t __attribute__((ext_vector_type(4)));
__device__ __forceinline__ void kload8(bf16x8*kf,lds_cptr kp){
  kf[0]=*(const __attribute__((address_space(3))) bf16x8*)(kp);      kf[1]=*(const __attribute__((address_space(3))) bf16x8*)(kp+512);
  kf[2]=*(const __attribute__((address_space(3))) bf16x8*)(kp+2048); kf[3]=*(const __attribute__((address_space(3))) bf16x8*)(kp+2560);
  kf[4]=*(const __attribute__((address_space(3))) bf16x8*)(kp+4096); kf[5]=*(const __attribute__((address_space(3))) bf16x8*)(kp+4608);
  kf[6]=*(const __attribute__((address_space(3))) bf16x8*)(kp+6144); kf[7]=*(const __attribute__((address_space(3))) bf16x8*)(kp+6656);
}
__device__ __forceinline__ void kload2(bf16x8*kf,lds_cptr kp,int j){ kf[2*j]=*(const __attribute__((address_space(3))) bf16x8*)(kp+j*2048); kf[2*j+1]=*(const __attribute__((address_space(3))) bf16x8*)(kp+j*2048+512); }
__device__ __forceinline__ s16x4 vtr(lds_cptr p){ return __builtin_bit_cast(s16x4,__builtin_amdgcn_ds_read_tr16_b64_v4i16((__attribute__((address_space(3))) v4i16_t*)p)); }
__device__ __forceinline__ float rowmax(const f32x16&p0,const f32x16&p1){
  float a=max3f(p0[0],p0[1],p1[0]),b=max3f(p0[2],p0[3],p1[1]);a=max3f(a,p1[2],p1[3]);
  #pragma unroll
  for(int r=4;r<16;r+=4){a=max3f(a,p0[r],p0[r+1]);b=max3f(b,p0[r+2],p0[r+3]);a=max3f(a,p1[r],p1[r+1]);b=max3f(b,p1[r+2],p1[r+3]);}
  const float m=max2f(a,b);
  auto rr=__builtin_amdgcn_permlane32_swap(__float_as_uint(m),__float_as_uint(m),false,false);
  return max2f(__uint_as_float(rr[0]),__uint_as_float(rr[1]));
}
__device__ __forceinline__ void pv(f32x16*o,int vb,bf16x8 pa0,bf16x8 pa1,bf16x8 pa2,bf16x8 pa3){
  #pragma unroll
  for(int d0=0;d0<2;++d0){s16x4 lo[4],hi[4];
    #pragma unroll
    for(int ks=0;ks<4;++ks){
      asm volatile("ds_read_b64_tr_b16 %0,%1 offset:%c2":"=&v"(lo[ks]):"v"(vb),"i"(d0*4096+ks*1024):"memory");
      asm volatile("ds_read_b64_tr_b16 %0,%1 offset:%c2":"=&v"(hi[ks]):"v"(vb),"i"(d0*4096+ks*1024+512):"memory");}
    asm volatile("s_waitcnt lgkmcnt(0)":::"memory");SBAR();
    #define PK(k) (bf16x8){lo[k][0],lo[k][1],lo[k][2],lo[k][3],hi[k][0],hi[k][1],hi[k][2],hi[k][3]}
    o[d0]=__builtin_amdgcn_mfma_f32_32x32x16_bf16(pa0,PK(0),o[d0],0,0,0);
    o[d0]=__builtin_amdgcn_mfma_f32_32x32x16_bf16(pa1,PK(1),o[d0],0,0,0);
    o[d0]=__builtin_amdgcn_mfma_f32_32x32x16_bf16(pa2,PK(2),o[d0],0,0,0);
    o[d0]=__builtin_amdgcn_mfma_f32_32x32x16_bf16(pa3,PK(3),o[d0],0,0,0);
    #undef PK
  }
}

#ifndef ATTN_STORE16
#define ATTN_STORE16(p,v) (*(u32x4*)(p)=(v))
#endif
typedef __attribute__((address_space(3))) float lds_f32; typedef __attribute__((address_space(3))) f32x4_t lds_f32x4;
template<int MODE,int THRL> __device__ __forceinline__ void attn_unit(int b,int h,int qb,const bf16*Q,const bf16*__restrict__ K,const bf16*__restrict__ V,bf16*O,const float*__restrict__ aux,char*shm,const int wave_s,const float skipb_unused){
  const int tid=tid_from_wave(wave_s),lane=tid&63,r32=lane&31,hi=lane>>5; const int wid=wave_s;
  const long rowbase=(long)b*SEQ; const int q0=qb*QB;
  const bf16*Qw=Q+(rowbase+q0+wid*QBLK)*DM+h*D;
  int t0=0;
  if(MODE==1){ if(qb>0){ const float skipb=*(const volatile __attribute__((address_space(3))) float*)((lds_cptr)shm+133136); const float*p=aux+(size_t)(b*8+h)*SEQ; const float cq=p[q0]; const bool sk=(lane<4*qb)&&(cq-p[(lane<4*qb?lane:0)*64+63]>=skipb);
      const unsigned long long mk=__ballot(sk); t0=(int)__builtin_ctzll(~mk); t0=__builtin_amdgcn_readfirstlane(t0)&~1; } }
  const bf16*Kh=K+(rowbase+(long)t0*64)*DM+h*D,*Vh=V+(rowbase+(long)t0*64)*DM+h*D;
  const unsigned lds0=(unsigned)(uintptr_t)shm;
  float*wsf=(float*)(shm+LDS_WS)+wid*64;
  const bf16*ksrc=Kh+(long)lane*DM+wid*8;
  const bf16*vsrc=Vh+(long)(16*(wid&3)+(lane>>2))*DM+(wid>>2)*32+(lane&3)*8;
  const unsigned kdst=lds0+LDS_K+wid*1024, vdst=lds0+LDS_V+wid*1024;
  #define DMA_K(t,slot) glds16(ksrc+(long)(t)*KVBLK*DM,(unsigned)__builtin_amdgcn_readfirstlane(kdst+(slot)))
  #define DMA_V(t,slot) glds16(vsrc+(long)(t)*KVBLK*DM,(unsigned)__builtin_amdgcn_readfirstlane(vdst+(slot)))
  const char*Kbase=shm+LDS_K; bf16x8 kf[8];
  const lds_cptr shm3=(lds_cptr)shm; const lds_cptr kp0=shm3+LDS_K+hi*1024+r32*16; const lds_cptr vp0=shm3+LDS_V+((lane>>4)&1)*32+(lane&3)*8+(4*hi+((lane&15)>>2))*64;
  const int NT=(q0+QB)/KVBLK-t0;
  lds_f32* auxl=(lds_f32*)(shm3+LDS_AUX);
  if(MODE==0){ for(int e=tid;e<qb*64;e+=512){ const int j=e>>6,dd=e&63; const float*p=aux+(size_t)((b*16+j)*4)*512+h*64+dd; auxl[e]=(p[0]+p[512])+(p[1024]+p[1536]); } }
  else { const float*p=aux+(size_t)(b*8+h)*SEQ+t0*64; for(int e=tid*4;e<NT*64;e+=2048){ *(lds_f32x4*)(auxl+e)=*(const f32x4_t*)(p+e); } }
  asm volatile("s_waitcnt vmcnt(0) lgkmcnt(0)\n\ts_barrier":::"memory");
  DMA_K(0,0);DMA_V(0,0);DMA_K(1,SLOTB);
  bf16x8 qr[4];
  #pragma unroll
  for(int d0=0;d0<4;++d0)qr[d0]=*reinterpret_cast<const bf16x8*>(&Qw[(long)r32*DM+d0*16+hi*8]);
  float mhat=0.f,l_reg=0.f;f32x16 o[2];o[0]=f32x16{};o[1]=f32x16{};f32x16 negm=f32x16{};if(MODE==0)asm volatile("":"+v"(negm));
  #define CINIT (MODE==0?negm:f32x16{})
  const int qrel=wid*QBLK+r32;
  #define CMASK(P0,P1,t) do{int jb_=(t)-(NT-4); if(jb_>=0)cmask(P0,P1,jb_,qrel,hi);}while(0)
  bool resc=false;
  #define START(P0,P1) do{ const float rm=rowmax(P0,P1); resc=false; \
    { const float dl=__builtin_fmaxf(rm,-30.f); mhat=fadd_s(mhat,dl); \
      _Pragma("unroll") for(int r=0;r<16;++r){P0[r]=fsub_s(P0[r],dl);P1[r]=fsub_s(P1[r],dl);} \
      if(MODE==0){ _Pragma("unroll") for(int r=0;r<16;++r)negm[r]=-mhat; asm volatile("":"+v"(negm)); } } \
    _Pragma("unroll") for(int r=0;r<16;++r)P0[r]=__builtin_amdgcn_exp2f(P0[r]); }while(0)
  #define RESC() do{ if(resc){ asm volatile("s_waitcnt lgkmcnt(0)":::"memory"); \
      _Pragma("unroll") for(int d_=0;d_<2;++d_) _Pragma("unroll") for(int r=0;r<16;++r)o[d_][r]*=wsf[crow(r,hi)]; } }while(0)
  f32x16 pA0,pA1,pB0,pB1;
  int sl_prev=0,sl_cur=0,sl_next=SLOTB;
  #define ROT() do{sl_prev=sl_cur;sl_cur=sl_next;sl_next=(sl_next==(NSLOT-1)*SLOTB)?0:sl_next+SLOTB;}while(0)
  DMA_K(2,2*SLOTB);
  WAIT_BAR(3);
  unsigned sel=0u;
  if(MODE==0){ float v1=-3.0e38f,v2=-3.0e38f,v3=-3.0e38f; int i1=-1,i2=-1,i3=-1;
    for(int j=0;j<qb;++j){ const lds_f32* km=auxl+j*64+hi*8; float g=0.f;
      _Pragma("unroll") for(int d0=0;d0<4;++d0){ const f32x4_t a=*(const lds_f32x4*)(km+d0*16), c=*(const lds_f32x4*)(km+d0*16+4);
        g+=__uint_as_float((unsigned)(unsigned short)qr[d0][0]<<16)*a[0]; g+=__uint_as_float((unsigned)(unsigned short)qr[d0][1]<<16)*a[1]; g+=__uint_as_float((unsigned)(unsigned short)qr[d0][2]<<16)*a[2]; g+=__uint_as_float((unsigned)(unsigned short)qr[d0][3]<<16)*a[3];
        g+=__uint_as_float((unsigned)(unsigned short)qr[d0][4]<<16)*c[0]; g+=__uint_as_float((unsigned)(unsigned short)qr[d0][5]<<16)*c[1]; g+=__uint_as_float((unsigned)(unsigned short)qr[d0][6]<<16)*c[2]; g+=__uint_as_float((unsigned)(unsigned short)qr[d0][7]<<16)*c[3]; }
      g=sum_x32(g);
      if(g>v1){v3=v2;i3=i2;v2=v1;i2=i1;v1=g;i1=j;} else if(g>v2){v3=v2;i3=i2;v2=g;i2=j;} else if(g>v3){v3=g;i3=j;} }
    sel=(i1>=0?(1u<<i1):0u)|(i2>=0?(1u<<i2):0u)|(i3>=0?(1u<<i3):0u); }
  #define HOOK(P0,P1,t) do{ if(MODE==0){ const int j_=(t)>>2; if(j_<qb){ if(!((sel>>j_)&1u)){ _Pragma("unroll") for(int r=0;r<16;++r){P0[r]=-INFINITY;P1[r]=-INFINITY;} } } } \
    else { const lds_f32* bp_=auxl+64*(t)+4*hi; const float nm_=-mhat; _Pragma("unroll") for(int g_=0;g_<4;++g_){ const f32x4_t b0_=*(const lds_f32x4*)(bp_+8*g_)+nm_; const f32x4_t b1_=*(const lds_f32x4*)(bp_+32+8*g_)+nm_; \
        P0[4*g_]+=b0_[0];P0[4*g_+1]+=b0_[1];P0[4*g_+2]+=b0_[2];P0[4*g_+3]+=b0_[3]; P1[4*g_]+=b1_[0];P1[4*g_+1]+=b1_[1];P1[4*g_+2]+=b1_[2];P1[4*g_+3]+=b1_[3]; } } }while(0)
  qkt(pA0,pA1,Kbase,qr,CINIT,r32,hi);asm volatile("s_nop 15\n\ts_nop 7":"+v"(pA0),"+v"(pA1));HOOK(pA0,pA1,0);CMASK(pA0,pA1,0);
  START(pA0,pA1);
  _Pragma("unroll") for(int r=0;r<16;++r)pA1[r]=__builtin_amdgcn_exp2f(pA1[r]);
  WAIT_BAR(0);
  DMA_K(3,0);DMA_V(1,SLOTB);
  ROT();
  kload8(kf,kp0+sl_cur);
  WAIT_BAR(2);
  s16x4 vlo[8],vhi[8]; u32x4 pw0,pw1,pw2,pw3;
  #define PKW(P,B) cvtpk_s(P[B],P[B+1])
  #define PAF(k) __builtin_bit_cast(bf16x8,pw##k)
  #define VFR(i) (bf16x8){vlo[i][0],vlo[i][1],vlo[i][2],vlo[i][3],vhi[i][0],vhi[i][1],vhi[i][2],vhi[i][3]}
  #define PIN(x) asm volatile("":"+v"(x))
  #define MX3(a,b,c) __builtin_fmaxf(__builtin_fmaxf((a),(b)),(c))
  #define GAPA(MF,A0,A1,A2,A3,W0,W1,PW) do{ MF; sacc+=A0; sacc+=A1; sacc+=A2; sacc+=A3; PIN(sacc); W0; W1; PIN(PW); SBAR(); }while(0)
  #define EX(v) __builtin_amdgcn_exp2f(v)
  #define GAPB(MF,X,B) do{ MF; X[B]=EX(X[B]); X[B+1]=EX(X[B+1]); X[B+2]=EX(X[B+2]); X[B+3]=EX(X[B+3]); PIN(X); SBAR(); }while(0)
  #define VRD(i) do{ vlo[i]=vtr(vp_+(((i)>>2)*4096+((i)&3)*1024)); vhi[i]=vtr(vp_+(((i)>>2)*4096+((i)&3)*1024+512)); }while(0)
  #define KRD(G,j) do{ if(G){ kload2(kf,kp0+sl_next,j); SBAR(); } }while(0)
  #define STEP(C0,C1,P0,P1,t,GK,GV,GL) do{ SBAR(); \
    const lds_cptr vp_=vp0+sl_prev; \
    VRD(0); SBAR(); float sacc=(P0[0]+P0[1]); \
    GAPA(C0=__builtin_amdgcn_mfma_f32_32x32x16_bf16(kf[0],qr[0],CINIT,0,0,0), P0[2],P0[3],P0[4],P0[5],     pw0[0]=PKW(P0,0), pw0[1]=PKW(P0,2), pw0); \
    VRD(4); SBAR(); GAPA(C1=__builtin_amdgcn_mfma_f32_32x32x16_bf16(kf[1],qr[0],CINIT,0,0,0), P0[6],P0[7],P0[8],P0[9],     pw0[2]=PKW(P0,4), pw0[3]=PKW(P0,6), pw0); \
    VRD(1); SBAR(); GAPA(C0=__builtin_amdgcn_mfma_f32_32x32x16_bf16(kf[2],qr[1],C0,0,0,0),   P0[10],P0[11],P0[12],P0[13], pw1[0]=PKW(P0,8), pw1[1]=PKW(P0,10), pw1); \
    VRD(5); SBAR(); GAPA(C1=__builtin_amdgcn_mfma_f32_32x32x16_bf16(kf[3],qr[1],C1,0,0,0),   P0[14],P0[15],P1[0],P1[1],   pw1[2]=PKW(P0,12),pw1[3]=PKW(P0,14), pw1); \
    VRD(2); SBAR(); GAPA(C0=__builtin_amdgcn_mfma_f32_32x32x16_bf16(kf[4],qr[2],C0,0,0,0),   P1[2],P1[3],P1[4],P1[5],     pw2[0]=PKW(P1,0), pw2[1]=PKW(P1,2), pw2); \
    VRD(6); SBAR(); GAPA(C1=__builtin_amdgcn_mfma_f32_32x32x16_bf16(kf[5],qr[2],C1,0,0,0),   P1[6],P1[7],P1[8],P1[9],     pw2[2]=PKW(P1,4), pw2[3]=PKW(P1,6), pw2); \
    VRD(3); SBAR(); GAPA(C0=__builtin_amdgcn_mfma_f32_32x32x16_bf16(kf[6],qr[3],C0,0,0,0),   P1[10],P1[11],P1[12],P1[13], pw3[0]=PKW(P1,8), pw3[1]=PKW(P1,10), pw3); \
    VRD(7); SBAR(); GAPA(C1=__builtin_amdgcn_mfma_f32_32x32x16_bf16(kf[7],qr[3],C1,0,0,0),   P1[14],P1[15],0.f,0.f,       pw3[2]=PKW(P1,12),pw3[3]=PKW(P1,14), pw3); \
    l_reg+=sacc; \
    if(GK){DMA_K((t)+3,sl_cur);} if(GV){DMA_V((t)+1,sl_next);} \
    HOOK(C0,C1,t); CMASK(C0,C1,t); \
    { float a=MX3(C0[0],C0[1],C1[0]),b=MX3(C0[2],C0[3],C1[1]); a=MX3(a,C1[2],C1[3]); \
      _Pragma("unroll") for(int r=4;r<16;r+=4){a=MX3(a,C0[r],C0[r+1]);b=MX3(b,C0[r+2],C0[r+3]);a=MX3(a,C1[r],C1[r+1]);b=MX3(b,C1[r+2],C1[r+3]);} \
      float rm=__builtin_fmaxf(a,b); { auto rr=__builtin_amdgcn_permlane32_swap(__float_as_uint(rm),__float_as_uint(rm),false,false); rm=__builtin_fmaxf(__uint_as_float(rr[0]),__uint_as_float(rr[1])); } \
      resc=false; \
      if(__builtin_expect(__any(rm>(float)THRL),0)){ const float dl=__builtin_fmaxf(rm,0.f); mhat+=dl; \
        _Pragma("unroll") for(int r=0;r<16;++r){C0[r]-=dl;C1[r]-=dl;} \
        if(MODE==0){ _Pragma("unroll") for(int r=0;r<16;++r)negm[r]=-mhat; asm volatile("":"+v"(negm)); } \
        const float f=__builtin_amdgcn_exp2f(-dl); l_reg*=f; if(hi==0)wsf[r32]=f; resc=true; } } \
    SBAR(); \
    GAPB(o[0]=__builtin_amdgcn_mfma_f32_32x32x16_bf16(PAF(0),VFR(0),o[0],0,0,0), C0,0); \
    GAPB(o[1]=__builtin_amdgcn_mfma_f32_32x32x16_bf16(PAF(0),VFR(4),o[1],0,0,0), C0,4); \
    KRD(GL,0); GAPB(o[0]=__builtin_amdgcn_mfma_f32_32x32x16_bf16(PAF(1),VFR(1),o[0],0,0,0), C0,8); \
    KRD(GL,1); GAPB(o[1]=__builtin_amdgcn_mfma_f32_32x32x16_bf16(PAF(1),VFR(5),o[1],0,0,0), C0,12); \
    KRD(GL,2); GAPB(o[0]=__builtin_amdgcn_mfma_f32_32x32x16_bf16(PAF(2),VFR(2),o[0],0,0,0), C1,0); \
    KRD(GL,3); GAPB(o[1]=__builtin_amdgcn_mfma_f32_32x32x16_bf16(PAF(2),VFR(6),o[1],0,0,0), C1,4); \
    GAPB(o[0]=__builtin_amdgcn_mfma_f32_32x32x16_bf16(PAF(3),VFR(3),o[0],0,0,0), C1,8); \
    GAPB(o[1]=__builtin_amdgcn_mfma_f32_32x32x16_bf16(PAF(3),VFR(7),o[1],0,0,0), C1,12); \
    }while(0)
  int t=1;
  #undef CMASK
  #define CMASK(P0,P1,t) do{}while(0)
  for(;t+5<NT;t+=2){
    STEP(pB0,pB1,pA0,pA1,t,true,true,true);     WAIT_BAR(2); RESC(); ROT();
    STEP(pA0,pA1,pB0,pB1,t+1,true,true,true);   WAIT_BAR(2); RESC(); ROT();
  }
  #undef CMASK
  #define CMASK(P0,P1,t) do{int jb_=(t)-(NT-4); if(jb_>=0)cmask(P0,P1,jb_,qrel,hi);}while(0)
  #define ENDW(tt) do{ if((tt)+3<NT){WAIT_BAR(2);} else if((tt)+2<NT){WAIT_BAR(1);} else {WAIT_BAR(0);} }while(0)
  for(;t+1<NT;t+=2){
    STEP(pB0,pB1,pA0,pA1,t,(t+3<NT),(t+1<NT),(t+1<NT));       ENDW(t);   RESC(); ROT();
    STEP(pA0,pA1,pB0,pB1,t+1,(t+4<NT),(t+2<NT),(t+2<NT));     ENDW(t+1); RESC(); ROT();
  }
  STEP(pB0,pB1,pA0,pA1,NT-1,false,false,false); RESC();
  { float sacc=pB0[0]+pB0[1]; _Pragma("unroll") for(int r=2;r<16;++r)sacc+=pB0[r]; _Pragma("unroll") for(int r=0;r<16;++r)sacc+=pB1[r]; l_reg+=sacc;
    pw0=(u32x4){PKW(pB0,0),PKW(pB0,2),PKW(pB0,4),PKW(pB0,6)};pw1=(u32x4){PKW(pB0,8),PKW(pB0,10),PKW(pB0,12),PKW(pB0,14)};pw2=(u32x4){PKW(pB1,0),PKW(pB1,2),PKW(pB1,4),PKW(pB1,6)};pw3=(u32x4){PKW(pB1,8),PKW(pB1,10),PKW(pB1,12),PKW(pB1,14)};
    SBAR(); const int vb0=(int)(lds0+LDS_V)+((lane>>4)&1)*32+(lane&3)*8+(4*hi+((lane&15)>>2))*64; pv(o,vb0+sl_cur,PAF(0),PAF(1),PAF(2),PAF(3)); }
  #undef PKW
  #undef PAF
  #undef VFR
  #undef PIN
  #undef MX3
  #undef GAPA
  #undef GAPB
  #undef EX
  #undef VRD
  #undef KRD
  #undef STEP
  #undef ENDW
  {auto rr=__builtin_amdgcn_permlane32_swap(__float_as_uint(l_reg),__float_as_uint(l_reg),false,false);l_reg=__uint_as_float(rr[0])+__uint_as_float(rr[1]);}
  if(hi==0)wsf[32+r32]=l_reg;asm volatile("s_waitcnt lgkmcnt(0)":::"memory");
  float rli[16];
  #pragma unroll
  for(int r=0;r<16;++r)rli[r]=__builtin_amdgcn_rcpf(wsf[32+crow(r,hi)]);
  bf16*Ow=O+(rowbase+q0+wid*QBLK)*DM+h*D;
  { bf16*stg=(bf16*)(shm+LDS_OST)+wid*2048;
    #pragma unroll
    for(int r=0;r<16;++r){const int orow=crow(r,hi);
      #pragma unroll
      for(int d0=0;d0<2;++d0)stg[orow*64+d0*32+r32]=__float2bfloat16(o[d0][r]*rli[r]);}
    asm volatile("s_waitcnt lgkmcnt(0)":::"memory");
    #pragma unroll
    for(int i=0;i<4;++i){const int row=i*8+(lane>>3),ch=lane&7; const u32x4 v=*(const u32x4*)(stg+row*64+ch*8); ATTN_STORE16(Ow+(long)row*DM+ch*8,v);} }
  asm volatile("s_waitcnt lgkmcnt(0)\n\ts_barrier":::"memory");
  #undef DMA_K
  #undef DMA_V
  #undef CMASK
  #undef HOOK
  #undef CINIT
  #undef START
  #undef RESC
  #undef ROT
}
#undef SBAR
#undef WAIT_BAR
}

namespace attn_body {
#define SBAR() __builtin_amdgcn_sched_barrier(0)
__device__ __forceinline__ void mem_unit(int brow,int bglob,int h,int qb,bf16*QO,const bf16*__restrict__ MK,char*shm,const int wave_s){
  const int tid=tid_from_wave(wave_s),lane=tid&63,r32=lane&31,hi=lane>>5; const int wid=wave_s;
  const lds_cptr shm3=(lds_cptr)shm; const unsigned lds0=(unsigned)(uintptr_t)shm;
  typedef __attribute__((address_space(3))) u32x4 lds_u32x4;
  const bf16*kg=MK+(size_t)(bglob*256)*MKP+h*128; const bf16*vg=kg+512;
  {
    const bf16*kp=kg+(size_t)(tid&255)*MKP+(tid>>8)*8; const lds_cptr kl=shm3+((tid&255)>>6)*16384+(tid>>8)*1024+(tid&63)*16;
    const bf16*vp=vg+(size_t)(tid>>2)*MKP+(tid&3)*8; const lds_cptr vl=shm3+65536+((tid>>2)>>6)*16384+((tid>>2)&63)*64+(tid&3)*16;
    #pragma unroll 2
    for(int i=0;i<8;i+=4){ u32x4 t0=*(const u32x4*)(kp+(i+0)*16),t1=*(const u32x4*)(kp+(i+1)*16),t2=*(const u32x4*)(kp+(i+2)*16),t3=*(const u32x4*)(kp+(i+3)*16);
      *(lds_u32x4*)(kl+(i+0)*2048)=t0; *(lds_u32x4*)(kl+(i+1)*2048)=t1; *(lds_u32x4*)(kl+(i+2)*2048)=t2; *(lds_u32x4*)(kl+(i+3)*2048)=t3; }
    #pragma unroll 2
    for(int i=0;i<8;i+=2){ u32x4 t0=*(const u32x4*)(vp+(i>>1)*32),t1=*(const u32x4*)(vp+(size_t)128*MKP+(i>>1)*32);
      *(lds_u32x4*)(vl+(i>>1)*4096)=t0; *(lds_u32x4*)(vl+32768+(i>>1)*4096)=t1; } }
  bf16*Qw=QO+(size_t)(brow+qb*256+wid*32)*DM+h*128;
  bf16x8 qr[8];
  #pragma unroll
  for(int d0=0;d0<8;++d0)qr[d0]=*reinterpret_cast<const bf16x8*>(&Qw[(size_t)r32*DM+d0*16+hi*8]);
  asm volatile("s_waitcnt vmcnt(0) lgkmcnt(0)\n\ts_barrier":::"memory");
  lds_f32* wsf=(lds_f32*)(shm3+131072)+wid*64;
  float m=-INFINITY,l_reg=0.f; f32x16 o[4]; o[0]=f32x16{};o[1]=f32x16{};o[2]=f32x16{};o[3]=f32x16{};
  const int vbl=((lane>>4)&1)*32+(lane&3)*8+(4*hi+((lane&15)>>2))*64;
  #pragma unroll 1
  for(int kt=0;kt<4;++kt){
    f32x16 p0=f32x16{},p1=f32x16{};
    const lds_cptr kb=shm3+kt*16384+hi*1024+r32*16;
    #pragma unroll
    for(int d0=0;d0<8;++d0){
      const bf16x8 b0=*(const __attribute__((address_space(3))) bf16x8*)(kb+d0*2048);
      const bf16x8 b1=*(const __attribute__((address_space(3))) bf16x8*)(kb+d0*2048+512);
      p0=__builtin_amdgcn_mfma_f32_32x32x16_bf16(b0,qr[d0],p0,0,0,0); p1=__builtin_amdgcn_mfma_f32_32x32x16_bf16(b1,qr[d0],p1,0,0,0); }
    float rm=p0[0];
    #pragma unroll
    for(int r=0;r<16;++r){rm=__builtin_fmaxf(rm,p0[r]);rm=__builtin_fmaxf(rm,p1[r]);}
    rm=max_x32(rm);
    const float mn=__builtin_fmaxf(m,rm); const float alpha=__builtin_amdgcn_exp2f(m-mn); m=mn;
    float sacc=0.f;
    #pragma unroll
    for(int r=0;r<16;++r){p0[r]=__builtin_amdgcn_exp2f(p0[r]-mn);p1[r]=__builtin_amdgcn_exp2f(p1[r]-mn);sacc+=p0[r]+p1[r];}
    l_reg=l_reg*alpha+sacc;
    if(hi==0)wsf[r32]=alpha;
    asm volatile("s_waitcnt lgkmcnt(0)":::"memory");
    #pragma unroll
    for(int r=0;r<16;++r){ const float a=wsf[crow(r,hi)]; o[0][r]*=a;o[1][r]*=a;o[2][r]*=a;o[3][r]*=a; }
    u32x4 pw0,pw1,pw2,pw3;
    pw0=(u32x4){cvtpk_s(p0[0],p0[1]),cvtpk_s(p0[2],p0[3]),cvtpk_s(p0[4],p0[5]),cvtpk_s(p0[6],p0[7])};
    pw1=(u32x4){cvtpk_s(p0[8],p0[9]),cvtpk_s(p0[10],p0[11]),cvtpk_s(p0[12],p0[13]),cvtpk_s(p0[14],p0[15])};
    pw2=(u32x4){cvtpk_s(p1[0],p1[1]),cvtpk_s(p1[2],p1[3]),cvtpk_s(p1[4],p1[5]),cvtpk_s(p1[6],p1[7])};
    pw3=(u32x4){cvtpk_s(p1[8],p1[9]),cvtpk_s(p1[10],p1[11]),cvtpk_s(p1[12],p1[13]),cvtpk_s(p1[14],p1[15])};
    const int vb=(int)(lds0+65536+kt*16384)+vbl;
    SBAR(); pv(o,vb,__builtin_bit_cast(bf16x8,pw0),__builtin_bit_cast(bf16x8,pw1),__builtin_bit_cast(bf16x8,pw2),__builtin_bit_cast(bf16x8,pw3));
    pv(o+2,vb+8192,__builtin_bit_cast(bf16x8,pw0),__builtin_bit_cast(bf16x8,pw1),__builtin_bit_cast(bf16x8,pw2),__builtin_bit_cast(bf16x8,pw3));
    asm volatile("s_waitcnt lgkmcnt(0)":::"memory");
  }
  l_reg=sum_x32(l_reg);
  if(hi==0)wsf[32+r32]=l_reg; asm volatile("s_waitcnt lgkmcnt(0)":::"memory");
  asm volatile("s_waitcnt lgkmcnt(0)\n\ts_barrier":::"memory");
  { typedef __attribute__((address_space(3))) unsigned short lds_u16;
    lds_u16* stg=(lds_u16*)(shm3+wid*8192);
    #pragma unroll
    for(int r=0;r<16;++r){ const float rl=__builtin_amdgcn_rcpf(wsf[32+crow(r,hi)]); const int orow=crow(r,hi);
      #pragma unroll
      for(int db=0;db<4;++db){ const unsigned w=cvtpk_s(o[db][r]*rl,0.f); stg[orow*128+db*32+r32]=(unsigned short)w; } }
    asm volatile("s_waitcnt lgkmcnt(0)":::"memory");
    #pragma unroll
    for(int i=0;i<8;++i){ const int row=i*4+(lane>>4),ch=lane&15; const u32x4 v=*(const lds_u32x4*)(shm3+wid*8192+row*256+ch*16); *(u32x4*)(Qw+(size_t)row*DM+ch*8)=v; } }
  asm volatile("s_waitcnt lgkmcnt(0)\n\ts_barrier":::"memory");
}
#undef SBAR
}

constexpr int NWAVES = 8;
constexpr int TOK = 32768, DMOD = 1024, FF = 2816, SEQL = 4096, PP = 5184, MKP = 2112, DIN = 8200, NLAYER = 2;
constexpr int C_QA = 0, C_PU = 512, C_QC = 1024, C_MQ = 1536, C_KA = 2048, C_VA = 2560, C_KC = 3072, C_VC = 3584, C_H = 4096, C_Z = 2048;
constexpr float RMS_EPS = 1e-6f;
constexpr float LOG2E = 1.4426950408889634f;
constexpr float C2_64 = 0.125f * LOG2E, C2_128 = 0.08838834764831845f * LOG2E;
constexpr size_t MiB = 1u << 20;
constexpr size_t WS_FOXF = 1 * MiB, WS_CK2 = 2 * MiB, WS_KMEAN = 3 * MiB, WS_MEMN = 4 * MiB, WS_MEMKV = 8 * MiB, WS_POOLED = 17 * MiB, WS_W = 49 * MiB,
                 WS_PROJ = 173 * MiB, WS_HF = WS_PROJ + 176 * MiB, WS_END = 497 * MiB;
static_assert((size_t)2048 * MKP * 2 <= 9 * MiB && (size_t)TOK * PP * 2 <= 324 * MiB && (size_t)TOK * FF * 2 <= 176 * MiB && (size_t)TOK * 512 * 2 <= 32 * MiB && (size_t)256 * 65536 * 2 <= 32 * MiB, "workspace map");
constexpr size_t E_FFN_IN = (size_t)2 * FF * DMOD, E_FFN_OUT = (size_t)DMOD * FF, E_WIN = (size_t)8192 * DMOD, E_WBR = (size_t)4 * DMOD * 1024  , E_WOUT = (size_t)DMOD * DMOD, E_WPOOL = (size_t)512 * 512;
constexpr size_t O_FFN1_IN = 0, O_FFN1_OUT = O_FFN1_IN + E_FFN_IN, O_WIN = O_FFN1_OUT + E_FFN_OUT, O_WBR = O_WIN + E_WIN, O_WOUT = O_WBR + E_WBR, O_WPOOL = O_WOUT + E_WOUT,
                 O_FFN2_IN = O_WPOOL + E_WPOOL, O_FFN2_OUT = O_FFN2_IN + E_FFN_IN, E_LAYER = O_FFN2_OUT + E_FFN_OUT, O_WMEM = NLAYER * E_LAYER, E_WTOTAL = O_WMEM + (size_t)2048 * 1024;
static_assert(E_WTOTAL * 2 <= 124 * MiB, "weights fit");
constexpr int RING_BYTES = 131072, LDS_BYTES = 147456;

#define LAS __attribute__((address_space(3)))
typedef unsigned short bf16;
typedef unsigned v4u __attribute__((ext_vector_type(4)));
typedef float f32x4 __attribute__((ext_vector_type(4)));
#define LDS_WAIT() asm volatile("s_waitcnt lgkmcnt(0)" ::: "memory")
__device__ __forceinline__ unsigned pk2(float lo, float hi) { return pg8::cvt_pk_bf16(lo, hi); }
__device__ __forceinline__ float wave_sum(float v) {
    v += xor_lane<1>(v); v += xor_lane<2>(v); v += xor_lane<4>(v); v += xor_lane<8>(v); v += xor_lane<16>(v); v = sum_x32(v);
    return v;
}
__device__ __forceinline__ void ld8(const bf16* p, float (&v)[8]) { const v4u w = *(const v4u*)p;
    v[0] = pg8::bf_lo(w.x); v[1] = pg8::bf_hi(w.x); v[2] = pg8::bf_lo(w.y); v[3] = pg8::bf_hi(w.y); v[4] = pg8::bf_lo(w.z); v[5] = pg8::bf_hi(w.z); v[6] = pg8::bf_lo(w.w); v[7] = pg8::bf_hi(w.w); }
__device__ __forceinline__ void un8(const v4u& w, float (&v)[8]) {
    v[0] = pg8::bf_lo(w.x); v[1] = pg8::bf_hi(w.x); v[2] = pg8::bf_lo(w.y); v[3] = pg8::bf_hi(w.y); v[4] = pg8::bf_lo(w.z); v[5] = pg8::bf_hi(w.z); v[6] = pg8::bf_lo(w.w); v[7] = pg8::bf_hi(w.w); }
__device__ __forceinline__ void st8(bf16* p, const float (&v)[8]) { v4u w; w.x = pk2(v[0], v[1]); w.y = pk2(v[2], v[3]); w.z = pk2(v[4], v[5]); w.w = pk2(v[6], v[7]); *(v4u*)p = w; }

__device__ __forceinline__ void tr_item(const float* W, int ldw, int srccol0, int k0, bf16* WT, int ldk, int dstrow0, const float* kscale, LAS float* scr, int lane) {
#pragma unroll
    for (int i = 0; i < 32; ++i) { const int kk = 2 * i + (lane >> 5); float v = W[(size_t)(k0 + kk) * ldw + srccol0 + (lane & 31)]; if (kscale) v *= kscale[k0 + kk]; scr[kk * 33 + (lane & 31)] = v; }
    LDS_WAIT(); asm volatile("" ::: "memory");
    const int c = lane & 7;
#pragma unroll
    for (int j = 0; j < 4; ++j) { const int n = (lane >> 3) + 8 * j; const LAS float* s = scr + (8 * c) * 33 + n;
        v4u o; o.x = pk2(s[0 * 33], s[1 * 33]); o.y = pk2(s[2 * 33], s[3 * 33]); o.z = pk2(s[4 * 33], s[5 * 33]); o.w = pk2(s[6 * 33], s[7 * 33]);
        *(v4u*)(WT + (size_t)(dstrow0 + n) * ldk + k0 + 8 * c) = o; }
    LDS_WAIT(); asm volatile("" ::: "memory");
}

template <bool FOX> __device__ __forceinline__ void norm_rows(const float* x, const float* gain, bf16* H, int ldh, int nrows, const float* w_in_l, float* foxf, int gw, int NGW, int lane) {
    f32x4 gv[4];
#pragma unroll
    for (int j = 0; j < 4; ++j) gv[j] = gain ? *((const f32x4*)gain + lane + 64 * j) : (f32x4){1.f, 1.f, 1.f, 1.f};
    f32x4 wf[FOX ? 16 : 1][2];
    if (FOX) {
#pragma unroll
        for (int j = 0; j < 4; ++j)
#pragma unroll
            for (int c = 0; c < 4; ++c) { const float* p = w_in_l + (size_t)(256 * j + 4 * lane + c) * DIN + 3072; wf[j * 4 + c][0] = *(const f32x4*)p; wf[j * 4 + c][1] = *(const f32x4*)(p + 4); }
    }
    f32x4 nv[4];
    if (gw < nrows) { const f32x4* xr = (const f32x4*)(x + (size_t)gw * DMOD) + lane;
#pragma unroll
        for (int j = 0; j < 4; ++j) nv[j] = xr[64 * j]; }
    for (int m = gw; m < nrows; m += NGW) {
        f32x4 v[4]; float s2 = 0.f;
#pragma unroll
        for (int j = 0; j < 4; ++j) { v[j] = nv[j]; s2 += (v[j].x * v[j].x + v[j].y * v[j].y) + (v[j].z * v[j].z + v[j].w * v[j].w); }
        if (m + NGW < nrows) { const f32x4* xr = (const f32x4*)(x + (size_t)(m + NGW) * DMOD) + lane;
#pragma unroll
            for (int j = 0; j < 4; ++j) nv[j] = xr[64 * j]; }
        const float rstd = 1.0f / sqrtf(wave_sum(s2) * (1.f / DMOD) + RMS_EPS);
        unsigned long long* o8 = (unsigned long long*)(H + (size_t)m * ldh) + lane;
#pragma unroll
        for (int j = 0; j < 4; ++j) { v[j] = v[j] * rstd * gv[j]; o8[64 * j] = (unsigned long long)pk2(v[j].x, v[j].y) | ((unsigned long long)pk2(v[j].z, v[j].w) << 32); }
        if (FOX) {
            float acc[8];
#pragma unroll
            for (int h = 0; h < 8; ++h) acc[h] = 0.f;
#pragma unroll
            for (int j = 0; j < 4; ++j)
#pragma unroll
                for (int c = 0; c < 4; ++c) { const float hv = v[j][c];
#pragma unroll
                    for (int h = 0; h < 4; ++h) { acc[h] += hv * wf[j * 4 + c][0][h]; acc[4 + h] += hv * wf[j * 4 + c][1][h]; } }
#pragma unroll
            for (int h = 0; h < 8; ++h) acc[h] = wave_sum(acc[h]);
            if (lane < 8) { const float sv = lane == 0 ? acc[0] : lane == 1 ? acc[1] : lane == 2 ? acc[2] : lane == 3 ? acc[3] : lane == 4 ? acc[4] : lane == 5 ? acc[5] : lane == 6 ? acc[6] : acc[7];
                foxf[(size_t)((m >> 12) * 8 + lane) * SEQL + (m & (SEQL - 1))] = sv; }
        }
    }
}

template <int GL> __device__ __forceinline__ void gnorm8(float (&v)[8], const float (&g)[8], float scale) {
    float ss = 0.f;
#pragma unroll
    for (int i = 0; i < 8; ++i) ss += v[i] * v[i];
    ss += xor_lane<1>(ss); ss += xor_lane<2>(ss); ss += xor_lane<4>(ss); if (GL > 8) ss += xor_lane<8>(ss);
    const float r = scale / sqrtf(ss * (1.0f / (8 * GL)) + RMS_EPS);
#pragma unroll
    for (int i = 0; i < 8; ++i) v[i] = v[i] * r * g[i];
}
__device__ __forceinline__ void rot8(float (&v)[8], const float (&cc)[8], const float (&sn)[8], int li) {
    float oth[8];
#pragma unroll
    for (int i = 0; i < 8; ++i) oth[i] = xor_lane<1>(v[i]);
    if (li == 0) {
#pragma unroll
        for (int i = 0; i < 8; ++i) v[i] = v[i] * cc[i] - oth[i] * sn[i];
    } else if (li == 1) {
#pragma unroll
        for (int i = 0; i < 8; ++i) v[i] = v[i] * cc[i] + oth[i] * sn[i];
    }
}

#define XB_TMO      128
#define XB_XCNT(j)  (256  + 64 * (j))
#define XB_XSUB(j)  (1280 + 64 * (j))
#define XB_XGEN(j)  (2304 + 64 * (j))
#define XB_TOP      3328
#define XB_TOPGEN   3392
#define XCD_BAR_WORDS 3456
#define XB_SPIN_CAP (1u << 18)

__device__ __forceinline__ unsigned xb_ld(unsigned* p)              { return __hip_atomic_load(p, __ATOMIC_RELAXED, __HIP_MEMORY_SCOPE_AGENT); }
__device__ __forceinline__ unsigned xb_add(unsigned* p, unsigned v) { return __hip_atomic_fetch_add(p, v, __ATOMIC_RELAXED, __HIP_MEMORY_SCOPE_AGENT); }
__device__ __forceinline__ unsigned xb_xcc_id() { return (unsigned)__builtin_amdgcn_s_getreg((3 << 11) | 20) & 0xFu; }
#define XB_SPIN(cond, bar) do { unsigned _sp = 0; while (cond) { __builtin_amdgcn_s_sleep(1); \
    if ((++_sp & 255u) == 0u) { if (xb_ld(&(bar)[XB_TMO])) break; if (_sp > XB_SPIN_CAP) { atomicAdd(&(bar)[XB_TMO], 1u); break; } } } } while (0)

struct XcdBarrier {
    unsigned* bar; unsigned x;
    volatile LAS unsigned* st;
};

__device__ __forceinline__ XcdBarrier xcd_barrier_post(unsigned* bar, volatile LAS unsigned* st, int wave_s) {
    XcdBarrier b; b.bar = bar; b.x = xb_xcc_id(); b.st = st;
    if (tid_from_wave(wave_s) == 0) (void)xb_add(&bar[XB_XCNT(b.x)], 1u);
    return b;
}
__device__ __forceinline__ void xcd_barrier_complete(unsigned* bar, unsigned x, unsigned& nloc, unsigned& nx) {
    const unsigned G = gridDim.x * gridDim.y * gridDim.z;
    unsigned sum, cnt, mine, sp = 0u;
    for (;;) {
        sum = 0u; cnt = 0u; mine = 0u;
#pragma unroll
        for (unsigned j = 0; j < 16; ++j) { const unsigned c = xb_ld(&bar[XB_XCNT(j)]); sum += c; cnt += (c > 0u) ? 1u : 0u; mine = (j == x) ? c : mine; }
        if (sum == G) break;
        __builtin_amdgcn_s_sleep(1);
        if ((++sp & 255u) == 0u) { if (xb_ld(&bar[XB_TMO])) break; if (sp > XB_SPIN_CAP) { atomicAdd(&bar[XB_TMO], 1u); break; } }
    }
    nloc = mine > 0u ? mine : 1u; nx = cnt > 0u ? cnt : 1u;
}

__device__ __forceinline__ void xcd_barrier(const XcdBarrier& b, int wave_s) {
    asm volatile("s_waitcnt vmcnt(0)" ::: "memory");
    __syncthreads();
    if (tid_from_wave(wave_s) == 0) {
        unsigned* bar = b.bar;
        __builtin_amdgcn_s_waitcnt(0);
        unsigned nloc = b.st[0], nx = b.st[1];
        if (nloc == 0u) { xcd_barrier_complete(bar, b.x, nloc, nx); b.st[0] = nloc; b.st[1] = nx; }
        const unsigned old = xb_add(&bar[XB_XSUB(b.x)], 1u);
        const unsigned gen = old / nloc;
        if (old + 1u == (gen + 1u) * nloc) {
            __builtin_amdgcn_fence(__ATOMIC_RELEASE, "agent");
            asm volatile("s_waitcnt vmcnt(0)" ::: "memory");
            const unsigned og = xb_add(&bar[XB_TOP], 1u);
            const unsigned tg = og / nx;
            if (og + 1u == (tg + 1u) * nx) xb_add(&bar[XB_TOPGEN], 1u);
            else XB_SPIN(xb_ld(&bar[XB_TOPGEN]) == tg, bar);
            __builtin_amdgcn_fence(__ATOMIC_ACQUIRE, "agent");
            xb_add(&bar[XB_XGEN(b.x)], 1u);
            asm volatile("s_waitcnt vmcnt(0)" ::: "memory");
        } else {
            XB_SPIN(xb_ld(&bar[XB_XGEN(b.x)]) == gen, bar);
            __builtin_amdgcn_fence(__ATOMIC_ACQUIRE, "agent");
            asm volatile("s_waitcnt vmcnt(0)" ::: "memory");
        }
    }
    __syncthreads();
}

__device__ __forceinline__ float logsig(float x) { return fminf(x, 0.f) - 0.6931471805599453f * __builtin_amdgcn_logf(1.0f + __builtin_amdgcn_exp2f(-1.4426950408889634f * fabsf(x))); }
struct Args { const float* in[24]; float* out; unsigned char* ws; };

__global__ void __launch_bounds__(NWAVES * 64, 2) hybrid_fwd(Args args) {
    extern __shared__ __attribute__((aligned(16))) unsigned char lds[];
    cg::grid_group grid = cg::this_grid();
    LAS unsigned char* ldsl = (LAS unsigned char*)lds;
    const int G = gridDim.x, bx = blockIdx.x;
    const int vcu = (G % 8 == 0) ? (bx % 8) * (G / 8) + bx / 8 : bx;
    const int NGW = G * NWAVES;
    const int wave_s = __builtin_amdgcn_readfirstlane((int)threadIdx.x >> 6);
    if (tid_from_wave(wave_s) < 2) ((volatile LAS unsigned*)(ldsl + 133120))[tid_from_wave(wave_s)] = 0u;
    __syncthreads();
    XcdBarrier xbar = xcd_barrier_post((unsigned*)args.ws, (volatile LAS unsigned*)(ldsl + 133120), wave_s);
#define GSYNC() xcd_barrier(xbar, wave_s)
#define LANE_STATE() const int tid = tid_from_wave(wave_s), lane = tid & 63, wave = wave_s, gw = vcu * NWAVES + wave; (void)tid; (void)lane; (void)gw
    unsigned char* ws = args.ws;
    const float* x_in = args.in[0]; const float* mem = args.in[1]; const int* positions = (const int*)args.in[2];
    float* xout = args.out;
    float* FOXF = (float*)(ws + WS_FOXF); float* CK2 = (float*)(ws + WS_CK2); float* KMEAN = (float*)(ws + WS_KMEAN);
    bf16* MEMN = (bf16*)(ws + WS_MEMN); bf16* MEMKV = (bf16*)(ws + WS_MEMKV); bf16* POOLED = (bf16*)(ws + WS_POOLED);
    bf16* HF = (bf16*)(ws + WS_HF); bf16* WB = (bf16*)(ws + WS_W); bf16* PROJ = (bf16*)(ws + WS_PROJ); bf16* HID = PROJ; bf16* GS = POOLED;

#ifdef PROBE_PHASE
    unsigned long long probe_acc = 0, probe_t0 = 0;
#define PB(k) do { if ((k) == PROBE_PHASE) probe_t0 = __builtin_amdgcn_s_memrealtime(); } while (0)
#define PE(k) do { if ((k) == PROBE_PHASE) probe_acc += __builtin_amdgcn_s_memrealtime() - probe_t0; } while (0)
#else
#define PB(k) do {} while (0)
#define PE(k) do {} while (0)
#endif
    PB(0);
    {
        LANE_STATE();
        LAS float* scr = (LAS float*)(ldsl + wave * 16384);
        constexpr int I_FI = 16 * 176, I_FO = 44 * 32, I_WI = 16 * 256, I_BR = 4 * 8 * 32, I_WO = 16 * 32, I_MEM = 16 * 32;
        constexpr int I_LAYER = 2 * I_FI + 2 * I_FO + I_WI + I_BR + I_WO + I_MEM;
        for (int it = gw; it < NLAYER * I_LAYER; it += NGW) {
            const int l = it / I_LAYER; int r = it % I_LAYER; bf16* WL = WB + (size_t)l * E_LAYER;
            if (r < 2 * I_FI) { const int which = r / I_FI; r %= I_FI; const float* W = args.in[which ? 22 : 4] + (size_t)l * DMOD * 2 * FF;
                const int kb = r / 176, nb = r % 176, n0 = 32 * nb, isu = n0 / FF, j = n0 % FF;
                tr_item(W, 2 * FF, n0, 64 * kb, WL + (which ? O_FFN2_IN : O_FFN1_IN), DMOD, 256 * (j / 128) + 128 * isu + (j % 128), nullptr, scr, lane); continue; }
            r -= 2 * I_FI;
            if (r < 2 * I_FO) { const int which = r / I_FO; r %= I_FO; const float* W = args.in[which ? 23 : 5] + (size_t)l * FF * DMOD;
                const int kb = r / 32, nb = r % 32;
                tr_item(W, DMOD, 32 * nb, 64 * kb, WL + (which ? O_FFN2_OUT : O_FFN1_OUT), FF, 32 * nb, nullptr, scr, lane); continue; }
            r -= 2 * I_FO;
            if (r < I_WI) { const float* W = args.in[7] + (size_t)l * DMOD * DIN; const int kb = r / 256, nb = r % 256, n0 = 32 * nb;
                int src;
                if (n0 >= 4096) src = n0 + 8; else { const int sec = n0 >> 9, o = n0 & 511;
                    const int sb = sec == 0 ? 0 : sec == 1 ? 3080 : sec == 2 ? 1536 : sec == 3 ? 3592 : sec == 4 ? 512 : sec == 5 ? 1024 : sec == 6 ? 2048 : 2560; src = sb + o; }
                tr_item(W, DIN, src, 64 * kb, WL + O_WIN, DMOD, n0, nullptr, scr, lane); continue; }
            r -= I_WI;
            if (r < I_BR) { const int br = r / 256; r %= 256; const float* W = args.in[19] + ((size_t)l * 4 + br) * 512 * DMOD; const int kb = r / 32, nb = r % 32;
                tr_item(W, DMOD, 32 * nb, 64 * kb, WL + O_WBR + (size_t)br * DMOD * 1024, 1024, 32 * nb, nullptr, scr, lane); continue; }
            r -= I_BR;
            if (r < I_WO) { const float* W = args.in[20] + (size_t)l * DMOD * DMOD; const int kb = r / 32, nb = r % 32;
                tr_item(W, DMOD, 32 * nb, 64 * kb, WL + O_WOUT, DMOD, 32 * nb, nullptr, scr, lane); continue; }
            r -= I_WO;
            { const float* W = args.in[14] + (size_t)l * DMOD * 1024; const int kb = r / 32, nb = r % 32;
                tr_item(W, 1024, 32 * nb, 64 * kb, WB + O_WMEM, DMOD, l * 1024 + 32 * nb, args.in[13] + l * DMOD, scr, lane); }
        }
        for (int e = gw * 64 + lane; e < NLAYER * 512 * 64; e += NGW * 64) {
            const int l = e / (512 * 64), r = e % (512 * 64), n = r / 64, k8 = (r % 64) * 8, g = n >> 7;
            float v[8];
            if ((k8 >> 7) == g) { const float* mp = args.in[17] + (((size_t)l * 4 + g) * 128 + (k8 & 127)) * 128 + (n & 127); const float sc = args.in[18][l * 512 + n];
#pragma unroll
                for (int i = 0; i < 8; ++i) v[i] = mp[i * 128] * sc;
            } else {
#pragma unroll
                for (int i = 0; i < 8; ++i) v[i] = 0.f;
            }
            st8(WB + (size_t)l * E_LAYER + O_WPOOL + (size_t)n * 512 + k8, v);
        }
        norm_rows<false>(mem, nullptr, MEMN, DMOD, 2048, nullptr, nullptr, gw, NGW, lane);
        norm_rows<false>(x_in, args.in[3], HF, DMOD, TOK, nullptr, nullptr, gw, NGW, lane);
    }
    GSYNC();
    if (args.out == nullptr) grid.sync();
    PE(0);

    for (int st = 0; st < 3 * NLAYER; ++st) {
        const int l = st / 3, kind = st % 3;
        bf16* WL = WB + (size_t)l * E_LAYER;
        if (kind != 1) {
            const bool second = (kind == 2);
            const float* xsrc = (st == 0) ? x_in : xout;
            if (st != 0) { PB(1); LANE_STATE(); norm_rows<false>(xsrc, args.in[second ? 21 : 3] + l * DMOD, HF, DMOD, TOK, nullptr, nullptr, gw, NGW, lane); GSYNC(); PE(1); }
            PB(2);
            { pg8::Gemm g{HF, WL + (second ? O_FFN2_IN : O_FFN1_IN), TOK, 2 * FF, DMOD, DMOD, DMOD, 0, 0}; pg8::StaticOrder S; S.init(TOK, 2 * FF, G, bx);
              pg8::EpiSwiglu E{HID, FF};

#ifndef NO_G0
              pg8::gemm_phase<pg8::EpiSwiglu, pg8::StaticOrder, true, true>(ldsl, g, S, E, wave_s);
#endif
              }
            GSYNC(); PE(2); PB(3);
            { pg8::Gemm g{HID, WL + (second ? O_FFN2_OUT : O_FFN1_OUT), TOK, DMOD, FF, FF, FF, 0, 0}; pg8::StaticOrder S; S.init(TOK, DMOD, G, bx);
              pg8::EpiResid E{xsrc, xout, DMOD, 0.5f};

#ifndef NO_G1
              pg8::gemm_phase<pg8::EpiResid, pg8::StaticOrder, true, true>(ldsl, g, S, E, wave_s);
#endif
              }
            GSYNC(); PE(3);
        } else {
            const float* w_in_l = args.in[7] + (size_t)l * DMOD * DIN;
            PB(4);
#ifndef NO_FOXNORM
            { LANE_STATE(); norm_rows<true>(xout, args.in[6] + l * DMOD, PROJ + C_H, PP, TOK, w_in_l, FOXF, gw, NGW, lane); }
#endif
            if (l == 0) {
                pg8::Gemm g{MEMN, WB + O_WMEM, 2048, 2048, DMOD, DMOD, DMOD, 0, 0}; pg8::StaticOrder S; S.init(2048, 2048, G, bx);
                pg8::EpiBf16 E{MEMKV, MKP};

#ifndef NO_G2
              pg8::gemm_phase<pg8::EpiBf16, pg8::StaticOrder, true, true>(ldsl, g, S, E, wave_s);
#endif

            }
            GSYNC(); PE(4);
            {
                PB(5);
                { pg8::Gemm g{PROJ + C_H, WL + O_WIN, TOK, 4096, DMOD, PP, DMOD, 0, 0}; pg8::StaticOrder S; S.init(TOK, 4096, G, bx);
                  pg8::EpiBf16 E{PROJ, PP};

#ifndef NO_G3
              pg8::gemm_phase<pg8::EpiBf16, pg8::StaticOrder, true, true>(ldsl, g, S, E, wave_s);
#endif
              }
                GSYNC(); PE(5); PB(6);
#ifndef NO_PP1
                {
                    LANE_STATE();
                    if (gw < 64) {
                        const int bl = gw >> 3, h = gw & 7; const float bfv = args.in[8][l * 8 + h];
                        const f32x4* f4 = (const f32x4*)(FOXF + (size_t)(bl * 8 + h) * SEQL + lane * 64);
                        f32x4 lf[16]; float run = 0.f;
#pragma unroll
                        for (int i = 0; i < 16; ++i) lf[i] = f4[i];
#pragma unroll
                        for (int i = 0; i < 16; ++i) {
#pragma unroll
                            for (int e = 0; e < 4; ++e) { lf[i][e] = logsig(lf[i][e] + bfv); run += lf[i][e]; } }
                        float incl = run;
#pragma unroll
                        for (int o = 1; o < 64; o <<= 1) { const float t = __builtin_bit_cast(float, __builtin_amdgcn_ds_bpermute((lane - o) << 2, __builtin_bit_cast(int, incl))); if (lane >= o) incl += t; }
                        run = incl - run;
                        f32x4* cp = (f32x4*)(CK2 + (size_t)(bl * 8 + h) * SEQL + lane * 64);
#pragma unroll
                        for (int i = 0; i < 16; ++i) { f32x4 o4;
#pragma unroll
                            for (int e = 0; e < 4; ++e) { run += lf[i][e]; o4[e] = -run * LOG2E; }
                            cp[i] = o4; }
                    }
                    {
                        float gk[8];
#pragma unroll
                        for (int i = 0; i < 8; ++i) gk[i] = args.in[16][l * 128 + (lane & 15) * 8 + i];
                        for (int r = gw; r < 2048; r += NGW) { bf16* p = MEMKV + (size_t)r * MKP + l * 1024 + lane * 8; float v[8]; ld8(p, v); gnorm8<16>(v, gk, 1.0f); st8(p, v); }
                    }
                    float gqa[8], gka[8], gqc[8], gkc[8], gmq[8];
#pragma unroll
                    for (int i = 0; i < 8; ++i) { const int d = (lane & 7) * 8 + i; gqa[i] = args.in[9][l * 64 + d]; gka[i] = args.in[10][l * 64 + d]; gqc[i] = args.in[11][l * 64 + d]; gkc[i] = args.in[12][l * 64 + d];
                        gmq[i] = args.in[15][l * 128 + (lane & 15) * 8 + i]; }
                    const float invf = powf(500000.0f, -(float)(lane & 7) * 0.125f);
                    LAS float* scr = (LAS float*)ldsl;
                    for (int it = vcu; it < TOK / 64; it += G) {
                        const int m0 = it * 64;
                        float kacc[8];
#pragma unroll
                        for (int i = 0; i < 8; ++i) kacc[i] = 0.f;
                        for (int tt = 0; tt < 8; ++tt) {
                            const int m = m0 + wave * 8 + tt, s = m & (SEQL - 1);
                            bf16* row = PROJ + (size_t)m * PP;
                            const int w = 2 << (lane >> 4); const int cnt = (s + 1 < w) ? s + 1 : w;
                            const v4u rqa = *(const v4u*)(row + C_QA + lane * 8), rka = *(const v4u*)(row + C_KA + lane * 8), rqc = *(const v4u*)(row + C_QC + lane * 8),
                                      rkc = *(const v4u*)(row + C_KC + lane * 8), rmq = *(const v4u*)(row + C_MQ + lane * 8), rpu = *(const v4u*)(row + C_PU + lane * 8);
                            v4u rw[15];
#pragma unroll
                            for (int j = 1; j < 16; ++j) rw[j - 1] = (j < cnt) ? *(const v4u*)(row - (size_t)j * PP + C_PU + lane * 8) : (v4u){0u, 0u, 0u, 0u};
                            const float ang = (float)positions[m] * invf;
                            const float cs = cosf(ang), sn = sinf(ang);
                            float cc[8], ss[8];
#pragma unroll
                            for (int i = 0; i < 8; ++i) { cc[i] = __builtin_bit_cast(float, __builtin_amdgcn_readlane(__builtin_bit_cast(int, cs), i)); ss[i] = __builtin_bit_cast(float, __builtin_amdgcn_readlane(__builtin_bit_cast(int, sn), i)); }
                            float v[8];
                            un8(rqa, v); gnorm8<8>(v, gqa, 1.0f); rot8(v, cc, ss, lane & 7);
#pragma unroll
                            for (int i = 0; i < 8; ++i) v[i] *= C2_64;
                            st8(row + C_QA + lane * 8, v);
                            un8(rka, v); gnorm8<8>(v, gka, 1.0f); rot8(v, cc, ss, lane & 7); st8(row + C_KA + lane * 8, v);
#pragma unroll
                            for (int i = 0; i < 8; ++i) kacc[i] += v[i];
                            un8(rqc, v); gnorm8<8>(v, gqc, C2_64); st8(row + C_QC + lane * 8, v);
                            un8(rkc, v); gnorm8<8>(v, gkc, 1.0f); st8(row + C_KC + lane * 8, v);
                            un8(rmq, v); gnorm8<16>(v, gmq, C2_128); st8(row + C_MQ + lane * 8, v);
                            {
                                float u0[8], sm[8]; un8(rpu, u0);
#pragma unroll
                                for (int i = 0; i < 8; ++i) sm[i] = u0[i];
#pragma unroll
                                for (int j = 0; j < 15; ++j) { float t[8]; un8(rw[j], t);
#pragma unroll
                                    for (int i = 0; i < 8; ++i) sm[i] += t[i]; }
                                const float inv = 1.0f / (float)cnt;
#pragma unroll
                                for (int i = 0; i < 8; ++i) sm[i] = sm[i] * inv - u0[i];
                                st8(POOLED + (size_t)m * 512 + lane * 8, sm);
                            }
                        }
#pragma unroll
                        for (int i = 0; i < 8; ++i) scr[wave * 512 + lane * 8 + i] = kacc[i];
                        __syncthreads();
                        { float t = 0.f;
#pragma unroll
                          for (int w8 = 0; w8 < 8; ++w8) t += scr[w8 * 512 + tid];
                          const int bl = m0 >> 12, s0 = m0 & (SEQL - 1);
                          KMEAN[(size_t)((bl * 16 + (s0 >> 8)) * 4 + ((s0 >> 6) & 3)) * 512 + tid] = t * (1.0f / 256.0f); }
                        __syncthreads();
                    }
                }
#endif
                GSYNC(); PE(6); PB(7);
                {
                    float skipb;
                    { float mq = 0.f, mk = 0.f; for (int i = 0; i < 64; ++i) { mq = fmaxf(mq, fabsf(args.in[11][l * 64 + i])); mk = fmaxf(mk, fabsf(args.in[12][l * 64 + i])); }
                      skipb = 2.0f * (C2_64 * 64.0f * 1.01f * mq * mk) + 48.0f; *(volatile LAS float*)(ldsl + 133136) = skipb; __syncthreads(); }
                    for (int ui = vcu; ui < 512; ui += G)
                        for (int uj = 0; uj < 2; ++uj) {
                            const int pp = ui, bh = pp >> 3, s8 = pp & 7, bl = bh >> 3, h = bh & 7;
                            const int qb = (uj & 1) ? s8 : 15 - s8;
#ifndef NO_ATTN0
                            attn_body::attn_unit<0, 8>(bl, h, qb, (const attn_body::bf16*)(PROJ + C_QA), (const attn_body::bf16*)(PROJ + C_KA), (const attn_body::bf16*)(PROJ + C_VA), (attn_body::bf16*)(PROJ + C_QA), KMEAN, (char*)lds, wave_s, 0.f);
#endif
                        }
                    for (int u = vcu; u < 512; u += G) { const int bl = u >> 6, h = (u >> 4) & 3, qb = u & 15;
#ifndef NO_MEM
                        attn_body::mem_unit(bl * SEQL, bl, h, qb, (attn_body::bf16*)(PROJ + C_MQ), (const attn_body::bf16*)(MEMKV + l * 1024), (char*)lds, wave_s);
#endif
                    }
                    { pg8::Gemm g{POOLED, WL + O_WPOOL, TOK, 512, 512, 512, 512, 0, 0}; pg8::StaticOrder S; S.init(TOK, 512, G, bx);
                      pg8::EpiBf16 E{PROJ + C_PU, PP};

#ifndef NO_G4
              pg8::gemm_phase<pg8::EpiBf16, pg8::StaticOrder, true, true>(ldsl, g, S, E, wave_s);
#endif
              }
                    {
                        for (int guard = 0; guard < 1200; ++guard) {
                            { int z_; asm volatile("s_mov_b32 %0, 0" : "=s"(z_));
                              if (tid_from_wave(wave_s) == 0) *(volatile LAS unsigned*)(ldsl + 133144 + z_) = atomicAdd((unsigned*)args.ws + 3584 + 64 * l + z_, 1u); }
                            __syncthreads();
                            const int fu = __builtin_amdgcn_readfirstlane((int)*(volatile LAS unsigned*)(ldsl + 133144));
                            __syncthreads();
                            if (fu >= 1024) break;
                            const int qb = 15 - (fu >> 6), bh = fu & 63, bl = bh >> 3, h = bh & 7;
#ifndef NO_ATTN1
                            attn_body::attn_unit<1, 24>(bl, h, qb, (const attn_body::bf16*)(PROJ + C_QC), (const attn_body::bf16*)(PROJ + C_KC), (const attn_body::bf16*)(PROJ + C_VC), (attn_body::bf16*)(PROJ + C_QC), CK2, (char*)lds, wave_s, 0.f);
#endif
                        }
                    }
                }
                GSYNC(); PE(7); PB(8);
                { pg8::Gemm g{PROJ, WL + O_WBR, TOK, DMOD, 512, PP, DMOD, 512, (long)DMOD * DMOD, PROJ + C_H, WL + O_WIN + (size_t)4096 * DMOD, DMOD, 0, (long)DMOD * DMOD}; pg8::StaticOrder S; S.init(TOK, DMOD, G, bx, 8);
                  pg8::EpiGate E{PROJ + C_Z, PP, GS + (size_t)bx * 65536};

#ifndef NO_G5
              pg8::gemm_phase<pg8::EpiGate, pg8::StaticOrder, true, true>(ldsl, g, S, E, wave_s);
#endif
              }
                GSYNC(); PE(8); PB(9);
                { pg8::Gemm g{PROJ + C_Z, WL + O_WOUT, TOK, DMOD, DMOD, PP, DMOD, 0, 0}; pg8::StaticOrder S; S.init(TOK, DMOD, G, bx);
                  float* xo = xout;
                  pg8::EpiResid E{xo, xo, DMOD, 1.0f};

#ifndef NO_G6
              pg8::gemm_phase<pg8::EpiResid, pg8::StaticOrder, true, true>(ldsl, g, S, E, wave_s);
#endif
              }
                GSYNC(); PE(9);
            }
        }
    }
#ifdef PROBE_SYNC
    for (int i = 0; i < 20; ++i) GSYNC();
#endif
#ifdef PROBE_PHASE
    { const unsigned long long tend = __builtin_amdgcn_s_memrealtime() + probe_acc; while (__builtin_amdgcn_s_memrealtime() < tend) __builtin_amdgcn_s_sleep(8); }
#endif
}

extern "C" void kernel_launch(void* const* d_in, const int* in_sizes, int n_in, void* d_out, int out_size, void* d_ws, size_t ws_size, hipStream_t stream) {
    static int grid = 0;
    if (grid == 0) {
        if (n_in != 24 || out_size != TOK * DMOD || ws_size < WS_END) { fprintf(stderr, "kernel_launch: unexpected shapes (n_in %d out %d ws %zu)\n", n_in, out_size, ws_size); grid = -1; return; }
        int dev = 0, cus = 0, per_cu = 0;
        hipGetDevice(&dev); hipDeviceGetAttribute(&cus, hipDeviceAttributeMultiprocessorCount, dev);
        hipFuncSetAttribute((const void*)hybrid_fwd, hipFuncAttributeMaxDynamicSharedMemorySize, LDS_BYTES);
        hipOccupancyMaxActiveBlocksPerMultiprocessor(&per_cu, (const void*)hybrid_fwd, NWAVES * 64, LDS_BYTES);
        (void)hipGetLastError();
        if (per_cu < 1) per_cu = 1;
        grid = cus;
    }
    if (grid < 0) return;
    if (hipMemsetAsync(d_ws, 0, 16384, stream) != hipSuccess) { fprintf(stderr, "kernel_launch: memset of the barrier words failed\n"); return; }
    Args a{};
    for (int i = 0; i < 24; ++i) a.in[i] = (const float*)d_in[i];
    a.out = (float*)d_out; a.ws = (unsigned char*)d_ws;
    void* kargs[] = {&a};
    hipError_t e = hipLaunchCooperativeKernel((const void*)hybrid_fwd, dim3(grid), dim3(NWAVES * 64), kargs, LDS_BYTES, stream);
    if (e != hipSuccess) fprintf(stderr, "cooperative launch failed: %s (grid %d)\n", hipGetErrorString(e), grid);
}
```
